# Optimizing an MI355X kernel written in HIP

```python
import math
import jax
import jax.numpy as jnp
from jax import lax
import numpy as np

D_MODEL = 2048
BATCH = 4
SEQ = 4096
DEPTH = 2

GRID_W = 64
CTX_LEN = 256
EPS = 1e-6
D_FF = ((8 * D_MODEL + 3 * 256 - 1) // (3 * 256)) * 256

S5_WIDTH = D_MODEL // 2
S5_GROUP = 16
S5_GROUPS = S5_WIDTH // S5_GROUP
S5_STATE = 64

DN_DK = 128
DN_DV = 128
DN_HEADS = (D_MODEL // 2) // DN_DV
DN_WIDTH = DN_HEADS * DN_DV
DN_CHUNK = 64
SHORT_CONV = 4

LRU_WIDTH = D_MODEL // 2
LRU_BLOCK = 128
LRU_BLOCKS = LRU_WIDTH // LRU_BLOCK
LRU_C = 8.0
LRU_CONV = 4

RET_DK = 256
RET_DV = 512
RET_HEADS = (D_MODEL // 2) // RET_DK
RET_QK = RET_HEADS * RET_DK
RET_V = RET_HEADS * RET_DV
RET_CHUNK = 128
ROPE_BASE = 10000.0

EVEN_IN_SIZES = (S5_WIDTH, 3 * DN_WIDTH, DN_WIDTH, 2 * DN_HEADS, 2 * DN_HEADS)
EVEN_IN = sum(EVEN_IN_SIZES)
EVEN_OUT = S5_WIDTH + DN_WIDTH
ODD_IN_SIZES = (LRU_WIDTH, LRU_WIDTH, RET_QK, RET_QK, RET_V, RET_V)
ODD_IN = sum(ODD_IN_SIZES)
ODD_OUT = LRU_WIDTH + RET_V

kernel_name = 'hybrid_s5_deltanet_rglru_retention_dit'


def _identity(t):
    return t


def _flip(t):
    return jnp.flip(t, axis=1)


def _split(p, sizes):
    return jnp.split(p, np.cumsum(sizes)[:-1].tolist(), axis=-1)


def rmsnorm(x, g=None):
    xf = x.astype(jnp.float32)
    y = xf * lax.rsqrt(jnp.mean(xf * xf, axis=-1, keepdims=True) + EPS)
    if g is not None:
        y = y * g
    return y.astype(x.dtype)


def l2norm(x):
    xf = x.astype(jnp.float32)
    return (xf * lax.rsqrt(jnp.sum(xf * xf, axis=-1, keepdims=True) + EPS)).astype(x.dtype)


def adaln(x, g, shift, scale):
    return rmsnorm(x, g) * (1.0 + scale) + shift


def swiglu(h, w1, w3, w2):
    return (jax.nn.silu(h @ w1) * (h @ w3)) @ w2


def centred_depthwise_conv(x, w, b=None):
    k = w.shape[-1]
    y = lax.conv_general_dilated(
        x, jnp.transpose(w)[:, None, :].astype(x.dtype), window_strides=(1,),
        padding=[(k // 2, k - 1 - k // 2)], dimension_numbers=('NWC', 'WIO', 'NWC'),
        feature_group_count=x.shape[-1])
    if b is not None:
        y = y + b
    return y


def _linear_combine(e1, e2):
    a1, b1 = e1
    a2, b2 = e2
    return a1 * a2, a2 * b1 + b2


def _cmul(ar, ai, br, bi):
    return ar * br - ai * bi, ar * bi + ai * br


def _complex_linear_combine(e1, e2):
    a1r, a1i, b1r, b1i = e1
    a2r, a2i, b2r, b2i = e2
    ar, ai = _cmul(a2r, a2i, a1r, a1i)
    br, bi = _cmul(a2r, a2i, b1r, b1i)
    return ar, ai, br + b2r, bi + b2i


def s5_discretise(lam_re, lam_im, log_step, b_re, b_im):
    lam_re = jnp.minimum(lam_re, -1e-4)
    dt = jnp.exp(log_step)[:, None]
    mag = jnp.exp(lam_re * dt)
    abar_re, abar_im = mag * jnp.cos(lam_im * dt), mag * jnp.sin(lam_im * dt)
    nr, ni = abar_re - 1.0, abar_im
    den = lam_re * lam_re + lam_im * lam_im
    coef_re = (nr * lam_re + ni * lam_im) / den
    coef_im = (ni * lam_re - nr * lam_im) / den
    bbar_re, bbar_im = _cmul(coef_re[..., None], coef_im[..., None], b_re, b_im)
    return abar_re, abar_im, bbar_re, bbar_im


def s5_scan(abar_re, abar_im, bu_re, bu_im, h0_re, h0_im):
    shape = (1, bu_re.shape[1]) + abar_re.shape
    a_re = jnp.broadcast_to(abar_re, shape)
    a_im = jnp.broadcast_to(abar_im, shape)
    acr, aci, hr, hi = lax.associative_scan(_complex_linear_combine, (a_re, a_im, bu_re, bu_im), axis=1)
    cr, ci = _cmul(acr, aci, h0_re[:, None], h0_im[:, None])
    return hr + cr, hi + ci


def s5_mixer(uc, ul, lam_re, lam_im, log_step, b_re, b_im, c_re, c_im, d_skip, glu_w, glu_b, need_ctx):
    def grouped(u):
        return u.reshape(u.shape[0], u.shape[1], S5_GROUPS, S5_GROUP)

    def drive(u, bbr, bbi):
        return jnp.einsum('blgs,gps->blgp', u, bbr), jnp.einsum('blgs,gps->blgp', u, bbi)

    def readout(hr, hi, cr, ci):
        y = jnp.einsum('blgp,gsp->blgs', hr, cr) - jnp.einsum('blgp,gsp->blgs', hi, ci)
        return y.reshape(y.shape[0], y.shape[1], S5_WIDTH)

    ugc, ugl = grouped(uc), grouped(ul)
    h0 = jnp.zeros((ul.shape[0], S5_GROUPS, S5_STATE), ul.dtype)
    yl = d_skip * ul
    yc = d_skip * uc if need_ctx else None
    for d in range(2):
        f = _identity if d == 0 else _flip
        abr, abi, bbr, bbi = s5_discretise(lam_re[d], lam_im[d], log_step[d], b_re[d], b_im[d])
        hcr, hci = s5_scan(abr, abi, *drive(f(ugc), bbr, bbi), h0, h0)
        hlr, hli = s5_scan(abr, abi, *drive(f(ugl), bbr, bbi), hcr[:, -1], hci[:, -1])
        yl = yl + f(readout(hlr, hli, c_re[d], c_im[d]))
        if need_ctx:
            yc = yc + f(readout(hcr, hci, c_re[d], c_im[d]))

    def glu(y):
        y = jax.nn.gelu(y)
        return y * jax.nn.sigmoid(y @ glu_w + glu_b)

    return (glu(yc) if need_ctx else None), glu(yl)


def gated_delta_chunks(q, k, v, g, beta, s0, with_out):
    bsz, n_tok, heads, dk = q.shape
    dv = v.shape[-1]
    c = DN_CHUNK
    n = n_tok // c

    def chunk(t):
        return jnp.moveaxis(t.reshape((bsz, n, c) + t.shape[2:]), 2, 3)

    q, k, v, beta = chunk(q), chunk(k), chunk(v), chunk(beta)
    gcum = jnp.cumsum(chunk(g).astype(jnp.float32), axis=-1)
    causal = jnp.tril(jnp.ones((c, c), dtype=bool))
    strict = jnp.tril(jnp.ones((c, c), dtype=bool), -1)
    gam = jnp.exp(jnp.where(causal, gcum[..., :, None] - gcum[..., None, :], -jnp.inf))
    kb = k * beta[..., None]
    m = jnp.where(strict, jnp.einsum('bnhid,bnhjd->bnhij', kb, k) * gam, 0.0)
    eye = jnp.eye(c, dtype=m.dtype)
    p = -m
    tinv = eye + p
    for _ in range(int(math.log2(c)) - 1):
        p = p @ p
        tinv = tinv @ (eye + p)
    u = tinv @ (v * beta[..., None])
    w = tinv @ (kb * jnp.exp(gcum)[..., None])
    g_last = gcum[..., -1]
    k_dec = k * jnp.exp(g_last[..., None] - gcum)[..., None]

    def step(s, inp):
        u_c, w_c, kd_c, gl_c = inp
        v_new = u_c - jnp.einsum('bhck,bhkv->bhcv', w_c, s)
        s_next = s * jnp.exp(gl_c)[..., None, None] + jnp.einsum('bhck,bhcv->bhkv', kd_c, v_new)
        return s_next, s

    def seq_first(t):
        return jnp.moveaxis(t, 1, 0)

    s_final, s_start = lax.scan(step, s0, (seq_first(u), seq_first(w), seq_first(k_dec), seq_first(g_last)))
    if not with_out:
        return None, s_final
    s_start = jnp.moveaxis(s_start, 0, 1)
    v_new = u - w @ s_start
    attn = jnp.einsum('bnhid,bnhjd->bnhij', q, k) * gam
    o = (q * jnp.exp(gcum)[..., None]) @ s_start + attn @ v_new
    return jnp.moveaxis(o, 3, 2).reshape(bsz, n_tok, heads, dv), s_final


def dn_prep(qkv, a_raw, b_raw, conv_w, a_log, dt_bias):
    bsz, n_tok, _ = qkv.shape
    qkv = jax.nn.silu(centred_depthwise_conv(qkv, conv_w))
    q, k, v = jnp.split(qkv, 3, axis=-1)
    q = l2norm(q.reshape(bsz, n_tok, DN_HEADS, DN_DK)) * (DN_DK ** -0.5)
    k = l2norm(k.reshape(bsz, n_tok, DN_HEADS, DN_DK))
    v = v.reshape(bsz, n_tok, DN_HEADS, DN_DV)
    a_raw = a_raw.reshape(bsz, n_tok, 2, DN_HEADS)
    b_raw = b_raw.reshape(bsz, n_tok, 2, DN_HEADS)
    g = -jnp.exp(a_log) * jax.nn.softplus(a_raw + dt_bias)
    beta = jax.nn.sigmoid(b_raw)
    return q, k, v, g, beta


def deltanet_mixer(qkv_c, gate_c, a_c, b_c, qkv_l, gate_l, a_l, b_l, conv_w, a_log, dt_bias, norm_g, need_ctx):
    qc, kc, vc, gc, bc = dn_prep(qkv_c, a_c, b_c, conv_w, a_log, dt_bias)
    ql, kl, vl, gl, bl = dn_prep(qkv_l, a_l, b_l, conv_w, a_log, dt_bias)
    s0 = jnp.zeros((ql.shape[0], DN_HEADS, DN_DK, DN_DV), jnp.float32)
    oc, ol = 0.0, 0.0
    for d in range(2):
        f = _identity if d == 0 else _flip
        oc_d, s_ctx = gated_delta_chunks(f(qc), f(kc), f(vc), f(gc[:, :, d]), f(bc[:, :, d]), s0, need_ctx)
        ol_d, _ = gated_delta_chunks(f(ql), f(kl), f(vl), f(gl[:, :, d]), f(bl[:, :, d]), s_ctx, True)
        ol = ol + f(ol_d)
        if need_ctx:
            oc = oc + f(oc_d)

    def finish(o, gate):
        bsz, n_tok = gate.shape[:2]
        gate = gate.reshape(bsz, n_tok, DN_HEADS, DN_DV)
        return (rmsnorm(o, norm_g) * jax.nn.silu(gate)).reshape(bsz, n_tok, DN_WIDTH)

    return (finish(oc, gate_c) if need_ctx else None), finish(ol, gate_l)


def rglru_scan(x, wa, ba, wx, bx, lam, h0):
    bsz, n_tok, _ = x.shape
    xf = x.astype(jnp.float32)
    xb = xf.reshape(bsz, n_tok, LRU_BLOCKS, LRU_BLOCK)
    r = jax.nn.sigmoid(jnp.einsum('blnd,nde->blne', xb, wa).reshape(bsz, n_tok, LRU_WIDTH) + ba)
    i = jax.nn.sigmoid(jnp.einsum('blnd,nde->blne', xb, wx).reshape(bsz, n_tok, LRU_WIDTH) + bx)
    log_a = -LRU_C * r * jax.nn.softplus(-lam.astype(jnp.float32))
    a = jnp.exp(log_a)
    b = jnp.sqrt(jnp.maximum(-jnp.expm1(2.0 * log_a), 0.0)) * (i * xf)
    a_cum, h = lax.associative_scan(_linear_combine, (a, b), axis=1)
    return h + a_cum * h0[:, None]


def rglru_mixer(xc, gc, xl, gl, conv_w, conv_b, wa, ba, wx, bx, lam, need_ctx):
    xc = centred_depthwise_conv(xc, conv_w, conv_b)
    xl = centred_depthwise_conv(xl, conv_w, conv_b)
    h0 = jnp.zeros((xl.shape[0], LRU_WIDTH), jnp.float32)
    yc, yl = 0.0, 0.0
    for d in range(2):
        f = _identity if d == 0 else _flip
        hc = rglru_scan(f(xc), wa[d], ba[d], wx[d], bx[d], lam[d], h0)
        hl = rglru_scan(f(xl), wa[d], ba[d], wx[d], bx[d], lam[d], hc[:, -1])
        yl = yl + f(hl)
        if need_ctx:
            yc = yc + f(hc)
    out_l = yl * jax.nn.gelu(gl)
    out_c = yc * jax.nn.gelu(gc) if need_ctx else None
    return out_c, out_l


def axial_rope_tables(n_tokens):
    rows = n_tokens // GRID_W
    r, col = jnp.meshgrid(jnp.arange(rows), jnp.arange(GRID_W), indexing='ij')
    n_freq = RET_DK // 4
    inv = ROPE_BASE ** (-jnp.arange(n_freq, dtype=jnp.float32) / n_freq)
    ang = jnp.concatenate([r.reshape(-1, 1) * inv, col.reshape(-1, 1) * inv], axis=-1)
    return jnp.cos(ang), jnp.sin(ang)


def apply_rope(t, cos, sin):
    half = t.shape[-1] // 2
    t1, t2 = t[..., :half], t[..., half:]
    cos, sin = cos[None, :, None, :], sin[None, :, None, :]
    return jnp.concatenate([t1 * cos - t2 * sin, t1 * sin + t2 * cos], axis=-1).astype(t.dtype)


def retention_chunks(q, k, v, log_gamma, s0, with_out):
    bsz, n_tok, heads, _ = q.shape
    dv = v.shape[-1]
    c = RET_CHUNK
    n = n_tok // c

    def chunk(t):
        return t.reshape(bsz, n, c, heads, t.shape[-1]).transpose(1, 0, 3, 2, 4)

    idx = jnp.arange(c, dtype=jnp.float32)
    lg = log_gamma.astype(jnp.float32)
    causal = jnp.tril(jnp.ones((c, c), dtype=bool))
    rel = idx[:, None] - idx[None, :]
    dec = jnp.exp(jnp.where(causal, rel[None] * lg[:, None, None], -jnp.inf))
    xi = jnp.exp((idx[None] + 1.0) * lg[:, None])
    zeta = jnp.exp((c - 1.0 - idx[None]) * lg[:, None])
    g_chunk = jnp.exp(c * lg)

    def step(s, inp):
        qc, kc, vc = inp
        s_next = s * g_chunk[None, :, None, None] + jnp.einsum('bhcd,bhcv->bhdv', kc * zeta[None, :, :, None], vc)
        if not with_out:
            return s_next, None
        inner = jnp.einsum('bhid,bhjd->bhij', qc, kc) * dec[None]
        o = jnp.einsum('bhij,bhjv->bhiv', inner, vc) + jnp.einsum('bhcd,bhdv->bhcv', qc * xi[None, :, :, None], s)
        return s_next, o

    s_final, o = lax.scan(step, s0, (chunk(q), chunk(k), chunk(v)))
    if not with_out:
        return None, s_final
    return o.transpose(1, 0, 3, 2, 4).reshape(bsz, n_tok, heads, dv), s_final


def retention_mixer(qc, kc, vc, rc, ql, kl, vl, rl, theta, cos, sin, need_ctx):
    def heads(t, dh):
        return t.reshape(t.shape[0], t.shape[1], RET_HEADS, dh)

    scale = RET_DK ** -0.5
    qc, kc, vc = heads(qc, RET_DK), heads(kc, RET_DK) * scale, heads(vc, RET_DV)
    ql = apply_rope(heads(ql, RET_DK), cos, sin)
    kl = apply_rope(heads(kl, RET_DK), cos, sin) * scale
    vl = heads(vl, RET_DV)
    log_gamma = -jnp.exp(theta.astype(jnp.float32))
    s0 = jnp.zeros((ql.shape[0], RET_HEADS, RET_DK, RET_DV), jnp.float32)
    oc, ol = 0.0, 0.0
    for d in range(2):
        f = _identity if d == 0 else _flip
        oc_d, s_ctx = retention_chunks(f(qc), f(kc), f(vc), log_gamma[d], s0, need_ctx)
        ol_d, _ = retention_chunks(f(ql), f(kl), f(vl), log_gamma[d], s_ctx, True)
        ol = ol + f(ol_d)
        if need_ctx:
            oc = oc + f(oc_d)

    def finish(o, gate):
        return (rmsnorm(o) * jax.nn.silu(heads(gate, RET_DV))).reshape(gate.shape[0], gate.shape[1], RET_V)

    return (finish(oc, rc) if need_ctx else None), finish(ol, rl)


def even_mixer(hc, hl, w_in, w_out, lam_re, lam_im, log_step, b_re, b_im, c_re, c_im, d_skip, glu_w, glu_b,
               dn_conv_w, dn_a_log, dn_dt_bias, dn_norm_g, need_ctx):
    uc, qkv_c, gate_c, a_c, b_c = _split(hc @ w_in, EVEN_IN_SIZES)
    ul, qkv_l, gate_l, a_l, b_l = _split(hl @ w_in, EVEN_IN_SIZES)
    s5_c, s5_l = s5_mixer(uc, ul, lam_re, lam_im, log_step, b_re, b_im, c_re, c_im, d_skip, glu_w, glu_b, need_ctx)
    dn_c, dn_l = deltanet_mixer(qkv_c, gate_c, a_c, b_c, qkv_l, gate_l, a_l, b_l,
                                dn_conv_w, dn_a_log, dn_dt_bias, dn_norm_g, need_ctx)
    yl = jnp.concatenate([s5_l, dn_l], axis=-1) @ w_out
    yc = jnp.concatenate([s5_c, dn_c], axis=-1) @ w_out if need_ctx else None
    return yc, yl


def odd_mixer(hc, hl, w_in, w_out, conv_w, conv_b, wa, ba, wx, bx, lam, ret_theta, cos, sin, need_ctx):
    xc, gc, qc, kc, vc, rc = _split(hc @ w_in, ODD_IN_SIZES)
    xl, gl, ql, kl, vl, rl = _split(hl @ w_in, ODD_IN_SIZES)
    lru_c, lru_l = rglru_mixer(xc, gc, xl, gl, conv_w, conv_b, wa, ba, wx, bx, lam, need_ctx)
    ret_c, ret_l = retention_mixer(qc, kc, vc, rc, ql, kl, vl, rl, ret_theta, cos, sin, need_ctx)
    yl = jnp.concatenate([lru_l, ret_l], axis=-1) @ w_out
    yc = jnp.concatenate([lru_c, ret_c], axis=-1) @ w_out if need_ctx else None
    return yc, yl


def setup_inputs(seed: int = 0) -> dict:
    key = jax.random.key(seed)
    keys = jax.random.split(key, 48)
    counter = iter(range(48))
    f32 = jnp.float32

    def nk():
        return keys[next(counter)]

    def normal(shape, scale):
        return jax.random.normal(nk(), shape, f32) * scale

    def uniform(shape, lo, hi):
        return jax.random.uniform(nk(), shape, f32, lo, hi)

    D = D_MODEL
    NE = (DEPTH + 1) // 2
    NO = DEPTH // 2
    n_idx = jnp.arange(S5_STATE, dtype=f32)
    dt_dn = jnp.exp(uniform((NE, 2, DN_HEADS), math.log(1e-3), math.log(1e-1)))
    a_lru = uniform((NO, 2, LRU_WIDTH), 0.9, 0.999) ** (1.0 / LRU_C)
    h_idx = jnp.arange(RET_HEADS, dtype=f32)
    ret_base = jnp.log(-jnp.log1p(-jnp.exp2(-5.0 - h_idx)))
    return {
        'x': normal((BATCH, SEQ, D), 1.0),
        'c': normal((BATCH, D), 1.0),
        'ctx': normal((BATCH, CTX_LEN, D), 1.0),
        'c_ctx': normal((D,), 1.0),
        'mod_w': normal((DEPTH, D, 6 * D), 0.5 * D ** -0.5),
        'mod_b': normal((DEPTH, 6 * D), 0.02),
        'norm1_g': 1.0 + normal((DEPTH, D), 0.02),
        'norm2_g': 1.0 + normal((DEPTH, D), 0.02),
        'ffn_w1': normal((DEPTH, D, D_FF), D ** -0.5),
        'ffn_w3': normal((DEPTH, D, D_FF), D ** -0.5),
        'ffn_w2': normal((DEPTH, D_FF, D), D_FF ** -0.5),
        'final_g': 1.0 + normal((D,), 0.02),
        'even_w_in': normal((NE, D, EVEN_IN), D ** -0.5),
        'even_w_out': normal((NE, EVEN_OUT, D), EVEN_OUT ** -0.5),
        's5_lam_re': -0.5 + normal((NE, 2, S5_GROUPS, S5_STATE), 0.01),
        's5_lam_im': math.pi * n_idx + normal((NE, 2, S5_GROUPS, S5_STATE), 0.01),
        's5_log_step': uniform((NE, 2, S5_GROUPS), math.log(1e-3), math.log(1e-1)),
        's5_b_re': normal((NE, 2, S5_GROUPS, S5_STATE, S5_GROUP), (2 * S5_GROUP) ** -0.5),
        's5_b_im': normal((NE, 2, S5_GROUPS, S5_STATE, S5_GROUP), (2 * S5_GROUP) ** -0.5),
        's5_c_re': normal((NE, 2, S5_GROUPS, S5_GROUP, S5_STATE), (2 * S5_STATE) ** -0.5),
        's5_c_im': normal((NE, 2, S5_GROUPS, S5_GROUP, S5_STATE), (2 * S5_STATE) ** -0.5),
        's5_d': normal((NE, S5_WIDTH), 0.5),
        's5_glu_w': normal((NE, S5_WIDTH, S5_WIDTH), S5_WIDTH ** -0.5),
        's5_glu_b': normal((NE, S5_WIDTH), 0.02),
        'dn_conv_w': normal((NE, 3 * DN_WIDTH, SHORT_CONV), SHORT_CONV ** -0.5),
        'dn_a_log': jnp.log(uniform((NE, 2, DN_HEADS), 1.0, 16.0)),
        'dn_dt_bias': dt_dn + jnp.log(-jnp.expm1(-dt_dn)),
        'dn_norm_g': 1.0 + normal((NE, DN_DV), 0.02),
        'odd_w_in': normal((NO, D, ODD_IN), D ** -0.5),
        'odd_w_out': normal((NO, ODD_OUT, D), ODD_OUT ** -0.5),
        'lru_conv_w': normal((NO, LRU_WIDTH, LRU_CONV), LRU_CONV ** -0.5),
        'lru_conv_b': normal((NO, LRU_WIDTH), 0.02),
        'lru_wa': normal((NO, 2, LRU_BLOCKS, LRU_BLOCK, LRU_BLOCK), LRU_BLOCK ** -0.5),
        'lru_ba': normal((NO, 2, LRU_WIDTH), 0.02),
        'lru_wx': normal((NO, 2, LRU_BLOCKS, LRU_BLOCK, LRU_BLOCK), LRU_BLOCK ** -0.5),
        'lru_bx': normal((NO, 2, LRU_WIDTH), 0.02),
        'lru_lam': jnp.log(a_lru) - jnp.log1p(-a_lru),
        'ret_theta': ret_base + normal((NO, 2, RET_HEADS), 0.01),
    }


def reference(x, c, ctx, c_ctx, mod_w, mod_b, norm1_g, norm2_g, ffn_w1, ffn_w3, ffn_w2, final_g,
              even_w_in, even_w_out, s5_lam_re, s5_lam_im, s5_log_step, s5_b_re, s5_b_im, s5_c_re, s5_c_im,
              s5_d, s5_glu_w, s5_glu_b, dn_conv_w, dn_a_log, dn_dt_bias, dn_norm_g,
              odd_w_in, odd_w_out, lru_conv_w, lru_conv_b, lru_wa, lru_ba, lru_wx, lru_bx, lru_lam, ret_theta):
    cos, sin = axial_rope_tables(x.shape[1])
    sc = jax.nn.silu(c)
    scc = jax.nn.silu(c_ctx)
    xl, xc = x, ctx
    for i in range(DEPTH):
        need_ctx = i < DEPTH - 1
        j = i // 2
        mod_l = [m[:, None, :] for m in jnp.split(sc @ mod_w[i] + mod_b[i], 6, axis=-1)]
        mod_c = jnp.split(scc @ mod_w[i] + mod_b[i], 6, axis=-1)
        hl = adaln(xl, norm1_g[i], mod_l[0], mod_l[1])
        hc = adaln(xc, norm1_g[i], mod_c[0], mod_c[1])
        if i % 2 == 0:
            yc, yl = even_mixer(hc, hl, even_w_in[j], even_w_out[j], s5_lam_re[j], s5_lam_im[j], s5_log_step[j],
                                s5_b_re[j], s5_b_im[j], s5_c_re[j], s5_c_im[j], s5_d[j], s5_glu_w[j], s5_glu_b[j],
                                dn_conv_w[j], dn_a_log[j], dn_dt_bias[j], dn_norm_g[j], need_ctx)
        else:
            yc, yl = odd_mixer(hc, hl, odd_w_in[j], odd_w_out[j], lru_conv_w[j], lru_conv_b[j], lru_wa[j], lru_ba[j],
                               lru_wx[j], lru_bx[j], lru_lam[j], ret_theta[j], cos, sin, need_ctx)
        xl = xl + mod_l[2] * yl
        hl = adaln(xl, norm2_g[i], mod_l[3], mod_l[4])
        xl = xl + mod_l[5] * swiglu(hl, ffn_w1[i], ffn_w3[i], ffn_w2[i])
        if need_ctx:
            xc = xc + mod_c[2] * yc
            hc = adaln(xc, norm2_g[i], mod_c[3], mod_c[4])
            xc = xc + mod_c[5] * swiglu(hc, ffn_w1[i], ffn_w3[i], ffn_w2[i])
    return rmsnorm(xl, final_g)
```

```cpp
#include <hip/hip_runtime.h>
#include <cstdio>
#include <cstdint>

#ifndef MK_ONE_LAUNCH
#define MK_ONE_LAUNCH 1
#endif

#define DI __device__ __forceinline__
#define LAS __attribute__((address_space(3)))
typedef unsigned short bf16;
typedef short bf16x8 __attribute__((ext_vector_type(8)));
typedef float f32x4 __attribute__((ext_vector_type(4)));
typedef float f32x2 __attribute__((ext_vector_type(2)));
typedef unsigned u32x4 __attribute__((ext_vector_type(4)));
typedef unsigned u32x2 __attribute__((ext_vector_type(2)));
typedef short s16x4 __attribute__((ext_vector_type(4)));

constexpr int DM = 2048, NB = 4, SEQ = 4096, CTX = 256, DFF = 5632;
constexpr int SROW = CTX + SEQ;
constexpr int MROWS = NB * SROW;
constexpr int NCH = SROW / 64;
constexpr float EPS = 1e-6f;
constexpr int IN0_LD = 5120;
constexpr int INB_LD = 6144;

constexpr size_t MiB = 1u << 20;
constexpr size_t WS_CTL = 0, CTL_BYTES = 1 * MiB;
constexpr size_t WS_MOD = 1 * MiB;
constexpr size_t WS_TAB = 2 * MiB;
constexpr size_t WS_XC = 4 * MiB;
constexpr size_t WS_W = 12 * MiB;
constexpr size_t W_IN = 0, W_OUT = 32 * MiB, W_GLU = 44 * MiB, W_UP = 46 * MiB, W_DN = 90 * MiB;
constexpr size_t WS_H = 124 * MiB;
constexpr size_t WS_MIX = 192 * MiB;
constexpr size_t WS_BIG = 294 * MiB;
constexpr size_t B_IN0 = 0, B_AB = 170 * MiB, B_DNQ = 173 * MiB, B_DNK = 207 * MiB, B_DNV = 241 * MiB, B_DNG = 275 * MiB, B_DNB = 277 * MiB,
                 B_DNO0 = 279 * MiB, B_DNO1 = 313 * MiB, B_S5Y = 347 * MiB, B_S5E = 381 * MiB, B_S5S = 398 * MiB, B_GCUM = 415 * MiB, B_END0 = 417 * MiB;
constexpr size_t MIX_TINV = 68 * MiB;
constexpr size_t B_INA = 0, B_XCV = 68 * MiB, B_LA = 102 * MiB, B_BB = 170 * MiB, B_LEP = 238 * MiB, B_LST = 243 * MiB;
constexpr size_t B_INB = 0, B_RO0 = 204 * MiB, B_RO1 = 268 * MiB;
constexpr size_t B_G = 0;
constexpr size_t WS_END = WS_BIG + B_END0;

DI float bf2f(unsigned v) { return __uint_as_float(v << 16); }
DI unsigned f2bf(float f) { unsigned u = __float_as_uint(f); return (u + 0x7fffu + ((u >> 16) & 1u)) >> 16; }
DI unsigned pk2(float lo, float hi) { return f2bf(lo) | (f2bf(hi) << 16); }
DI float lo16(unsigned w) { return __uint_as_float(w << 16); }
DI float hi16(unsigned w) { return __uint_as_float(w & 0xffff0000u); }
DI float sigmoidf_(float x) { return 1.f / (1.f + expf(-x)); }
DI float siluf_(float x) { return x / (1.f + expf(-x)); }
DI float softplusf_(float x) { return fmaxf(x, 0.f) + log1pf(expf(-fabsf(x))); }
DI float gelu_tanh(float x) { const float u = 0.7978845608028654f * (x + 0.044715f * x * x * x); return 0.5f * x * (1.f + tanhf(u)); }
DI float wave_sum(float v) {
#pragma unroll
    for (int o = 1; o < 64; o <<= 1) v += __shfl_xor(v, o);
    return v;
}

DI bf16x8 frag_rows(LAS unsigned char* base, int RSB, int row0, int k0, int r, int q) { return *(const LAS bf16x8*)(base + (row0 + r) * RSB + (k0 + 8 * q) * 2); }
DI bf16x8 frag_tr(LAS unsigned char* base, int RSB, int k0, int n0, int q, int qq, int pp) {
    const s16x4 a = __builtin_amdgcn_ds_read_tr16_b64_v4i16((LAS s16x4*)(base + (k0 + 8 * q + qq) * RSB + (n0 + 4 * pp) * 2));
    const s16x4 b = __builtin_amdgcn_ds_read_tr16_b64_v4i16((LAS s16x4*)(base + (k0 + 8 * q + 4 + qq) * RSB + (n0 + 4 * pp) * 2));
    return (bf16x8){a[0], a[1], a[2], a[3], b[0], b[1], b[2], b[3]}; }
DI bf16x8 frag_rows_perm(LAS unsigned char* base, int RSB, int row0, int k0, int r, int q) {
    const u32x2 a = *(const LAS u32x2*)(base + (row0 + r) * RSB + (k0 + 4 * q) * 2), b = *(const LAS u32x2*)(base + (row0 + r) * RSB + (k0 + 16 + 4 * q) * 2);
    u32x4 w; w.x = a.x; w.y = a.y; w.z = b.x; w.w = b.y; return __builtin_bit_cast(bf16x8, w); }
DI bf16x8 pack_pair(const f32x4& x, const f32x4& y) { u32x4 w; w.x = pk2(x[0], x[1]); w.y = pk2(x[2], x[3]); w.z = pk2(y[0], y[1]); w.w = pk2(y[2], y[3]); return __builtin_bit_cast(bf16x8, w); }
#define MFMA16(a, b, c) __builtin_amdgcn_mfma_f32_16x16x32_bf16((a), (b), (c), 0, 0, 0)
DI void st_hl(LAS unsigned char* p, int lo_off, const f32x4& c) {
    u32x2 h; h.x = pk2(c[0], c[1]); h.y = pk2(c[2], c[3]);
    u32x2 l; l.x = pk2(c[0] - lo16(h.x), c[1] - hi16(h.x)); l.y = pk2(c[2] - lo16(h.y), c[3] - hi16(h.y));
    *(LAS u32x2*)p = h; *(LAS u32x2*)(p + lo_off) = l; }
DI f32x4 mm3(f32x4 c, const bf16x8& ah, const bf16x8& al, const bf16x8& bh, const bf16x8& bl) { c = MFMA16(ah, bh, c); c = MFMA16(ah, bl, c); c = MFMA16(al, bh, c); return c; }
#define LDS_WAIT() asm volatile("s_waitcnt lgkmcnt(0)" ::: "memory")
#define VM_WAIT() asm volatile("s_waitcnt vmcnt(0)" ::: "memory")

namespace pg8 {
constexpr int BM = 256, BK = 64, HALF = 128, HTB = HALF * BK * 2, STAGE_BYTES = 8 * HTB, NXCD = 8, WGM = 8;
DI int lds_byte(int r, int c) { const int st = (r >> 4) * 2 + (c >> 5), rr = r & 15, cc = c & 31, ob = rr * 64 + cc * 2; return st * 1024 + (ob ^ (((ob >> 9) & 1) << 5)); }
DI void stage_rc(int b, int& R, int& C) { const int st = b / 1024, sb = b % 1024, swz = sb ^ (((sb >> 9) & 1) << 5); R = (st >> 1) * 16 + swz / 64; C = (st & 1) * 32 + (swz % 64) / 2; }
DI int perm32(int rho) { const int n = rho >> 4, i = rho & 15; return 8 * (i >> 2) + 4 * n + (i & 3); }
struct Unit { int pm, pn, koff, nt; };
struct Gemm { const bf16* A; const bf16* Bt; int lda, ldb, K; };
struct StaticOrder {
    int nM, nN, nwg, G, c, lat;
    DI void init(int nM_, int nN_, int G_, int c_, int lat_) { nM = nM_; nN = nN_; nwg = nM * nN; G = G_; c = c_; lat = lat_; }
    DI bool next(int i, int& upm, int& upn, int& ukoff, int& unt) const {
        const long L = (long)i * G + c; if (L >= nwg) return false;
        int wgid = (int)L; { const int q = nwg / NXCD, r = nwg % NXCD, xcd = wgid % NXCD, off = wgid / NXCD; wgid = (xcd < r ? xcd * (q + 1) : r * (q + 1) + (xcd - r) * q) + off; }
        const int nig = WGM * nN, gid = wgid / nig, fm = gid * WGM, gsz = (nM - fm) < WGM ? (nM - fm) : WGM;
        int pm = fm + ((wgid % nig) % gsz); upn = (wgid % nig) / gsz;
        if (lat) pm = (pm >> 4) * 17 + 1 + (pm & 15);
        upm = pm; ukoff = 0; unt = 0; return true;
    }
};
template <int NTOT> struct TailOrder {
    int G, c;
    static constexpr int NWG = 512, LO = (NTOT / 8) & ~1, EX2 = (NTOT - LO * 8) >> 1;
    DI void init(int G_, int c_) { G = G_; c = c_; }
    DI bool next(int i, int& upm, int& upn, int& ukoff, int& unt) const {
        const int L = i * G + c; if (L >= NWG + 256) return false;
        const bool mainu = L < NWG; const int T = L - NWG;
        const int wgid = (L & 7) * (NWG / 8) + (L >> 3);
        const int w = wgid & 63, pml = (wgid >> 6) * 8 + (w & 7); const int ctn = T >> 3, sp = T & 7;
        upm = mainu ? (pml >> 4) * 17 + 1 + (pml & 15) : (ctn >> 3) * 17; upn = mainu ? (w >> 3) : (ctn & 7);
        unt = mainu ? 0 : ((LO + (sp < EX2 ? 2 : 0)) | (sp << 8)); ukoff = mainu ? 0 : (LO * sp + 2 * (sp < EX2 ? sp : EX2)) * 128; return true;
    }
};
DI unsigned cvt_pk_bf16(float lo, float hi) { unsigned r; asm volatile("v_cvt_pk_bf16_f32 %0, %1, %2" : "=v"(r) : "v"(lo), "v"(hi)); return r; }

template <class Epi, class Sched = StaticOrder, bool BLKDIAG = false>
DI void gemm_phase(LAS unsigned char* lds, const Gemm g, const Sched& S, const Epi& E) {
    int tid_ = threadIdx.x; asm volatile("" : "+v"(tid_));
    const int tid = tid_, wid = __builtin_amdgcn_readfirstlane(tid >> 6), lane = tid & 63, wr = wid >> 2, wc = wid & 3, fr = lane & 15, fq = lane >> 4;
    int K_ = g.K; asm volatile("" : "+s"(K_));
    const int K = K_, nt = K / BK;
    unsigned voffA[2], voffB[2];
#pragma unroll
    for (int i = 0; i < 2; ++i) { int R, C; stage_rc(tid * 16 + i * 8192, R, C); const int Rb = Epi::PERM ? ((R & ~31) + perm32(R & 31)) : R;
        voffA[i] = (unsigned)(R * g.lda + C) * 2u; voffB[i] = (unsigned)(Rb * g.ldb + C) * 2u; }
    const size_t kstep = (size_t)(BK * 2);
    const size_t hstepA = (size_t)HALF * g.lda * 2, hstepB = (size_t)HALF * g.ldb * 2;
    const size_t tstepA = 2 * hstepA, tstepB = 2 * hstepB;
    const unsigned ldsw = (unsigned)wid * 1024u;
    const int aoff = lds_byte(wr * 64 + fr, fq * 8), boff = lds_byte(wc * 32 + fr, fq * 8);
#define PG8_SA(b, h) (((b) * 2 + (h)) * HTB)
#define PG8_SB(b, h) ((4 + (b) * 2 + (h)) * HTB)
#define PG8_STAGE(bufoff, gbase, voff) do { _Pragma("unroll") for (int _i = 0; _i < 2; ++_i) \
        __builtin_amdgcn_global_load_lds((const unsigned*)((const char*)(gbase) + (voff)[_i]), (LAS unsigned*)(lds + (bufoff) + ldsw + _i * 8192), 16, 0, 0); } while (0)
#define PG8_LDA(dst, b, h) do { _Pragma("unroll") for (int m = 0; m < 4; ++m) _Pragma("unroll") for (int k = 0; k < 2; ++k) dst[m][k] = *(const LAS bf16x8*)(lds + PG8_SA(b, h) + aoff + m * 2048 + k * 1024); } while (0)
#define PG8_LDB(dst, b, h) do { _Pragma("unroll") for (int n = 0; n < 2; ++n) _Pragma("unroll") for (int k = 0; k < 2; ++k) dst[n][k] = *(const LAS bf16x8*)(lds + PG8_SB(b, h) + boff + n * 2048 + k * 1024); } while (0)
#define PG8_MMA(ai, bj, At, Bt) do { __builtin_amdgcn_s_setprio(1); _Pragma("unroll") for (int m = 0; m < 4; ++m) _Pragma("unroll") for (int n = 0; n < 2; ++n) _Pragma("unroll") for (int k = 0; k < 2; ++k) \
        acc[ai][bj][m][n] = __builtin_amdgcn_mfma_f32_16x16x32_bf16(Bt[n][k], At[m][k], acc[ai][bj][m][n], 0, 0, 0); __builtin_amdgcn_s_setprio(0); } while (0)
#define PG8_WAIT_V(n) asm volatile("s_waitcnt vmcnt(" #n ")" ::: "memory")
#define PG8_WAIT_L(n) asm volatile("s_waitcnt lgkmcnt(" #n ")" ::: "memory")
#define PG8_BAR __builtin_amdgcn_s_barrier()
#define PG8_SCHED __builtin_amdgcn_sched_barrier(0)
#define PG8_KOFF(pn_, koff_) ((BLKDIAG ? (size_t)(((pn_) & 7) >> 1) * 512 : (size_t)0) + (size_t)(koff_))
    int cpm, cpn, ckoff, cnt_, npm = 0, npn = 0, nkoff = 0, nnt = 0; int ui = 0;
    if (!S.next(0, cpm, cpn, ckoff, cnt_)) return;
    f32x4 acc[2][2][4][2];
#pragma unroll
    for (int a = 0; a < 2; ++a)
#pragma unroll
        for (int b = 0; b < 2; ++b)
#pragma unroll
            for (int m = 0; m < 4; ++m)
#pragma unroll
                for (int n = 0; n < 2; ++n) acc[a][b][m][n] = (f32x4){0.f, 0.f, 0.f, 0.f};
    bf16x8 At[4][2], B0[2][2], B1[2][2];
    const char* cA = (const char*)g.A + (size_t)cpm * tstepA + PG8_KOFF(cpn, ckoff); const char* cB = (const char*)g.Bt + (size_t)cpn * tstepB + (size_t)ckoff;
    PG8_STAGE(PG8_SB(0, 0), cB, voffB); PG8_STAGE(PG8_SB(0, 1), cB + hstepB, voffB); PG8_STAGE(PG8_SA(0, 0), cA, voffA); PG8_STAGE(PG8_SA(0, 1), cA + hstepA, voffA);
    if (wr == 1) PG8_BAR;
    PG8_WAIT_V(2); PG8_BAR;
    PG8_STAGE(PG8_SB(1, 0), cB + kstep, voffB); PG8_STAGE(PG8_SA(1, 0), cA + kstep, voffA); PG8_STAGE(PG8_SB(1, 1), cB + hstepB + kstep, voffB);
    PG8_WAIT_V(6); PG8_BAR;
    for (;;) {
        const bool has_next = S.next(ui + 1, npm, npn, nkoff, nnt);
        const char* nA = has_next ? (const char*)g.A + (size_t)npm * tstepA + PG8_KOFF(npn, nkoff) : cA; const char* nB = has_next ? (const char*)g.Bt + (size_t)npn * tstepB + (size_t)nkoff : cB;
        const int cnt = cnt_ ? (cnt_ & 255) : nt;
        for (int t = 0; t < cnt; t += 2) {
            const bool last = (t == cnt - 2);
            const char* a1 = cA + (size_t)(t + 1) * kstep;
            const char* a2 = last ? nA : cA + (size_t)(t + 2) * kstep; const char* b2 = last ? nB : cB + (size_t)(t + 2) * kstep;
            const char* a3 = a2 + kstep; const char* b3 = b2 + kstep;
            PG8_LDB(B0, 0, 0); PG8_LDB(B1, 0, 1); PG8_SCHED; PG8_LDA(At, 0, 0); PG8_STAGE(PG8_SA(1, 1), a1 + hstepA, voffA);
            PG8_WAIT_V(8); PG8_WAIT_L(0); PG8_BAR; PG8_MMA(0, 0, At, B0); PG8_MMA(0, 1, At, B1); PG8_BAR; PG8_SCHED;
            PG8_LDA(At, 0, 1); PG8_STAGE(PG8_SB(0, 0), b2, voffB); PG8_STAGE(PG8_SB(0, 1), b2 + hstepB, voffB); PG8_STAGE(PG8_SA(0, 0), a2, voffA);
            PG8_WAIT_V(8); PG8_WAIT_L(0); PG8_BAR; PG8_MMA(1, 0, At, B0); PG8_MMA(1, 1, At, B1); PG8_BAR; PG8_SCHED;
            PG8_LDB(B0, 1, 0); PG8_LDB(B1, 1, 1); PG8_SCHED; PG8_LDA(At, 1, 0); PG8_STAGE(PG8_SA(0, 1), a2 + hstepA, voffA);
            PG8_WAIT_V(8); PG8_WAIT_L(0); PG8_BAR; PG8_MMA(0, 0, At, B0); PG8_MMA(0, 1, At, B1); PG8_BAR; PG8_SCHED;
            PG8_LDA(At, 1, 1); PG8_STAGE(PG8_SB(1, 0), b3, voffB); PG8_STAGE(PG8_SB(1, 1), b3 + hstepB, voffB); PG8_STAGE(PG8_SA(1, 0), a3, voffA);
            PG8_WAIT_V(8); PG8_WAIT_L(0); PG8_BAR; PG8_MMA(1, 0, At, B0); PG8_MMA(1, 1, At, B1); PG8_BAR; PG8_SCHED;
        }
        if (wr == 0) PG8_BAR;
        { Unit cu; cu.pm = cpm; cu.pn = cpn; cu.koff = ckoff; cu.nt = cnt_; E(acc, cu, wr, wc, fr, fq); }
        if (!has_next) break;
#pragma unroll
        for (int a = 0; a < 2; ++a)
#pragma unroll
            for (int b = 0; b < 2; ++b)
#pragma unroll
                for (int m = 0; m < 4; ++m)
#pragma unroll
                    for (int n = 0; n < 2; ++n) acc[a][b][m][n] = (f32x4){0.f, 0.f, 0.f, 0.f};
        cpm = npm; cpn = npn; ckoff = nkoff; cnt_ = nnt; cA = nA; cB = nB; ++ui;
        if (wr == 1) PG8_BAR;
    }
    PG8_WAIT_V(0);
    PG8_BAR;
#undef PG8_SA
#undef PG8_SB
#undef PG8_STAGE
#undef PG8_LDA
#undef PG8_LDB
#undef PG8_MMA
#undef PG8_WAIT_V
#undef PG8_WAIT_L
#undef PG8_BAR
#undef PG8_SCHED
#undef PG8_KOFF
}
}
using pg8::Unit;
typedef f32x4 AccT[2][2][4][2];

struct EpiPlain {
    static constexpr bool PERM = true;
    bf16* O; int ldc;
    DI void operator()(const AccT& acc, const Unit& u, int wr, int wc, int fr, int fq) const {
        const int row0 = u.pm * 256 + wr * 64 + fr, col0 = u.pn * 256 + wc * 32 + 8 * fq;
#pragma unroll
        for (int ai = 0; ai < 2; ++ai)
#pragma unroll
            for (int m = 0; m < 4; ++m) { bf16* rowp = O + (size_t)(row0 + ai * 128 + m * 16) * ldc + col0;
#pragma unroll
                for (int bj = 0; bj < 2; ++bj) { const f32x4 v0 = acc[ai][bj][m][0], v1 = acc[ai][bj][m][1];
                    u32x4 w; w.x = pg8::cvt_pk_bf16(v0[0], v0[1]); w.y = pg8::cvt_pk_bf16(v0[2], v0[3]); w.z = pg8::cvt_pk_bf16(v1[0], v1[1]); w.w = pg8::cvt_pk_bf16(v1[2], v1[3]);
                    *(u32x4*)(rowp + bj * 128) = w; } }
    }
};
struct EpiIn0 {
    static constexpr bool PERM = true;
    bf16* O; float* AB;
    DI void operator()(const AccT& acc, const Unit& u, int wr, int wc, int fr, int fq) const {
        const int row0 = u.pm * 256 + wr * 64 + fr;
        if (u.pn < 20) {
            const int col0 = u.pn * 256 + wc * 32 + 8 * fq;
#pragma unroll
            for (int ai = 0; ai < 2; ++ai)
#pragma unroll
                for (int m = 0; m < 4; ++m) { bf16* rowp = O + (size_t)(row0 + ai * 128 + m * 16) * IN0_LD + col0;
#pragma unroll
                    for (int bj = 0; bj < 2; ++bj) { const f32x4 v0 = acc[ai][bj][m][0], v1 = acc[ai][bj][m][1];
                        u32x4 w; w.x = pg8::cvt_pk_bf16(v0[0], v0[1]); w.y = pg8::cvt_pk_bf16(v0[2], v0[3]); w.z = pg8::cvt_pk_bf16(v1[0], v1[1]); w.w = pg8::cvt_pk_bf16(v1[2], v1[3]);
                        *(u32x4*)(rowp + bj * 128) = w; } }
        } else if (wc == 0) {
#pragma unroll
            for (int ai = 0; ai < 2; ++ai)
#pragma unroll
                for (int m = 0; m < 4; ++m) { float* rowp = AB + (size_t)(row0 + ai * 128 + m * 16) * 32 + 8 * fq;
                    *(f32x4*)(rowp) = acc[ai][0][m][0]; *(f32x4*)(rowp + 4) = acc[ai][0][m][1]; }
        }
    }
};
template <bool XIN_F32> struct EpiRes {
    static constexpr bool PERM = true;
    const void* xin_l; bf16* xout_l; const float* mod; float* slab;
    DI void operator()(const AccT& acc, const Unit& u, int wr, int wc, int fr, int fq) const {
        const int b = u.pm / 17, j = u.pm % 17;
        const int r0 = wr * 64 + fr, col0 = u.pn * 256 + wc * 32 + 8 * fq;
        if (j == 0) {
            float* sp = slab + ((size_t)(u.nt >> 8) * 1024 + (size_t)b * 256) * DM;
#pragma unroll
            for (int ai = 0; ai < 2; ++ai)
#pragma unroll
                for (int m = 0; m < 4; ++m) { const size_t ro = (size_t)(r0 + ai * 128 + m * 16) * DM + col0;
#pragma unroll
                    for (int bj = 0; bj < 2; ++bj) { *(f32x4*)(sp + ro + bj * 128) = acc[ai][bj][m][0]; *(f32x4*)(sp + ro + bj * 128 + 4) = acc[ai][bj][m][1]; } }
            return;
        }
        const size_t off = ((size_t)b * SEQ + (size_t)(j - 1) * 256) * DM; const float* gt = mod + b * 12288;
        f32x4 gv[2][2];
#pragma unroll
        for (int bj = 0; bj < 2; ++bj)
#pragma unroll
            for (int n = 0; n < 2; ++n) gv[bj][n] = *(const f32x4*)(gt + col0 + bj * 128 + 4 * n);
#pragma unroll
        for (int ai = 0; ai < 2; ++ai)
#pragma unroll
            for (int m = 0; m < 4; ++m) { const size_t ro = off + (size_t)(r0 + ai * 128 + m * 16) * DM + col0;
#pragma unroll
                for (int bj = 0; bj < 2; ++bj) { f32x4 x0, x1;
                    if (XIN_F32) { x0 = *(const f32x4*)((const float*)xin_l + ro + bj * 128); x1 = *(const f32x4*)((const float*)xin_l + ro + bj * 128 + 4); }
                    else { const u32x4 w = *(const u32x4*)((const bf16*)xin_l + ro + bj * 128); x0 = (f32x4){lo16(w.x), hi16(w.x), lo16(w.y), hi16(w.y)}; x1 = (f32x4){lo16(w.z), hi16(w.z), lo16(w.w), hi16(w.w)}; }
                    const f32x4 o0 = x0 + gv[bj][0] * acc[ai][bj][m][0], o1 = x1 + gv[bj][1] * acc[ai][bj][m][1];
                    u32x4 w; w.x = pg8::cvt_pk_bf16(o0[0], o0[1]); w.y = pg8::cvt_pk_bf16(o0[2], o0[3]); w.z = pg8::cvt_pk_bf16(o1[0], o1[1]); w.w = pg8::cvt_pk_bf16(o1[2], o1[3]);
                    *(u32x4*)(xout_l + ro + bj * 128) = w; } }
    }
};
struct EpiSwiglu {
    static constexpr bool PERM = true;
    bf16* O;
    DI void operator()(const AccT& acc, const Unit& u, int wr, int wc, int fr, int fq) const {
        const int row0 = u.pm * 256 + wr * 64 + fr, col0 = u.pn * 128 + wc * 32 + 8 * fq;
#pragma unroll
        for (int ai = 0; ai < 2; ++ai)
#pragma unroll
            for (int m = 0; m < 4; ++m) { bf16* rowp = O + (size_t)(row0 + ai * 128 + m * 16) * DFF + col0;
                float v[8];
#pragma unroll
                for (int n = 0; n < 2; ++n)
#pragma unroll
                    for (int j = 0; j < 4; ++j) { const float a = acc[ai][0][m][n][j], b = acc[ai][1][m][n][j]; v[n * 4 + j] = a / (1.f + __expf(-a)) * b; }
                u32x4 w; w.x = pg8::cvt_pk_bf16(v[0], v[1]); w.y = pg8::cvt_pk_bf16(v[2], v[3]); w.z = pg8::cvt_pk_bf16(v[4], v[5]); w.w = pg8::cvt_pk_bf16(v[6], v[7]);
                *(u32x4*)rowp = w; }
    }
};
struct EpiGlu {
    static constexpr bool PERM = true;
    const bf16* Y; bf16* O; const float* gb;
    DI void operator()(const AccT& acc, const Unit& u, int wr, int wc, int fr, int fq) const {
        const int row0 = u.pm * 256 + wr * 64 + fr, col0 = u.pn * 256 + wc * 32 + 8 * fq;
#pragma unroll
        for (int bj = 0; bj < 2; ++bj) {
            const f32x4 b0 = *(const f32x4*)(gb + col0 + bj * 128), b1 = *(const f32x4*)(gb + col0 + bj * 128 + 4);
#pragma unroll
            for (int ai = 0; ai < 2; ++ai)
#pragma unroll
                for (int m = 0; m < 4; ++m) { const size_t r = (size_t)(row0 + ai * 128 + m * 16);
                    const u32x4 yw = *(const u32x4*)(Y + r * 1024 + col0 + bj * 128);
                    const f32x4 v0 = acc[ai][bj][m][0] + b0, v1 = acc[ai][bj][m][1] + b1;
                    float o[8];
                    o[0] = lo16(yw.x) * sigmoidf_(v0[0]); o[1] = hi16(yw.x) * sigmoidf_(v0[1]); o[2] = lo16(yw.y) * sigmoidf_(v0[2]); o[3] = hi16(yw.y) * sigmoidf_(v0[3]);
                    o[4] = lo16(yw.z) * sigmoidf_(v1[0]); o[5] = hi16(yw.z) * sigmoidf_(v1[1]); o[6] = lo16(yw.w) * sigmoidf_(v1[2]); o[7] = hi16(yw.w) * sigmoidf_(v1[3]);
                    u32x4 w; w.x = pg8::cvt_pk_bf16(o[0], o[1]); w.y = pg8::cvt_pk_bf16(o[2], o[3]); w.z = pg8::cvt_pk_bf16(o[4], o[5]); w.w = pg8::cvt_pk_bf16(o[6], o[7]);
                    *(u32x4*)(O + r * 2048 + col0 + bj * 128) = w; }
        }
    }
};
struct EpiGate {
    static constexpr bool PERM = true;
    const bf16* X; bf16* LA; bf16* BB; const float* ba; const float* bx; const float* spl;
    DI void operator()(const AccT& acc, const Unit& u, int wr, int wc, int fr, int fq) const {
        const int dir = u.pn >> 3, blk = u.pn & 7;
        const int row0 = u.pm * 256 + wr * 64 + fr, ch0 = blk * 128 + wc * 32 + 8 * fq;
        const f32x4 ba0 = *(const f32x4*)(ba + dir * 1024 + ch0), ba1 = *(const f32x4*)(ba + dir * 1024 + ch0 + 4);
        const f32x4 bx0 = *(const f32x4*)(bx + dir * 1024 + ch0), bx1 = *(const f32x4*)(bx + dir * 1024 + ch0 + 4);
        const f32x4 sp0 = *(const f32x4*)(spl + dir * 1024 + ch0), sp1 = *(const f32x4*)(spl + dir * 1024 + ch0 + 4);
#pragma unroll
        for (int ai = 0; ai < 2; ++ai)
#pragma unroll
            for (int m = 0; m < 4; ++m) { const size_t r = (size_t)(row0 + ai * 128 + m * 16);
                const u32x4 xw = *(const u32x4*)(X + r * 1024 + ch0);
                const float xv[8] = {lo16(xw.x), hi16(xw.x), lo16(xw.y), hi16(xw.y), lo16(xw.z), hi16(xw.z), lo16(xw.w), hi16(xw.w)};
                float la[8], bb[8];
#pragma unroll
                for (int n = 0; n < 2; ++n)
#pragma unroll
                    for (int j = 0; j < 4; ++j) { const int q = n * 4 + j;
                        const float pa = acc[ai][0][m][n][j] + (n ? ba1[j] : ba0[j]), px = acc[ai][1][m][n][j] + (n ? bx1[j] : bx0[j]);
                        const float rg = __builtin_amdgcn_rcpf(1.f + __expf(-pa)), ig = __builtin_amdgcn_rcpf(1.f + __expf(-px));
                        const float l = rg * (n ? sp1[j] : sp0[j]); la[q] = l;
                        const float x2 = 2.f * l;
                        const float ser = -x2 * (1.f + x2 * 0.5f * (1.f + x2 * (1.f / 3.f) * (1.f + x2 * 0.25f * (1.f + x2 * 0.2f))));
                        const float om = x2 > -0.25f ? ser : 1.f - __expf(x2);
                        bb[q] = __builtin_sqrtf(fmaxf(om, 0.f)) * (ig * xv[q]); }
                u32x4 w; w.x = pg8::cvt_pk_bf16(la[0], la[1]); w.y = pg8::cvt_pk_bf16(la[2], la[3]); w.z = pg8::cvt_pk_bf16(la[4], la[5]); w.w = pg8::cvt_pk_bf16(la[6], la[7]);
                *(u32x4*)(LA + (r * 2 + dir) * 1024 + ch0) = w;
                w.x = pg8::cvt_pk_bf16(bb[0], bb[1]); w.y = pg8::cvt_pk_bf16(bb[2], bb[3]); w.z = pg8::cvt_pk_bf16(bb[4], bb[5]); w.w = pg8::cvt_pk_bf16(bb[6], bb[7]);
                *(u32x4*)(BB + (r * 2 + dir) * 1024 + ch0) = w; }
    }
};
struct EpiRope {
    static constexpr bool PERM = true;
    bf16* O; const f32x2* rope;
    DI void operator()(const AccT& acc, const Unit& u, int wr, int wc, int fr, int fq) const {
        const int row0 = u.pm * 256 + wr * 64 + fr, col0 = u.pn * 256 + wc * 32 + 8 * fq;
        const int jt = u.pm % 17;
        const bool isqk = u.pn < 8, lat = jt != 0;
        const float sc = (u.pn >= 4 && u.pn < 8) ? 0.0625f : 1.f;
#pragma unroll
        for (int ai = 0; ai < 2; ++ai)
#pragma unroll
            for (int m = 0; m < 4; ++m) { const int rl = wr * 64 + fr + ai * 128 + m * 16;
                bf16* rowp = O + (size_t)(u.pm * 256 + rl) * INB_LD + col0;
                float t1[8], t2[8];
#pragma unroll
                for (int n = 0; n < 2; ++n)
#pragma unroll
                    for (int j = 0; j < 4; ++j) { t1[n * 4 + j] = acc[ai][0][m][n][j]; t2[n * 4 + j] = acc[ai][1][m][n][j]; }
                if (isqk && lat) {
                    const int pos = (jt - 1) * 256 + rl;
                    const int p = (wc < 2) ? (pos >> 6) : (pos & 63);
                    const int f0 = (wc & 1) * 32 + 8 * fq;
                    const f32x4* rp = (const f32x4*)(rope + p * 64 + f0);
#pragma unroll
                    for (int q = 0; q < 4; ++q) { const f32x4 cs = rp[q];
                        const float a0 = t1[2 * q], b0 = t2[2 * q], a1 = t1[2 * q + 1], b1 = t2[2 * q + 1];
                        t1[2 * q] = a0 * cs[0] - b0 * cs[1]; t2[2 * q] = a0 * cs[1] + b0 * cs[0];
                        t1[2 * q + 1] = a1 * cs[2] - b1 * cs[3]; t2[2 * q + 1] = a1 * cs[3] + b1 * cs[2]; }
                }
                u32x4 w; w.x = pg8::cvt_pk_bf16(t1[0] * sc, t1[1] * sc); w.y = pg8::cvt_pk_bf16(t1[2] * sc, t1[3] * sc); w.z = pg8::cvt_pk_bf16(t1[4] * sc, t1[5] * sc); w.w = pg8::cvt_pk_bf16(t1[6] * sc, t1[7] * sc);
                *(u32x4*)(rowp) = w;
                w.x = pg8::cvt_pk_bf16(t2[0] * sc, t2[1] * sc); w.y = pg8::cvt_pk_bf16(t2[2] * sc, t2[3] * sc); w.z = pg8::cvt_pk_bf16(t2[4] * sc, t2[5] * sc); w.w = pg8::cvt_pk_bf16(t2[6] * sc, t2[7] * sc);
                *(u32x4*)(rowp + 128) = w; }
    }
};

#define XB_TMO      128
#define XB_XCNT(j)  (256  + 64 * (j))
#define XB_XSUB(j)  (1280 + 64 * (j))
#define XB_XGEN(j)  (2304 + 64 * (j))
#define XB_TOP      3328
#define XB_TOPGEN   3392
#define XCD_BAR_WORDS 3456
#define XB_SPIN_CAP (1u << 22)
__device__ __forceinline__ unsigned xb_ld(unsigned* p)              { return __hip_atomic_load(p, __ATOMIC_RELAXED, __HIP_MEMORY_SCOPE_AGENT); }
__device__ __forceinline__ unsigned xb_add(unsigned* p, unsigned v) { return __hip_atomic_fetch_add(p, v, __ATOMIC_RELAXED, __HIP_MEMORY_SCOPE_AGENT); }
__device__ __forceinline__ unsigned xb_xcc_id() { return (unsigned)__builtin_amdgcn_s_getreg((3 << 11) | 20) & 0xFu; }
#define XB_SPIN(cond, bar) do { unsigned _sp = 0; while (cond) { __builtin_amdgcn_s_sleep(1); \
    if ((++_sp & 255u) == 0u) { if (xb_ld(&(bar)[XB_TMO])) break; if (_sp > XB_SPIN_CAP) { atomicAdd(&(bar)[XB_TMO], 1u); break; } } } } while (0)
struct XcdBarrier { unsigned* bar; unsigned x; volatile LAS unsigned* st; };
__device__ __forceinline__ XcdBarrier xcd_barrier_post(unsigned* bar, volatile LAS unsigned* st) {
    XcdBarrier b; b.bar = bar; b.x = xb_xcc_id(); b.st = st;
    if (threadIdx.x == 0) (void)xb_add(&bar[XB_XCNT(b.x)], 1u);
    return b;
}
__device__ __forceinline__ void xcd_barrier_complete(unsigned* bar, unsigned x, unsigned& nloc, unsigned& nx) {
    const unsigned G = gridDim.x * gridDim.y * gridDim.z;
    unsigned sum, cnt, mine, sp = 0u;
    for (;;) {
        sum = 0u; cnt = 0u; mine = 0u;
#pragma unroll
        for (unsigned j = 0; j < 16; ++j) { const unsigned c = xb_ld(&bar[XB_XCNT(j)]); sum += c; cnt += (c > 0u) ? 1u : 0u; mine = (j == x) ? c : mine; }
        if (sum == G) break;
        __builtin_amdgcn_s_sleep(1);
        if ((++sp & 255u) == 0u) { if (xb_ld(&bar[XB_TMO])) break; if (sp > XB_SPIN_CAP) { atomicAdd(&bar[XB_TMO], 1u); break; } }
    }
    nloc = mine > 0u ? mine : 1u; nx = cnt > 0u ? cnt : 1u;
}
__device__ __forceinline__ void xcd_barrier(const XcdBarrier& b) {
    asm volatile("s_waitcnt vmcnt(0)" ::: "memory");
    __syncthreads();
    if (threadIdx.x == 0) {
        unsigned* bar = b.bar;
        __builtin_amdgcn_s_waitcnt(0);
        unsigned nloc = b.st[0], nx = b.st[1];
        if (nloc == 0u) { xcd_barrier_complete(bar, b.x, nloc, nx); b.st[0] = nloc; b.st[1] = nx; }
        const unsigned old = xb_add(&bar[XB_XSUB(b.x)], 1u);
        const unsigned gen = old / nloc;
        if (old + 1u == (gen + 1u) * nloc) {
            __builtin_amdgcn_fence(__ATOMIC_RELEASE, "agent");
            asm volatile("s_waitcnt vmcnt(0)" ::: "memory");
            const unsigned og = xb_add(&bar[XB_TOP], 1u);
            const unsigned tg = og / nx;
            if (og + 1u == (tg + 1u) * nx) xb_add(&bar[XB_TOPGEN], 1u);
            else XB_SPIN(xb_ld(&bar[XB_TOPGEN]) == tg, bar);
            __builtin_amdgcn_fence(__ATOMIC_ACQUIRE, "agent");
            xb_add(&bar[XB_XGEN(b.x)], 1u);
            asm volatile("s_waitcnt vmcnt(0)" ::: "memory");
        } else {
            XB_SPIN(xb_ld(&bar[XB_XGEN(b.x)]) == gen, bar);
            __builtin_amdgcn_fence(__ATOMIC_ACQUIRE, "agent");
            asm volatile("s_waitcnt vmcnt(0)" ::: "memory");
        }
    }
    __syncthreads();
}

struct Args { const float* in[38]; float* out; unsigned char* ws; int ph_lo, ph_hi; };
enum { I_X = 0, I_C, I_CTX, I_CCTX, I_MODW, I_MODB, I_N1G, I_N2G, I_W1, I_W3, I_W2, I_FING, I_EWIN, I_EWOUT, I_LRE, I_LIM, I_LSTEP, I_BRE, I_BIM, I_CRE, I_CIM,
       I_S5D, I_GLUW, I_GLUB, I_DNCW, I_DNALOG, I_DNDT, I_DNNG, I_OWIN, I_OWOUT, I_LCW, I_LCB, I_LWA, I_LBA, I_LWX, I_LBX, I_LLAM, I_RTH };

constexpr int LDS_RING = 131072, LDS_CTL_OFF = 131072, LDS_BYTES = 147456;
constexpr int NW = 8;

DI void transpose_item(const float* W, int ldw, int k0, int n_src0, bf16* WT, int ldk, int dst_row0, LAS float* scr, int lane) {
#pragma unroll 8
    for (int i = 0; i < 32; ++i) { const int kk = 2 * i + (lane >> 5); scr[kk * 33 + (lane & 31)] = W[(size_t)(k0 + kk) * ldw + n_src0 + (lane & 31)]; }
    LDS_WAIT();
    const int c = lane & 7;
#pragma unroll
    for (int j = 0; j < 4; ++j) { const int n = (lane >> 3) + 8 * j; const LAS float* s = scr + (8 * c) * 33 + n;
        u32x4 o; o.x = pk2(s[0 * 33], s[1 * 33]); o.y = pk2(s[2 * 33], s[3 * 33]); o.z = pk2(s[4 * 33], s[5 * 33]); o.w = pk2(s[6 * 33], s[7 * 33]);
        *(u32x4*)(WT + (size_t)(dst_row0 + n) * ldk + k0 + 8 * c) = o; }
    LDS_WAIT();
}
DI void transpose_job(int it, const float* W, int K, int N, bf16* WT, int mode, int add, LAS float* scr, int lane) {
    const int nblk = N / 32, kb = it / nblk, nb = it % nblk, n0 = nb * 32;
    const int dr = mode ? ((n0 >> 7) * 256 + (n0 & 127) + add) : n0;
    transpose_item(W, N, kb * 64, n0, WT, K, dr, scr, lane);
}

__global__ void __launch_bounds__(512, 2) fwd_kernel(Args args) {
    extern __shared__ __attribute__((aligned(16))) unsigned char lds_raw[];
    LAS unsigned char* lds = (LAS unsigned char*)lds_raw;
    const int tid0 = threadIdx.x;
    const int G = gridDim.x, bid = blockIdx.x;
    const int NGW = G * NW;
    unsigned char* ws = args.ws;
    float* MOD = (float*)(ws + WS_MOD);
    float* XC = (float*)(ws + WS_XC);
    bf16* XLb = (bf16*)(ws + WS_BIG + 340 * MiB);
    bf16* Hb = (bf16*)(ws + WS_H);
    bf16* MIX = (bf16*)(ws + WS_MIX);
    unsigned char* BIG = ws + WS_BIG;
    unsigned char* WB = ws + WS_W;
    float* SLAB = (float*)(BIG + 200 * MiB);
    float* T_ABAR = (float*)(ws + WS_TAB); float* T_APOW = (float*)(ws + WS_TAB + 65536); f32x2* T_ROPE = (f32x2*)(ws + WS_TAB + 131072);
    float* T_SPL = (float*)(ws + WS_TAB + 163840);
    float* T_BBR = (float*)(ws + WS_XC); float* T_BBI = (float*)(ws + WS_XC + MiB / 2);
    bf16* T_BBF = (bf16*)(ws + WS_TAB + MiB);
    bf16* T_CF = (bf16*)(ws + WS_TAB + MiB + MiB / 2);

    volatile LAS unsigned* CTLW = (volatile LAS unsigned*)(lds + LDS_CTL_OFF);
    for (int u = tid0; u < (LDS_BYTES - LDS_CTL_OFF) / 4; u += 512) CTLW[u] = 0u;
    __syncthreads();
#if MK_ONE_LAUNCH
    XcdBarrier bar = xcd_barrier_post((unsigned*)(ws + WS_CTL) + 4096, CTLW + 8);
#define SEAM() xcd_barrier(bar)
#else
#define SEAM() do {} while (0)
#endif
    const int lo = args.ph_lo, hi = args.ph_hi;
    int ph = 0;
#define PHASE_BEGIN if (ph >= lo && ph < hi) { int tid = tid0; asm volatile("" : "+v"(tid)); const int lane = tid & 63, wave = __builtin_amdgcn_readfirstlane(tid >> 6), gw = bid * NW + wave; (void)lane; (void)gw;
#define PHASE_END   if (ph + 1 < hi) SEAM(); } ++ph;

    PHASE_BEGIN
    {
        LAS float* sc = (LAS float*)lds;
        LAS float* red = (LAS float*)(lds + 40960);
        if (bid < 96) {
            for (int i = tid; i < 5 * 2048; i += 512) { const int r = i >> 11, k = i & 2047; const float v = r < 4 ? args.in[I_C][r * 2048 + k] : args.in[I_CCTX][k]; sc[i] = siluf_(v); }
            __syncthreads();
            for (int cb = bid; cb < 96; cb += G) {
                const int n0 = cb * 256, layer = n0 / 12288, nn = n0 % 12288;
                const float* W = args.in[I_MODW] + (size_t)layer * 2048 * 12288 + nn + lane * 4;
                float a[5][4];
#pragma unroll
                for (int r = 0; r < 5; ++r)
#pragma unroll
                    for (int j = 0; j < 4; ++j) a[r][j] = 0.f;
                const int kb = wave * 256;
#pragma unroll 8
                for (int k = kb; k < kb + 256; ++k) { const f32x4 w = *(const f32x4*)(W + (size_t)k * 12288);
#pragma unroll
                    for (int r = 0; r < 5; ++r) { const float s = sc[r * 2048 + k];
#pragma unroll
                        for (int j = 0; j < 4; ++j) a[r][j] += s * w[j]; } }
#pragma unroll
                for (int r = 0; r < 5; ++r)
#pragma unroll
                    for (int j = 0; j < 4; ++j) red[(wave * 5 + r) * 256 + lane * 4 + j] = a[r][j];
                __syncthreads();
                for (int i = tid; i < 5 * 256; i += 512) { const int r = i >> 8, cc = i & 255; float s = args.in[I_MODB][layer * 12288 + nn + cc];
#pragma unroll
                    for (int w = 0; w < 8; ++w) s += red[(w * 5 + r) * 256 + cc];
                    MOD[(size_t)(layer * 5 + r) * 12288 + nn + cc] = s; }
                __syncthreads();
            }
        }
        for (int i = bid * 512 + tid; i < 2 * 64 * 64 * 16; i += G * 512) {
            const int s = i & 15, p = (i >> 4) & 63, g = (i >> 10) & 63, d = i >> 16;
            const int ip = (d * 64 + g) * 64 + p;
            const float lre = fminf(args.in[I_LRE][ip], -1e-4f), lim = args.in[I_LIM][ip];
            const float dt = expf(args.in[I_LSTEP][d * 64 + g]);
            const float mag = expf(lre * dt); const float ar = mag * cosf(lim * dt), ai = mag * sinf(lim * dt);
            const float nr = ar - 1.f, ni = ai, den = lre * lre + lim * lim;
            const float cre = (nr * lre + ni * lim) / den, cim = (ni * lre - nr * lim) / den;
            const float br = args.in[I_BRE][(size_t)ip * 16 + s], bi = args.in[I_BIM][(size_t)ip * 16 + s];
            T_BBR[(size_t)ip * 16 + s] = cre * br - cim * bi; T_BBI[(size_t)ip * 16 + s] = cre * bi + cim * br;
            T_BBF[((size_t)(d * 64 + g) * 128 + p) * 16 + s] = (bf16)f2bf(cre * br - cim * bi); T_BBF[((size_t)(d * 64 + g) * 128 + 64 + p) * 16 + s] = (bf16)f2bf(cre * bi + cim * br);
            T_CF[((size_t)(d * 64 + g) * 16 + s) * 128 + p] = (bf16)f2bf(args.in[I_CRE][((size_t)(d * 64 + g) * 16 + s) * 64 + p]); T_CF[((size_t)(d * 64 + g) * 16 + s) * 128 + 64 + p] = (bf16)f2bf(-args.in[I_CIM][((size_t)(d * 64 + g) * 16 + s) * 64 + p]);
            if (s == 0) { T_ABAR[ip * 2] = ar; T_ABAR[ip * 2 + 1] = ai; float pr = ar, pi = ai;
#pragma unroll
                for (int q = 0; q < 6; ++q) { const float tr = pr * pr - pi * pi, ti = 2.f * pr * pi; pr = tr; pi = ti; }
                T_APOW[ip * 2] = pr; T_APOW[ip * 2 + 1] = pi; }
        }
        for (int i = bid * 512 + tid; i < 4096; i += G * 512) { const int p = i >> 6, f = i & 63; const float inv = powf(10000.f, -(float)f / 64.f); const float ang = (float)p * inv;
            f32x2 v; v.x = cosf(ang); v.y = sinf(ang); T_ROPE[i] = v; }
        for (int i = bid * 512 + tid; i < 2048; i += G * 512) T_SPL[i] = -8.f * softplusf_(-args.in[I_LLAM][i]);
        __syncthreads();
        LAS float* scr = (LAS float*)(lds + wave * 16384);
        constexpr int J0 = 32 * 161, J1 = 32 * 64, J2 = 16 * 32, J3 = 32 * 176, J4 = J3, J5 = 88 * 64;
        for (int it = gw; it < J0 + J1 + J2 + J3 + J4 + J5; it += NGW) {
            int r = it;
            if (r < J0) { transpose_job(r, args.in[I_EWIN], 2048, 5152, (bf16*)(WB + W_IN), 0, 0, scr, lane); continue; } r -= J0;
            if (r < J1) { transpose_job(r, args.in[I_EWOUT], 2048, 2048, (bf16*)(WB + W_OUT), 0, 0, scr, lane); continue; } r -= J1;
            if (r < J2) { transpose_job(r, args.in[I_GLUW], 1024, 1024, (bf16*)(WB + W_GLU), 0, 0, scr, lane); continue; } r -= J2;
            if (r < J3) { transpose_job(r, args.in[I_W1], 2048, 5632, (bf16*)(WB + W_UP), 1, 0, scr, lane); continue; } r -= J3;
            if (r < J4) { transpose_job(r, args.in[I_W3], 2048, 5632, (bf16*)(WB + W_UP), 1, 128, scr, lane); continue; } r -= J4;
            transpose_job(r, args.in[I_W2], 5632, 2048, (bf16*)(WB + W_DN), 0, 0, scr, lane);
        }
    }
    PHASE_END

#define ADALN(LAYER, WHICH, SRCBF, SRC_L, SRC_C, LATONLY, SLABP, SGATE) \
    for (int R = gw; R < MROWS; R += NGW) { const int b = R / SROW, s = R % SROW; const bool cx = s < CTX; if ((LATONLY) && cx) continue; \
        const float* md = MOD + (size_t)((LAYER) * 5 + (cx ? 4 : b)) * 12288 + (WHICH) * 3 * 2048; \
        const float* gn = args.in[(WHICH) ? I_N2G : I_N1G] + (LAYER) * 2048; \
        f32x4 v[8]; float ss = 0.f; \
        if ((SRCBF) && !cx) { const bf16* srcb = (const bf16*)(SRC_L) + ((size_t)b * SEQ + (s - CTX)) * DM; \
            _Pragma("unroll") for (int j = 0; j < 8; ++j) { const u32x2 w = *(const u32x2*)(srcb + lane * 4 + j * 256); v[j] = (f32x4){lo16(w.x), hi16(w.x), lo16(w.y), hi16(w.y)}; } } \
        else { const float* src = cx ? (SRC_C) + ((size_t)b * CTX + s) * DM : (const float*)(SRC_L) + ((size_t)b * SEQ + (s - CTX)) * DM; \
            _Pragma("unroll") for (int j = 0; j < 8; ++j) v[j] = *(const f32x4*)(src + lane * 4 + j * 256); } \
        if ((SLABP) != nullptr && cx) { const size_t crow = (size_t)b * CTX + s; \
            _Pragma("unroll") for (int j = 0; j < 8; ++j) { const int c = lane * 4 + j * 256; f32x4 a = (f32x4){0.f, 0.f, 0.f, 0.f}; \
                _Pragma("unroll") for (int sp = 0; sp < 8; ++sp) a += *(const f32x4*)((SLABP) + ((size_t)sp * 1024 + crow) * DM + c); \
                v[j] = v[j] + *(const f32x4*)((SGATE) + c) * a; *(f32x4*)(XC + crow * DM + c) = v[j]; } } \
        _Pragma("unroll") for (int j = 0; j < 8; ++j) ss += (v[j][0] * v[j][0] + v[j][1] * v[j][1]) + (v[j][2] * v[j][2] + v[j][3] * v[j][3]); \
        const float rstd = 1.f / sqrtf(wave_sum(ss) * (1.f / DM) + EPS); \
        _Pragma("unroll") for (int j = 0; j < 8; ++j) { const int c = lane * 4 + j * 256; const f32x4 gg = *(const f32x4*)(gn + c), sh = *(const f32x4*)(md + c), sl = *(const f32x4*)(md + 2048 + c); \
            const f32x4 o = v[j] * rstd * gg * (sl + 1.f) + sh; u32x2 w; w.x = pk2(o[0], o[1]); w.y = pk2(o[2], o[3]); *(u32x2*)(Hb + (size_t)R * DM + c) = w; } }

    PHASE_BEGIN
    ADALN(0, 0, false, args.in[I_X], args.in[I_CTX], false, (const float*)nullptr, (const float*)nullptr)
    PHASE_END

    PHASE_BEGIN
    { pg8::Gemm g{Hb, (const bf16*)(WB + W_IN), DM, DM, DM}; pg8::StaticOrder S; S.init(68, 21, G, bid, 0);
      EpiIn0 E{(bf16*)(BIG + B_IN0), (float*)(BIG + B_AB)};
      pg8::gemm_phase<EpiIn0>(lds, g, S, E); }
    PHASE_END

#define S5_PASS(READOUT) { \
        const bf16* IN0 = (const bf16*)(BIG + B_IN0); \
        LAS float* BU = (LAS float*)(lds + wave * 12800); LAS unsigned char* HB = lds + wave * 12800 + 8448; \
        const int r = lane & 15, q = lane >> 4; \
        const int NU = (READOUT) ? NB * 64 * NCH : NB * 64 * 2 * NCH; \
        for (int unit = gw; unit < NU; unit += NGW) { \
            const int c = unit % NCH; int rest = unit / NCH; const int g = rest & 63; rest >>= 6; \
            int dsel = 0, b; if (READOUT) b = rest; else { dsel = rest & 1; b = rest >> 1; } \
            const int R0 = b * SROW + c * 64; \
            bf16x8 Uf[4]; \
            _Pragma("unroll") for (int tt = 0; tt < 4; ++tt) { Uf[tt] = (bf16x8){0, 0, 0, 0, 0, 0, 0, 0}; if (q < 2) Uf[tt] = *(const bf16x8*)(IN0 + (size_t)(R0 + 16 * tt + r) * IN0_LD + g * 16 + 8 * q); } \
            f32x4 Y[4]; \
            _Pragma("unroll") for (int tt = 0; tt < 4; ++tt) Y[tt] = (f32x4){0.f, 0.f, 0.f, 0.f}; \
            for (int dd = 0; dd < ((READOUT) ? 2 : 1); ++dd) { \
                const int dir = (READOUT) ? dd : dsel; \
                bf16x8 Bf[8], Cf[4]; \
                _Pragma("unroll") for (int pt = 0; pt < 8; ++pt) { Bf[pt] = (bf16x8){0, 0, 0, 0, 0, 0, 0, 0}; if (q < 2) Bf[pt] = *(const bf16x8*)(T_BBF + ((size_t)(dir * 64 + g) * 128 + 16 * pt + r) * 16 + 8 * q); } \
                if (READOUT) { _Pragma("unroll") for (int ks = 0; ks < 4; ++ks) Cf[ks] = *(const bf16x8*)(T_CF + ((size_t)(dir * 64 + g) * 16 + r) * 128 + 32 * ks + 8 * q); } \
                const int ip = (dir * 64 + g) * 64 + lane; \
                const float ar = T_ABAR[ip * 2], ai = T_ABAR[ip * 2 + 1]; \
                float hr = 0.f, hi = 0.f; \
                if (READOUT) { const float* st = (const float*)(BIG + B_S5S) + ((((size_t)(b * 64 + g) * 2 + dir) * NCH + c) * 64 + lane) * 2; hr = st[0]; hi = st[1]; } \
                for (int ti = 0; ti < 4; ++ti) { const int tt = dir ? 3 - ti : ti; \
                    _Pragma("unroll") for (int pt = 0; pt < 8; ++pt) { const f32x4 cc = MFMA16(Uf[tt], Bf[pt], ((f32x4){0.f, 0.f, 0.f, 0.f})); \
                        _Pragma("unroll") for (int jj = 0; jj < 4; ++jj) BU[(4 * q + jj) * 132 + 16 * pt + r] = cc[jj]; } \
                    LDS_WAIT(); \
                    _Pragma("unroll") for (int i = 0; i < 16; ++i) { const int tl = dir ? 15 - i : i; \
                        const float bur = BU[tl * 132 + lane], bui = BU[tl * 132 + 64 + lane]; \
                        const float nr = ar * hr - ai * hi + bur, ni = ar * hi + ai * hr + bui; hr = nr; hi = ni; \
                        if (READOUT) { *(LAS bf16*)(HB + tl * 272 + lane * 2) = (bf16)f2bf(hr); *(LAS bf16*)(HB + tl * 272 + 128 + lane * 2) = (bf16)f2bf(hi); } } \
                    if (READOUT) { LDS_WAIT(); \
                        _Pragma("unroll") for (int ks = 0; ks < 4; ++ks) Y[tt] = MFMA16(frag_rows(HB, 272, 0, 32 * ks, r, q), Cf[ks], Y[tt]); } \
                    LDS_WAIT(); \
                } \
                if (!(READOUT)) { float* e = (float*)(BIG + B_S5E) + ((((size_t)(b * 64 + g) * 2 + dir) * NCH + c) * 64 + lane) * 2; e[0] = hr; e[1] = hi; } \
            } \
            if (READOUT) { const float dsk = args.in[I_S5D][g * 16 + r]; \
                _Pragma("unroll") for (int tt = 0; tt < 4; ++tt) \
                    _Pragma("unroll") for (int jj = 0; jj < 4; ++jj) { const size_t R = (size_t)(R0 + 16 * tt + 4 * q + jj); const float uu = bf2f(IN0[R * IN0_LD + g * 16 + r]); \
                        ((bf16*)(BIG + B_S5Y))[R * 1024 + g * 16 + r] = (bf16)f2bf(gelu_tanh(Y[tt][jj] + dsk * uu)); } } \
        } }

#define S5_PASS_OLD(READOUT) { \
        const bf16* IN0 = (const bf16*)(BIG + B_IN0); \
        LAS float* ubuf = (LAS float*)(lds + wave * 12288); LAS float* ybuf = ubuf + 1024; LAS float* hbuf = ubuf + 2048; \
        const int NU = (READOUT) ? NB * 64 * NCH : NB * 64 * 2 * NCH; \
        for (int unit = gw; unit < NU; unit += NGW) { \
            const int c = unit % NCH; int rest = unit / NCH; const int g = rest & 63; rest >>= 6; \
            int dsel = 0, b; if (READOUT) b = rest; else { dsel = rest & 1; b = rest >> 1; } \
            const int R0 = b * SROW + c * 64; \
            { const u32x4* up = (const u32x4*)(IN0 + (size_t)(R0 + lane) * IN0_LD + g * 16); const u32x4 w0 = up[0], w1 = up[1]; \
              f32x4 f; f = (f32x4){lo16(w0.x), hi16(w0.x), lo16(w0.y), hi16(w0.y)}; *(LAS f32x4*)(ubuf + lane * 16) = f; \
              f = (f32x4){lo16(w0.z), hi16(w0.z), lo16(w0.w), hi16(w0.w)}; *(LAS f32x4*)(ubuf + lane * 16 + 4) = f; \
              f = (f32x4){lo16(w1.x), hi16(w1.x), lo16(w1.y), hi16(w1.y)}; *(LAS f32x4*)(ubuf + lane * 16 + 8) = f; \
              f = (f32x4){lo16(w1.z), hi16(w1.z), lo16(w1.w), hi16(w1.w)}; *(LAS f32x4*)(ubuf + lane * 16 + 12) = f; } \
            LDS_WAIT(); \
            for (int dd = 0; dd < ((READOUT) ? 2 : 1); ++dd) { \
                const int dir = (READOUT) ? dd : dsel; \
                const int ip = (dir * 64 + g) * 64 + lane; \
                float bbr[16], bbi[16]; \
                _Pragma("unroll") for (int q = 0; q < 4; ++q) { const f32x4 x = *(const f32x4*)(T_BBR + (size_t)ip * 16 + 4 * q), y = *(const f32x4*)(T_BBI + (size_t)ip * 16 + 4 * q); \
                    _Pragma("unroll") for (int j = 0; j < 4; ++j) { bbr[4 * q + j] = x[j]; bbi[4 * q + j] = y[j]; } } \
                const float ar = T_ABAR[ip * 2], ai = T_ABAR[ip * 2 + 1]; \
                float cr[16], ci[16]; const int so = lane & 15, pq = lane >> 4; \
                if (READOUT) { const size_t co = ((size_t)(dir * 64 + g) * 16 + so) * 64 + pq * 16; \
                    _Pragma("unroll") for (int q = 0; q < 4; ++q) { const f32x4 x = *(const f32x4*)(args.in[I_CRE] + co + 4 * q), y = *(const f32x4*)(args.in[I_CIM] + co + 4 * q); \
                        _Pragma("unroll") for (int j = 0; j < 4; ++j) { cr[4 * q + j] = x[j]; ci[4 * q + j] = y[j]; } } } \
                float hr = 0.f, hi = 0.f; \
                if (READOUT) { const float* st = (const float*)(BIG + B_S5S) + ((((size_t)(b * 64 + g) * 2 + dir) * NCH + c) * 64 + lane) * 2; hr = st[0]; hi = st[1]; } \
                for (int tb = 0; tb < 16; ++tb) { \
                    _Pragma("unroll") for (int tt = 0; tt < 4; ++tt) { const int ti = tb * 4 + tt, t = dir ? 63 - ti : ti; \
                        float bur = 0.f, bui = 0.f; \
                        _Pragma("unroll") for (int q = 0; q < 4; ++q) { const f32x4 uu = *(const LAS f32x4*)(ubuf + t * 16 + 4 * q); \
                            _Pragma("unroll") for (int j = 0; j < 4; ++j) { bur += bbr[4 * q + j] * uu[j]; bui += bbi[4 * q + j] * uu[j]; } } \
                        const float nr = ar * hr - ai * hi + bur, ni = ar * hi + ai * hr + bui; hr = nr; hi = ni; \
                        if (READOUT) { hbuf[tt * 128 + lane] = hr; hbuf[tt * 128 + 64 + lane] = hi; } } \
                    if (READOUT) { LDS_WAIT(); \
                        _Pragma("unroll") for (int tt = 0; tt < 4; ++tt) { const int ti = tb * 4 + tt, t = dir ? 63 - ti : ti; float a = 0.f; \
                            _Pragma("unroll") for (int q = 0; q < 4; ++q) { const f32x4 xr = *(const LAS f32x4*)(hbuf + tt * 128 + pq * 16 + 4 * q), xi = *(const LAS f32x4*)(hbuf + tt * 128 + 64 + pq * 16 + 4 * q); \
                                _Pragma("unroll") for (int j = 0; j < 4; ++j) a += xr[j] * cr[4 * q + j] - xi[j] * ci[4 * q + j]; } \
                            a += __shfl_xor(a, 16); a += __shfl_xor(a, 32); \
                            if (pq == 0) { if (dd == 0) ybuf[t * 16 + so] = a; else ybuf[t * 16 + so] += a; } } \
                        LDS_WAIT(); } \
                } \
                if (!(READOUT)) { float* e = (float*)(BIG + B_S5E) + ((((size_t)(b * 64 + g) * 2 + dir) * NCH + c) * 64 + lane) * 2; e[0] = hr; e[1] = hi; } \
            } \
            if (READOUT) { LDS_WAIT(); float o[16]; \
                _Pragma("unroll") for (int q = 0; q < 4; ++q) { const f32x4 yv = *(const LAS f32x4*)(ybuf + lane * 16 + 4 * q), uv = *(const LAS f32x4*)(ubuf + lane * 16 + 4 * q); const f32x4 dv = *(const f32x4*)(args.in[I_S5D] + g * 16 + 4 * q); \
                    _Pragma("unroll") for (int j = 0; j < 4; ++j) o[4 * q + j] = gelu_tanh(yv[j] + dv[j] * uv[j]); } \
                u32x4 w0, w1; w0.x = pk2(o[0], o[1]); w0.y = pk2(o[2], o[3]); w0.z = pk2(o[4], o[5]); w0.w = pk2(o[6], o[7]); w1.x = pk2(o[8], o[9]); w1.y = pk2(o[10], o[11]); w1.z = pk2(o[12], o[13]); w1.w = pk2(o[14], o[15]); \
                u32x4* yp = (u32x4*)((bf16*)(BIG + B_S5Y) + (size_t)(R0 + lane) * 1024 + g * 16); yp[0] = w0; yp[1] = w1; LDS_WAIT(); } \
        } }

    PHASE_BEGIN
    S5_PASS_OLD(false)
    {
        const bf16* IN0 = (const bf16*)(BIG + B_IN0); const float* AB = (const float*)(BIG + B_AB);
        bf16* DQ = (bf16*)(BIG + B_DNQ); bf16* DK = (bf16*)(BIG + B_DNK); bf16* DV = (bf16*)(BIG + B_DNV);
        float* DG = (float*)(BIG + B_DNG); float* DBt = (float*)(BIG + B_DNB);
        const float* cw = args.in[I_DNCW];
        int cur_combo = -1; f32x4 wv[8];
        for (int item = gw; item < MROWS * 6; item += NGW) {
            const int combo = item / MROWS, R = item - combo * MROWS, part = combo >> 1, hq = combo & 1;
            const int b = R / SROW, sx = R - b * SROW;
            const int seg_lo = sx < CTX ? 0 : CTX, seg_hi = sx < CTX ? CTX : SROW;
            const int cidx = part * 1024 + hq * 512 + lane * 8;
            if (combo != cur_combo) { cur_combo = combo;
#pragma unroll
                for (int e = 0; e < 8; ++e) wv[e] = *(const f32x4*)(cw + (size_t)(cidx + e) * 4); }
            float acc[8];
#pragma unroll
            for (int e = 0; e < 8; ++e) acc[e] = 0.f;
#pragma unroll
            for (int j = 0; j < 4; ++j) { const int sj = sx + j - 2;
                if (sj >= seg_lo && sj < seg_hi) { const u32x4 w = *(const u32x4*)(IN0 + (size_t)(b * SROW + sj) * IN0_LD + 1024 + cidx);
                    acc[0] += wv[0][j] * lo16(w.x); acc[1] += wv[1][j] * hi16(w.x); acc[2] += wv[2][j] * lo16(w.y); acc[3] += wv[3][j] * hi16(w.y);
                    acc[4] += wv[4][j] * lo16(w.z); acc[5] += wv[5][j] * hi16(w.z); acc[6] += wv[6][j] * lo16(w.w); acc[7] += wv[7][j] * hi16(w.w); } }
            float ss = 0.f;
#pragma unroll
            for (int e = 0; e < 8; ++e) { acc[e] = acc[e] * __builtin_amdgcn_rcpf(1.f + __expf(-acc[e])); ss += acc[e] * acc[e]; }
            ss += __shfl_xor(ss, 1); ss += __shfl_xor(ss, 2); ss += __shfl_xor(ss, 4); ss += __shfl_xor(ss, 8);
            const float sc = part == 0 ? 0.08838834764831845f / sqrtf(ss + EPS) : (part == 1 ? 1.f / sqrtf(ss + EPS) : 1.f);
            u32x4 o; o.x = pk2(acc[0] * sc, acc[1] * sc); o.y = pk2(acc[2] * sc, acc[3] * sc); o.z = pk2(acc[4] * sc, acc[5] * sc); o.w = pk2(acc[6] * sc, acc[7] * sc);
            bf16* dst = part == 0 ? DQ : (part == 1 ? DK : DV);
            *(u32x4*)(dst + (size_t)R * 1024 + hq * 512 + lane * 8) = o;
        }
        for (int i = bid * 512 + tid; i < MROWS * 16; i += G * 512) { const int R = i >> 4, l16 = i & 15;
            const float araw = AB[(size_t)R * 32 + l16], braw = AB[(size_t)R * 32 + 16 + l16];
            DG[i] = -expf(args.in[I_DNALOG][l16]) * softplusf_(araw + args.in[I_DNDT][l16]);
            DBt[i] = sigmoidf_(braw); }
    }
    PHASE_END

    PHASE_BEGIN
    {
        for (int i = bid * 512 + tid; i < NB * 64 * 2 * 64; i += G * 512) {
            const int p = i & 63, dir = (i >> 6) & 1, bg = i >> 7, g = bg & 63;
            const int ip = (dir * 64 + g) * 64 + p; const float pr = T_APOW[ip * 2], pi = T_APOW[ip * 2 + 1];
            const float* E = (const float*)(BIG + B_S5E) + ((size_t)(bg * 2 + dir) * NCH) * 128 + p * 2;
            float* St = (float*)(BIG + B_S5S) + ((size_t)(bg * 2 + dir) * NCH) * 128 + p * 2;
            float sr = 0.f, si = 0.f;
            for (int k = 0; k < NCH; ++k) { const int c = dir == 0 ? k : (k < 4 ? 3 - k : 71 - k);
                St[c * 128] = sr; St[c * 128 + 1] = si; const float er = E[c * 128], ei = E[c * 128 + 1];
                const float nr = pr * sr - pi * si + er, ni = pr * si + pi * sr + ei; sr = nr; si = ni; }
        }
        {
            const bf16* DK = (const bf16*)(BIG + B_DNK); const float* DG = (const float*)(BIG + B_DNG); const float* DBt = (const float*)(BIG + B_DNB);
            bf16* TINV = (bf16*)((unsigned char*)MIX + MIX_TINV); bf16* WT = Hb; float* GCUM = (float*)(BIG + B_GCUM);
            constexpr int KC = 0, KB = 17408, KG = 34816, PA = 52224, PB = 61440, TA = 70656, TB = 79872, LO = 36864, WSo = 52224, GCo = 125952, BTo = 126208, RS = 272, PS = 144;
            const int r = lane & 15, q = lane >> 4, qq = r >> 2, pp = r & 3, it = wave >> 1, nh = wave & 1;
            LAS float* GC = (LAS float*)(lds + GCo); LAS float* BT = (LAS float*)(lds + BTo);
#define DN_ROW(n, row) ((size_t)b * SROW + (dir == 0 ? ((n) * 64 + (row)) : (((n) * 64 + (row)) < CTX ? CTX - 1 - ((n) * 64 + (row)) : SROW + CTX - 1 - ((n) * 64 + (row)))))
            for (int unit = bid; unit < NB * 8 * 2 * NCH; unit += G) {
                const int n = unit % NCH; int rest = unit / NCH; const int dir = rest & 1; rest >>= 1; const int h = rest & 7, b = rest >> 3;
                u32x4 kreg[2];
#pragma unroll
                for (int k = 0; k < 2; ++k) { const int id = tid + 512 * k, row = id >> 4, cp = id & 15; kreg[k] = *(const u32x4*)(DK + DN_ROW(n, row) * 1024 + h * 128 + cp * 8); }
                if (wave == 0) { const size_t R = DN_ROW(n, lane); float g = DG[R * 16 + dir * 8 + h]; const float bt = DBt[R * 16 + dir * 8 + h];
#pragma unroll
                    for (int o = 1; o < 64; o <<= 1) { const float t = __shfl_up(g, o); if (lane >= o) g += t; }
                    GC[lane] = g; BT[lane] = bt; GCUM[(size_t)unit * 64 + lane] = g; }
                __syncthreads();
#pragma unroll
                for (int k = 0; k < 2; ++k) { const int id = tid + 512 * k, row = id >> 4, cp = id & 15; const float bt = BT[row], bg = bt * __expf(GC[row]);
                    const u32x4 w = kreg[k];
                    *(LAS u32x4*)(lds + KC + row * RS + cp * 16) = w;
                    u32x4 x; x.x = pk2(lo16(w.x) * bt, hi16(w.x) * bt); x.y = pk2(lo16(w.y) * bt, hi16(w.y) * bt); x.z = pk2(lo16(w.z) * bt, hi16(w.z) * bt); x.w = pk2(lo16(w.w) * bt, hi16(w.w) * bt);
                    *(LAS u32x4*)(lds + KB + row * RS + cp * 16) = x;
                    x.x = pk2(lo16(w.x) * bg, hi16(w.x) * bg); x.y = pk2(lo16(w.y) * bg, hi16(w.y) * bg); x.z = pk2(lo16(w.z) * bg, hi16(w.z) * bg); x.w = pk2(lo16(w.w) * bg, hi16(w.w) * bg);
                    *(LAS u32x4*)(lds + KG + row * RS + cp * 16) = x; }
                __syncthreads();
#pragma unroll
                for (int e = 0; e < 2; ++e) { const int jt = 2 * nh + e; f32x4 c = (f32x4){0.f, 0.f, 0.f, 0.f};
                    if (jt <= it) {
#pragma unroll
                        for (int ks = 0; ks < 4; ++ks) c = MFMA16(frag_rows(lds + KC, RS, 16 * jt, 32 * ks, r, q), frag_rows(lds + KB, RS, 16 * it, 32 * ks, r, q), c);
                        const float gi = GC[16 * it + r]; const f32x4 gj = *(const LAS f32x4*)(GC + 16 * jt + 4 * q);
#pragma unroll
                        for (int jj = 0; jj < 4; ++jj) c[jj] = (16 * jt + 4 * q + jj < 16 * it + r) ? -c[jj] * __expf(gi - gj[jj]) : 0.f; }
                    st_hl(lds + PA + (16 * it + r) * PS + (16 * jt + 4 * q) * 2, LO, c);
                    if (jt == it) {
#pragma unroll
                        for (int jj = 0; jj < 4; ++jj) if (4 * q + jj == r) c[jj] = 1.f; }
                    st_hl(lds + TA + (16 * it + r) * PS + (16 * jt + 4 * q) * 2, LO, c); }
                __syncthreads();
#pragma unroll
                for (int st = 1; st <= 6; ++st) {
                    LAS unsigned char* Pc = lds + ((st & 1) ? PA : PB); LAS unsigned char* Pn = lds + ((st & 1) ? PB : PA);
                    LAS unsigned char* Tc = lds + ((st & 1) ? TB : TA); LAS unsigned char* Tn = lds + ((st & 1) ? TA : TB);
                    if (st == 1) { Tc = lds + TA; }
#pragma unroll
                    for (int e = 0; e < 2; ++e) { const int nt = 2 * nh + e;
                        if (st <= 5) { f32x4 c = (f32x4){0.f, 0.f, 0.f, 0.f};
#pragma unroll
                            for (int kb = 0; kb < 2; ++kb) c = mm3(c, frag_tr(Pc, PS, 32 * kb, 16 * nt, q, qq, pp), frag_tr(Pc + LO, PS, 32 * kb, 16 * nt, q, qq, pp), frag_rows(Pc, PS, 16 * it, 32 * kb, r, q), frag_rows(Pc + LO, PS, 16 * it, 32 * kb, r, q));
                            st_hl(Pn + (16 * it + r) * PS + (16 * nt + 4 * q) * 2, LO, c); }
                        if (st >= 2) { const u32x2 t0 = *(const LAS u32x2*)(Tc + (16 * it + r) * PS + (16 * nt + 4 * q) * 2), t1 = *(const LAS u32x2*)(Tc + LO + (16 * it + r) * PS + (16 * nt + 4 * q) * 2);
                            f32x4 c = (f32x4){lo16(t0.x) + lo16(t1.x), hi16(t0.x) + hi16(t1.x), lo16(t0.y) + lo16(t1.y), hi16(t0.y) + hi16(t1.y)};
#pragma unroll
                            for (int kb = 0; kb < 2; ++kb) c = mm3(c, frag_tr(Pc, PS, 32 * kb, 16 * nt, q, qq, pp), frag_tr(Pc + LO, PS, 32 * kb, 16 * nt, q, qq, pp), frag_rows(Tc, PS, 16 * it, 32 * kb, r, q), frag_rows(Tc + LO, PS, 16 * it, 32 * kb, r, q));
                            st_hl(Tn + (16 * it + r) * PS + (16 * nt + 4 * q) * 2, LO, c); }
                    }
                    __syncthreads();
                }
#pragma unroll
                for (int e = 0; e < 4; ++e) { const int nt = 4 * nh + e; f32x4 c = (f32x4){0.f, 0.f, 0.f, 0.f};
#pragma unroll
                    for (int kb = 0; kb < 2; ++kb) c = MFMA16(frag_tr(lds + KG, RS, 32 * kb, 16 * nt, q, qq, pp), frag_rows(lds + TB, PS, 16 * it, 32 * kb, r, q), c);
                    u32x2 w; w.x = pk2(-c[0], -c[1]); w.y = pk2(-c[2], -c[3]); *(LAS u32x2*)(lds + WSo + (16 * it + r) * RS + (16 * nt + 4 * q) * 2) = w; }
                __syncthreads();
#pragma unroll
                for (int k = 0; k < 2; ++k) { const int id = tid + 512 * k, row = id >> 4, cp = id & 15; *(u32x4*)(WT + ((size_t)unit * 64 + row) * 128 + cp * 8) = *(const LAS u32x4*)(lds + WSo + row * RS + cp * 16); }
                { const int row = tid >> 3, cp = tid & 7; *(u32x4*)(TINV + ((size_t)unit * 64 + row) * 64 + cp * 8) = *(const LAS u32x4*)(lds + TB + row * PS + cp * 16); }
            }
        }
    }
    PHASE_END

    PHASE_BEGIN
    {
        const bf16* DQ = (const bf16*)(BIG + B_DNQ); const bf16* DK = (const bf16*)(BIG + B_DNK); const bf16* DV = (const bf16*)(BIG + B_DNV);
        const float* DBt = (const float*)(BIG + B_DNB); const bf16* TINV = (const bf16*)((unsigned char*)MIX + MIX_TINV); const bf16* WT = Hb; const float* GCUM = (const float*)(BIG + B_GCUM);
        constexpr int QC0 = 0, KC0 = 17408, QC1 = 34816, KC1 = 52224, WC = 69632, TI = 87040, VB = 96256, VN = 101376, VD = 105984, ST0 = 110592, ST1 = 119296, GS0 = 128000, GS1 = 128768, RS = 272, PS = 144, VBS = 80;
        const int r = lane & 15, q = lane >> 4, qq = r >> 2, pp = r & 3, it = wave >> 1, ct = wave & 1;
        for (int unit = bid; unit < NB * 8 * 2 * 4; unit += G) {
            const int sl = unit & 3, dir = (unit >> 2) & 1, h = (unit >> 3) & 7, b = unit >> 6;
            const size_t ubase = (size_t)((b * 8 + h) * 2 + dir) * NCH;
            bf16* DO = (bf16*)(BIG + (dir ? B_DNO1 : B_DNO0));
            f32x4 Sacc[2] = {(f32x4){0.f, 0.f, 0.f, 0.f}, (f32x4){0.f, 0.f, 0.f, 0.f}};
            u32x4 rq[2], rk[2], rw[2], rt, rv; float rbeta = 0.f, rgc = 0.f;
#define DNB_LOAD(n) do { _Pragma("unroll") for (int k = 0; k < 2; ++k) { const int id = tid + 512 * k, row = id >> 4, cp = id & 15; const size_t R = DN_ROW(n, row); \
                    rq[k] = *(const u32x4*)(DQ + R * 1024 + h * 128 + cp * 8); rk[k] = *(const u32x4*)(DK + R * 1024 + h * 128 + cp * 8); \
                    rw[k] = *(const u32x4*)(WT + ((ubase + (n)) * 64 + row) * 128 + cp * 8); } \
                { const int row = tid >> 3, cp = tid & 7; rt = *(const u32x4*)(TINV + ((ubase + (n)) * 64 + row) * 64 + cp * 8); } \
                if (tid < 256) { const int row = tid >> 2, cp = tid & 3; const size_t R = DN_ROW(n, row); rv = *(const u32x4*)(DV + R * 1024 + h * 128 + sl * 32 + cp * 8); rbeta = DBt[R * 16 + dir * 8 + h]; } \
                if (tid < 64) rgc = GCUM[(ubase + (n)) * 64 + tid]; } while (0)
#define DNB_STAGE(QCo, KCo, GSo) do { _Pragma("unroll") for (int k = 0; k < 2; ++k) { const int id = tid + 512 * k, row = id >> 4, cp = id & 15; \
                    *(LAS u32x4*)(lds + (QCo) + row * RS + cp * 16) = rq[k]; *(LAS u32x4*)(lds + (KCo) + row * RS + cp * 16) = rk[k]; *(LAS u32x4*)(lds + WC + row * RS + cp * 16) = rw[k]; } \
                { const int row = tid >> 3, cp = tid & 7; *(LAS u32x4*)(lds + TI + row * PS + cp * 16) = rt; } \
                if (tid < 256) { const int row = tid >> 2, cp = tid & 3; u32x4 x; x.x = pk2(lo16(rv.x) * rbeta, hi16(rv.x) * rbeta); x.y = pk2(lo16(rv.y) * rbeta, hi16(rv.y) * rbeta); \
                    x.z = pk2(lo16(rv.z) * rbeta, hi16(rv.z) * rbeta); x.w = pk2(lo16(rv.w) * rbeta, hi16(rv.w) * rbeta); *(LAS u32x4*)(lds + VB + row * VBS + cp * 16) = x; } \
                if (tid < 64) { const float gl = __shfl(rgc, 63); LAS float* gs = (LAS float*)(lds + (GSo)); gs[tid] = rgc; gs[64 + tid] = __expf(rgc); gs[128 + tid] = __expf(gl - rgc); } } while (0)
            for (int i = tid; i < 8704 / 4; i += 512) ((LAS unsigned*)(lds + ST0))[i] = 0u;
            DNB_LOAD(0);
            DNB_STAGE(QC0, KC0, GS0);
            if (NCH > 1) DNB_LOAD(1);
            __syncthreads();
            for (int n = 0; n < NCH; ++n) {
                LAS unsigned char* QC = lds + ((n & 1) ? QC1 : QC0); LAS unsigned char* KC = lds + ((n & 1) ? KC1 : KC0);
                LAS float* GS = (LAS float*)(lds + ((n & 1) ? GS1 : GS0));
                LAS unsigned char* STc = lds + ((n & 1) ? ST1 : ST0); LAS unsigned char* STn = lds + ((n & 1) ? ST0 : ST1);
                { f32x4 c = (f32x4){0.f, 0.f, 0.f, 0.f};
#pragma unroll
                  for (int kb = 0; kb < 2; ++kb) c = MFMA16(frag_rows(lds + TI, PS, 16 * it, 32 * kb, r, q), frag_tr(lds + VB, VBS, 32 * kb, 16 * ct, q, qq, pp), c);
#pragma unroll
                  for (int ks = 0; ks < 4; ++ks) c = MFMA16(frag_rows(lds + WC, RS, 16 * it, 32 * ks, r, q), frag_rows(STc, RS, 16 * ct, 32 * ks, r, q), c);
                  const f32x4 ed = *(const LAS f32x4*)(GS + 128 + 16 * it + 4 * q);
                  u32x2 w; w.x = pk2(c[0], c[1]); w.y = pk2(c[2], c[3]); *(LAS u32x2*)(lds + VN + (16 * ct + r) * PS + (16 * it + 4 * q) * 2) = w;
                  w.x = pk2(c[0] * ed[0], c[1] * ed[1]); w.y = pk2(c[2] * ed[2], c[3] * ed[3]); *(LAS u32x2*)(lds + VD + (16 * ct + r) * PS + (16 * it + 4 * q) * 2) = w; }
                __syncthreads();
                if (n + 1 < NCH) { if (n & 1) DNB_STAGE(QC0, KC0, GS0); else DNB_STAGE(QC1, KC1, GS1); }
                if (n + 2 < NCH) DNB_LOAD(n + 2);
                { const float egl = GS[64 + 63];
#pragma unroll
                  for (int e = 0; e < 2; ++e) { f32x4 c = Sacc[e] * egl;
#pragma unroll
                      for (int kb = 0; kb < 2; ++kb) c = MFMA16(frag_tr(KC, RS, 32 * kb, 16 * wave, q, qq, pp), frag_rows(lds + VD, PS, 16 * e, 32 * kb, r, q), c);
                      Sacc[e] = c;
                      u32x2 w; w.x = pk2(c[0], c[1]); w.y = pk2(c[2], c[3]); *(LAS u32x2*)(STn + (16 * e + r) * RS + (16 * wave + 4 * q) * 2) = w; } }
                { f32x4 o = (f32x4){0.f, 0.f, 0.f, 0.f};
                  bf16x8 Qf[4];
#pragma unroll
                  for (int ks = 0; ks < 4; ++ks) Qf[ks] = frag_rows(QC, RS, 16 * it, 32 * ks, r, q);
#pragma unroll
                  for (int ks = 0; ks < 4; ++ks) o = MFMA16(Qf[ks], frag_rows(STc, RS, 16 * ct, 32 * ks, r, q), o);
                  { const f32x4 eg = *(const LAS f32x4*)(GS + 64 + 16 * it + 4 * q); o = o * eg; }
                  const float gi = GS[16 * it + r];
#pragma unroll
                  for (int kp = 0; kp < 2; ++kp) {
                      if (2 * kp <= it) { f32x4 pt[2];
#pragma unroll
                          for (int e = 0; e < 2; ++e) { const int jt = 2 * kp + e; f32x4 c = (f32x4){0.f, 0.f, 0.f, 0.f};
                              if (jt <= it) {
#pragma unroll
                                  for (int ks = 0; ks < 4; ++ks) c = MFMA16(frag_rows(KC, RS, 16 * jt, 32 * ks, r, q), Qf[ks], c);
                                  const f32x4 gj = *(const LAS f32x4*)(GS + 16 * jt + 4 * q);
#pragma unroll
                                  for (int jj = 0; jj < 4; ++jj) c[jj] = (16 * jt + 4 * q + jj <= 16 * it + r) ? c[jj] * __expf(gi - gj[jj]) : 0.f; }
                              pt[e] = c; }
                          o = MFMA16(pack_pair(pt[0], pt[1]), frag_rows_perm(lds + VN, PS, 16 * ct, 32 * kp, r, q), o); }
                  }
#pragma unroll
                  for (int jj = 0; jj < 4; ++jj) { const size_t R = DN_ROW(n, 16 * it + 4 * q + jj); DO[R * 1024 + h * 128 + sl * 32 + 16 * ct + r] = (bf16)f2bf(o[jj]); } }
                __syncthreads();
            }
        }
#undef DNB_LOAD
#undef DNB_STAGE
    }
    S5_PASS(true)
    PHASE_END

    PHASE_BEGIN
    {
        const bf16* O0 = (const bf16*)(BIG + B_DNO0); const bf16* O1 = (const bf16*)(BIG + B_DNO1); const bf16* IN0 = (const bf16*)(BIG + B_IN0);
        for (int item = gw; item < MROWS * 8; item += NGW) {
            const int R = item >> 3, h = item & 7; const size_t o = (size_t)R * 1024 + h * 128 + 2 * lane;
            const unsigned a = *(const unsigned*)(O0 + o), c = *(const unsigned*)(O1 + o);
            const float v0 = lo16(a) + lo16(c), v1 = hi16(a) + hi16(c);
            const float ms = wave_sum(v0 * v0 + v1 * v1) * (1.f / 128.f); const float rs = 1.f / sqrtf(ms + EPS);
            const unsigned gt = *(const unsigned*)(IN0 + (size_t)R * IN0_LD + 4096 + h * 128 + 2 * lane);
            const float g0 = args.in[I_DNNG][2 * lane], g1 = args.in[I_DNNG][2 * lane + 1];
            *(unsigned*)(MIX + (size_t)R * 2048 + 1024 + h * 128 + 2 * lane) = pk2(v0 * rs * g0 * siluf_(lo16(gt)), v1 * rs * g1 * siluf_(hi16(gt)));
        }
    }
    { pg8::Gemm g{(const bf16*)(BIG + B_S5Y), (const bf16*)(WB + W_GLU), 1024, 1024, 1024}; pg8::StaticOrder S; S.init(68, 4, G, bid, 0);
      EpiGlu E{(const bf16*)(BIG + B_S5Y), MIX, args.in[I_GLUB]};
      pg8::gemm_phase<EpiGlu>(lds, g, S, E); }
    PHASE_END

    PHASE_BEGIN
    { pg8::Gemm g{MIX, (const bf16*)(WB + W_OUT), 2048, 2048, 2048}; pg8::TailOrder<32> S; S.init(G, bid);
      EpiRes<true> E{args.in[I_X], XLb, MOD + 2 * 2048, SLAB};
      pg8::gemm_phase<EpiRes<true>, pg8::TailOrder<32>>(lds, g, S, E); }
    PHASE_END

    PHASE_BEGIN
    ADALN(0, 1, true, XLb, args.in[I_CTX], false, SLAB, MOD + 4 * 12288 + 2 * 2048)
    PHASE_END

    PHASE_BEGIN
    { pg8::Gemm g{Hb, (const bf16*)(WB + W_UP), DM, DM, DM}; pg8::StaticOrder S; S.init(68, 44, G, bid, 0);
      EpiSwiglu E{(bf16*)(BIG + B_G)};
      pg8::gemm_phase<EpiSwiglu>(lds, g, S, E); }
    PHASE_END

    PHASE_BEGIN
    { pg8::Gemm g{(const bf16*)(BIG + B_G), (const bf16*)(WB + W_DN), DFF, DFF, DFF}; pg8::TailOrder<88> S; S.init(G, bid);
      EpiRes<false> E{XLb, XLb, MOD + 5 * 2048, SLAB};
      pg8::gemm_phase<EpiRes<false>, pg8::TailOrder<88>>(lds, g, S, E); }
    PHASE_END

    PHASE_BEGIN
    ADALN(1, 0, true, XLb, XC, false, SLAB, MOD + 4 * 12288 + 5 * 2048)
    {
        LAS float* scr = (LAS float*)(lds + wave * 16384);
        constexpr int J0 = 32 * 256, J1 = 48 * 64, J3 = 32 * 176, J4 = J3, J5 = 88 * 64;
        for (int it = gw; it < J0 + J1 + J3 + J4 + J5; it += NGW) {
            int r = it;
            if (r < J0) { transpose_job(r, args.in[I_OWIN], 2048, 8192, (bf16*)(WB + W_IN), 0, 0, scr, lane); continue; } r -= J0;
            if (r < J1) { transpose_job(r, args.in[I_OWOUT], 3072, 2048, (bf16*)(WB + W_OUT), 0, 0, scr, lane); continue; } r -= J1;
            if (r < J3) { transpose_job(r, args.in[I_W1] + (size_t)2048 * 5632, 2048, 5632, (bf16*)(WB + W_UP), 1, 0, scr, lane); continue; } r -= J3;
            if (r < J4) { transpose_job(r, args.in[I_W3] + (size_t)2048 * 5632, 2048, 5632, (bf16*)(WB + W_UP), 1, 128, scr, lane); continue; } r -= J4;
            transpose_job(r, args.in[I_W2] + (size_t)5632 * 2048, 5632, 2048, (bf16*)(WB + W_DN), 0, 0, scr, lane);
        }
        bf16* WG = (bf16*)(WB + W_GLU);
        for (int i = bid * 512 + tid; i < 4096 * 256 / 2; i += G * 512) {
            const int kk = (i & 127) * 2, np = i >> 7; const int e = np & 127, half = (np >> 7) & 1, q = np >> 8, blk = q & 7, dir = q >> 3;
            unsigned w = 0u;
            if ((kk >> 7) == (blk & 1)) { const float* src = args.in[half ? I_LWX : I_LWA] + ((size_t)(dir * 8 + blk) * 128 + (kk & 127)) * 128 + e; w = pk2(src[0], src[128]); }
            *(unsigned*)(WG + (size_t)np * 256 + kk) = w;
        }
    }
    PHASE_END

    PHASE_BEGIN
    { pg8::Gemm g{Hb, (const bf16*)(WB + W_IN), DM, DM, DM}; pg8::StaticOrder S; S.init(68, 8, G, bid, 0);
      EpiPlain E{(bf16*)(BIG + B_INA), 2048};
      pg8::gemm_phase<EpiPlain>(lds, g, S, E); }
    PHASE_END

    PHASE_BEGIN
    {
        const bf16* INA = (const bf16*)(BIG + B_INA); bf16* XCV = (bf16*)(BIG + B_XCV);
        for (size_t i = (size_t)bid * 512 + tid; i < (size_t)MROWS * 512; i += (size_t)G * 512) {
            const int R = (int)(i >> 9), ch = (int)(i & 511) * 2, b = R / SROW, s = R % SROW;
            const int seg_lo = s < CTX ? 0 : CTX, seg_hi = s < CTX ? CTX : SROW;
            const f32x4 w0 = *(const f32x4*)(args.in[I_LCW] + ch * 4), w1 = *(const f32x4*)(args.in[I_LCW] + ch * 4 + 4);
            float a0 = args.in[I_LCB][ch], a1 = args.in[I_LCB][ch + 1];
#pragma unroll
            for (int j = 0; j < 4; ++j) { const int sx = s + j - 2;
                if (sx >= seg_lo && sx < seg_hi) { const unsigned pr = *(const unsigned*)(INA + (size_t)(b * SROW + sx) * 2048 + ch); a0 += w0[j] * lo16(pr); a1 += w1[j] * hi16(pr); } }
            *(unsigned*)(XCV + (size_t)R * 1024 + ch) = pk2(a0, a1);
        }
    }
    PHASE_END

    PHASE_BEGIN
    { pg8::Gemm g{(const bf16*)(BIG + B_XCV), (const bf16*)(WB + W_GLU), 1024, 256, 256}; pg8::StaticOrder S; S.init(68, 16, G, bid, 0);
      EpiGate E{(const bf16*)(BIG + B_XCV), (bf16*)(BIG + B_LA), (bf16*)(BIG + B_BB), args.in[I_LBA], args.in[I_LBX], T_SPL};
      pg8::gemm_phase<EpiGate, pg8::StaticOrder, true>(lds, g, S, E); }
    PHASE_END

    PHASE_BEGIN
    {
        const bf16* LA = (const bf16*)(BIG + B_LA); const bf16* BBp = (const bf16*)(BIG + B_BB); float* EP = (float*)(BIG + B_LEP);
        for (int i = bid * 512 + tid; i < NB * 2 * NCH * 1024; i += G * 512) {
            const int ch = i & 1023; int rest = i >> 10; const int c = rest % NCH; rest /= NCH; const int dir = rest & 1, b = rest >> 1;
            float P = 1.f, h = 0.f;
            for (int ti = 0; ti < 64; ++ti) { const int t = dir ? 63 - ti : ti; const size_t o = ((size_t)(b * SROW + c * 64 + t) * 2 + dir) * 1024 + ch;
                const float a = expf(bf2f(LA[o])), bb = bf2f(BBp[o]); P *= a; h = a * h + bb; }
            EP[(size_t)i * 2] = P; EP[(size_t)i * 2 + 1] = h;
        }
    }
    PHASE_END

    PHASE_BEGIN
    {
        const float* EP = (const float*)(BIG + B_LEP); float* ST = (float*)(BIG + B_LST);
        for (int i = bid * 512 + tid; i < NB * 2 * 1024; i += G * 512) {
            const int ch = i & 1023, dir = (i >> 10) & 1, b = i >> 11; float s = 0.f;
            for (int k = 0; k < NCH; ++k) { const int c = dir == 0 ? k : (k < 4 ? 3 - k : 71 - k); const size_t o = ((size_t)(b * 2 + dir) * NCH + c) * 1024 + ch;
                ST[o] = s; s = EP[o * 2] * s + EP[o * 2 + 1]; }
        }
    }
    PHASE_END

    PHASE_BEGIN
    {
        const bf16* LA = (const bf16*)(BIG + B_LA); const bf16* BBp = (const bf16*)(BIG + B_BB); const float* ST = (const float*)(BIG + B_LST); const bf16* INA = (const bf16*)(BIG + B_INA);
        LAS float* hb = (LAS float*)lds;
        for (int u = bid; u < NB * 64 * 2; u += G) {
            const int half = u & 1, c = 4 + ((u >> 1) & 63), b = u >> 7, ch = half * 512 + tid;
            float h = ST[((size_t)(b * 2 + 0) * NCH + c) * 1024 + ch];
            for (int t = 0; t < 64; ++t) { const size_t o = ((size_t)(b * SROW + c * 64 + t) * 2 + 0) * 1024 + ch; h = expf(bf2f(LA[o])) * h + bf2f(BBp[o]); hb[t * 512 + tid] = h; }
            h = ST[((size_t)(b * 2 + 1) * NCH + c) * 1024 + ch];
            for (int t = 63; t >= 0; --t) { const size_t R = (size_t)(b * SROW + c * 64 + t); const size_t o = (R * 2 + 1) * 1024 + ch; h = expf(bf2f(LA[o])) * h + bf2f(BBp[o]);
                const float y = hb[t * 512 + tid] + h; const float gt = bf2f(INA[R * 2048 + 1024 + ch]);
                MIX[R * 3072 + ch] = (bf16)f2bf(y * gelu_tanh(gt)); }
        }
    }
    PHASE_END

    PHASE_BEGIN
    { pg8::Gemm g{Hb, (const bf16*)(WB + W_IN) + (size_t)2048 * 2048, DM, DM, DM}; pg8::StaticOrder S; S.init(68, 24, G, bid, 0);
      EpiRope E{(bf16*)(BIG + B_INB), T_ROPE};
      pg8::gemm_phase<EpiRope>(lds, g, S, E); }
    PHASE_END

    PHASE_BEGIN
    {
        const bf16* INB = (const bf16*)(BIG + B_INB);
        constexpr int QS = 0, KS = 33792, VS = 67584, TS = 76800, RS = 528, VRS = 144;
        const int r = lane & 15, q = lane >> 4, qq = r >> 2, pp = r & 3;
        const int it = wave >> 1, dvp = wave & 1;
        for (int unit = bid; unit < NB * 4 * 2 * 8; unit += G) {
            const int sl = unit & 7, dir = (unit >> 3) & 1, h = (unit >> 4) & 3, b = unit >> 6;
            bf16* RO = (bf16*)(BIG + (dir ? B_RO1 : B_RO0));
            const float lgam = -expf(args.in[I_RTH][dir * 4 + h]);
            const float gC = expf(64.f * lgam);
            f32x4 Tacc[2][4];
#pragma unroll
            for (int a = 0; a < 2; ++a)
#pragma unroll
                for (int d = 0; d < 4; ++d) Tacc[a][d] = (f32x4){0.f, 0.f, 0.f, 0.f};
            const int vrow = tid >> 3, vcp = tid & 7;
            const float vsc = expf(-(float)vrow * lgam);
            u32x4 pq[4], pk[4], pv;
#define RT_ROW(n, row) ((size_t)b * SROW + (dir == 0 ? ((n) * 64 + (row)) : (((n) * 64 + (row)) < CTX ? CTX - 1 - ((n) * 64 + (row)) : SROW + CTX - 1 - ((n) * 64 + (row)))))
#define RT_LOAD(n) do { _Pragma("unroll") for (int k = 0; k < 4; ++k) { const int id = tid + 512 * k, row = id >> 5, cp = id & 31; const bf16* src = INB + RT_ROW(n, row) * INB_LD + h * 256 + cp * 8; \
                pq[k] = *(const u32x4*)src; pk[k] = *(const u32x4*)(src + 1024); } \
                pv = *(const u32x4*)(INB + RT_ROW(n, vrow) * INB_LD + 2048 + h * 512 + sl * 64 + vcp * 8); } while (0)
            RT_LOAD(0);
            for (int n = 0; n < NCH; ++n) {
#pragma unroll
                for (int k = 0; k < 4; ++k) { const int id = tid + 512 * k, row = id >> 5, cp = id & 31;
                    *(LAS u32x4*)(lds + QS + row * RS + cp * 16) = pq[k]; *(LAS u32x4*)(lds + KS + row * RS + cp * 16) = pk[k]; }
                { u32x4 w; w.x = pk2(lo16(pv.x) * vsc, hi16(pv.x) * vsc); w.y = pk2(lo16(pv.y) * vsc, hi16(pv.y) * vsc); w.z = pk2(lo16(pv.z) * vsc, hi16(pv.z) * vsc); w.w = pk2(lo16(pv.w) * vsc, hi16(pv.w) * vsc);
                  *(LAS u32x4*)(lds + VS + vrow * VRS + vcp * 16) = w; }
                const bool outp = n >= 4;
                if (outp) {
#pragma unroll
                    for (int a = 0; a < 2; ++a)
#pragma unroll
                        for (int d = 0; d < 4; ++d) { u32x2 w; w.x = pk2(Tacc[a][d][0], Tacc[a][d][1]); w.y = pk2(Tacc[a][d][2], Tacc[a][d][3]);
                            *(LAS u32x2*)(lds + TS + (16 * d + r) * RS + (16 * (2 * wave + a) + 4 * q) * 2) = w; }
                }
                __syncthreads();
                if (n + 1 < NCH) RT_LOAD(n + 1);
                if (outp) {
                    bf16x8 Qf[8];
#pragma unroll
                    for (int ks = 0; ks < 8; ++ks) Qf[ks] = *(const LAS bf16x8*)(lds + QS + (16 * it + r) * RS + (32 * ks + 8 * q) * 2);
                    f32x4 oacc[2];
#pragma unroll
                    for (int dd = 0; dd < 2; ++dd) { f32x4 c = (f32x4){0.f, 0.f, 0.f, 0.f};
#pragma unroll
                        for (int ks = 0; ks < 8; ++ks) { const bf16x8 tf = *(const LAS bf16x8*)(lds + TS + (16 * (2 * dvp + dd) + r) * RS + (32 * ks + 8 * q) * 2);
                            c = __builtin_amdgcn_mfma_f32_16x16x32_bf16(Qf[ks], tf, c, 0, 0, 0); }
                        oacc[dd] = c * gC; }
#pragma unroll
                    for (int kp = 0; kp < 2; ++kp) {
                        if (2 * kp <= it) {
                            f32x4 pt[2];
#pragma unroll
                            for (int e = 0; e < 2; ++e) { const int jt = 2 * kp + e; f32x4 c = (f32x4){0.f, 0.f, 0.f, 0.f};
                                if (jt <= it) {
#pragma unroll
                                    for (int ks = 0; ks < 8; ++ks) { const bf16x8 kf = *(const LAS bf16x8*)(lds + KS + (16 * jt + r) * RS + (32 * ks + 8 * q) * 2);
                                        c = __builtin_amdgcn_mfma_f32_16x16x32_bf16(kf, Qf[ks], c, 0, 0, 0); }
                                    if (jt == it) {
#pragma unroll
                                        for (int jj = 0; jj < 4; ++jj) if (4 * q + jj > r) c[jj] = 0.f; }
                                }
                                pt[e] = c; }
                            u32x4 pw; pw.x = pk2(pt[0][0], pt[0][1]); pw.y = pk2(pt[0][2], pt[0][3]); pw.z = pk2(pt[1][0], pt[1][1]); pw.w = pk2(pt[1][2], pt[1][3]);
                            const bf16x8 pf = __builtin_bit_cast(bf16x8, pw);
#pragma unroll
                            for (int dd = 0; dd < 2; ++dd) { const int dvt = 2 * dvp + dd;
                                const s16x4 v0 = __builtin_amdgcn_ds_read_tr16_b64_v4i16((LAS s16x4*)(lds + VS + (32 * kp + 4 * q + qq) * VRS + (16 * dvt + 4 * pp) * 2));
                                const s16x4 v1 = __builtin_amdgcn_ds_read_tr16_b64_v4i16((LAS s16x4*)(lds + VS + (32 * kp + 16 + 4 * q + qq) * VRS + (16 * dvt + 4 * pp) * 2));
                                const bf16x8 vf = {v0[0], v0[1], v0[2], v0[3], v1[0], v1[1], v1[2], v1[3]};
                                oacc[dd] = __builtin_amdgcn_mfma_f32_16x16x32_bf16(pf, vf, oacc[dd], 0, 0, 0); }
                        }
                    }
#pragma unroll
                    for (int jj = 0; jj < 4; ++jj) { const int i = 16 * it + 4 * q + jj; const float gi = expf((float)i * lgam);
                        const size_t R = RT_ROW(n, i); const size_t Rl = (size_t)b * SEQ + (R - (size_t)b * SROW - CTX);
#pragma unroll
                        for (int dd = 0; dd < 2; ++dd) RO[Rl * 2048 + h * 512 + sl * 64 + 16 * (2 * dvp + dd) + r] = (bf16)f2bf(oacc[dd][jj] * gi); }
                }
#pragma unroll
                for (int a = 0; a < 2; ++a)
#pragma unroll
                    for (int d = 0; d < 4; ++d) Tacc[a][d] = Tacc[a][d] * gC;
#pragma unroll
                for (int ks = 0; ks < 2; ++ks) {
                    bf16x8 kt[2], vf[4];
#pragma unroll
                    for (int a = 0; a < 2; ++a) { const int dkt = 2 * wave + a;
                        const s16x4 k0 = __builtin_amdgcn_ds_read_tr16_b64_v4i16((LAS s16x4*)(lds + KS + (32 * ks + 8 * q + qq) * RS + (16 * dkt + 4 * pp) * 2));
                        const s16x4 k1 = __builtin_amdgcn_ds_read_tr16_b64_v4i16((LAS s16x4*)(lds + KS + (32 * ks + 8 * q + 4 + qq) * RS + (16 * dkt + 4 * pp) * 2));
                        kt[a] = (bf16x8){k0[0], k0[1], k0[2], k0[3], k1[0], k1[1], k1[2], k1[3]}; }
#pragma unroll
                    for (int d = 0; d < 4; ++d) {
                        const s16x4 v0 = __builtin_amdgcn_ds_read_tr16_b64_v4i16((LAS s16x4*)(lds + VS + (32 * ks + 8 * q + qq) * VRS + (16 * d + 4 * pp) * 2));
                        const s16x4 v1 = __builtin_amdgcn_ds_read_tr16_b64_v4i16((LAS s16x4*)(lds + VS + (32 * ks + 8 * q + 4 + qq) * VRS + (16 * d + 4 * pp) * 2));
                        vf[d] = (bf16x8){v0[0], v0[1], v0[2], v0[3], v1[0], v1[1], v1[2], v1[3]}; }
#pragma unroll
                    for (int a = 0; a < 2; ++a)
#pragma unroll
                        for (int d = 0; d < 4; ++d) Tacc[a][d] = __builtin_amdgcn_mfma_f32_16x16x32_bf16(kt[a], vf[d], Tacc[a][d], 0, 0, 0);
                }
                __syncthreads();
            }
        }
#undef RT_ROW
#undef RT_LOAD
    }
    PHASE_END

    PHASE_BEGIN
    {
        const bf16* O0 = (const bf16*)(BIG + B_RO0); const bf16* O1 = (const bf16*)(BIG + B_RO1); const bf16* INB = (const bf16*)(BIG + B_INB);
        for (int item = gw; item < NB * SEQ * 4; item += NGW) {
            const int Rl = item >> 2, h = item & 3, b = Rl / SEQ, n = Rl % SEQ; const size_t R = (size_t)b * SROW + CTX + n;
            const size_t o = (size_t)Rl * 2048 + h * 512 + lane * 8;
            const u32x4 a = *(const u32x4*)(O0 + o), c = *(const u32x4*)(O1 + o);
            float v[8] = {lo16(a.x) + lo16(c.x), hi16(a.x) + hi16(c.x), lo16(a.y) + lo16(c.y), hi16(a.y) + hi16(c.y), lo16(a.z) + lo16(c.z), hi16(a.z) + hi16(c.z), lo16(a.w) + lo16(c.w), hi16(a.w) + hi16(c.w)};
            float ss = 0.f;
#pragma unroll
            for (int e = 0; e < 8; ++e) ss += v[e] * v[e];
            const float rs = 1.f / sqrtf(wave_sum(ss) * (1.f / 512.f) + EPS);
            const u32x4 gw4 = *(const u32x4*)(INB + R * INB_LD + 4096 + h * 512 + lane * 8);
            const float gt[8] = {lo16(gw4.x), hi16(gw4.x), lo16(gw4.y), hi16(gw4.y), lo16(gw4.z), hi16(gw4.z), lo16(gw4.w), hi16(gw4.w)};
            u32x4 w; w.x = pk2(v[0] * rs * siluf_(gt[0]), v[1] * rs * siluf_(gt[1])); w.y = pk2(v[2] * rs * siluf_(gt[2]), v[3] * rs * siluf_(gt[3]));
            w.z = pk2(v[4] * rs * siluf_(gt[4]), v[5] * rs * siluf_(gt[5])); w.w = pk2(v[6] * rs * siluf_(gt[6]), v[7] * rs * siluf_(gt[7]));
            *(u32x4*)(MIX + R * 3072 + 1024 + h * 512 + lane * 8) = w;
        }
    }
    PHASE_END

    PHASE_BEGIN
    { pg8::Gemm g{MIX, (const bf16*)(WB + W_OUT), 3072, 3072, 3072}; pg8::StaticOrder S; S.init(64, 8, G, bid, 1);
      EpiRes<false> E{XLb, XLb, MOD + 5 * 12288 + 2 * 2048, SLAB};
      pg8::gemm_phase<EpiRes<false>>(lds, g, S, E); }
    PHASE_END

    PHASE_BEGIN
    ADALN(1, 1, true, XLb, XC, true, (const float*)nullptr, (const float*)nullptr)
    PHASE_END

    PHASE_BEGIN
    { pg8::Gemm g{Hb, (const bf16*)(WB + W_UP), DM, DM, DM}; pg8::StaticOrder S; S.init(64, 44, G, bid, 1);
      EpiSwiglu E{(bf16*)(BIG + B_G)};
      pg8::gemm_phase<EpiSwiglu>(lds, g, S, E); }
    PHASE_END

    PHASE_BEGIN
    { pg8::Gemm g{(const bf16*)(BIG + B_G), (const bf16*)(WB + W_DN), DFF, DFF, DFF}; pg8::StaticOrder S; S.init(64, 8, G, bid, 1);
      EpiRes<false> E{XLb, XLb, MOD + 5 * 12288 + 5 * 2048, SLAB};
      pg8::gemm_phase<EpiRes<false>>(lds, g, S, E); }
    PHASE_END

    PHASE_BEGIN
    {
        const float* fg = args.in[I_FING];
        for (int R = gw; R < NB * SEQ; R += NGW) { const bf16* xr = XLb + (size_t)R * DM; float* orow = args.out + (size_t)R * DM;
            f32x4 v[8]; float ss = 0.f;
#pragma unroll
            for (int j = 0; j < 8; ++j) { const u32x2 w = *(const u32x2*)(xr + lane * 4 + j * 256); v[j] = (f32x4){lo16(w.x), hi16(w.x), lo16(w.y), hi16(w.y)};
                ss += (v[j][0] * v[j][0] + v[j][1] * v[j][1]) + (v[j][2] * v[j][2] + v[j][3] * v[j][3]); }
            const float rstd = 1.f / sqrtf(wave_sum(ss) * (1.f / DM) + EPS);
#pragma unroll
            for (int j = 0; j < 8; ++j) { const f32x4 gg = *(const f32x4*)(fg + lane * 4 + j * 256); *(f32x4*)(orow + lane * 4 + j * 256) = v[j] * rstd * gg; }
        }
    }
    PHASE_END
}
constexpr int N_PHASES = 26;

extern "C" void kernel_launch(void* const* d_in, const int* in_sizes, int n_in, void* d_out, int out_size, void* d_ws, size_t ws_size, hipStream_t stream) {
    static int grid = 0;
    if (grid == 0) {
        if (n_in != 38 || out_size != NB * SEQ * DM || ws_size < WS_END) { fprintf(stderr, "kernel_launch: unexpected problem (n_in %d out %d ws %zu, need %zu)\n", n_in, out_size, ws_size, (size_t)WS_END); grid = -1; return; }
        int dev = 0, cus = 0;
        if (hipGetDevice(&dev) != hipSuccess || hipDeviceGetAttribute(&cus, hipDeviceAttributeMultiprocessorCount, dev) != hipSuccess) { grid = -1; return; }
        if (hipFuncSetAttribute((const void*)fwd_kernel, hipFuncAttributeMaxDynamicSharedMemorySize, LDS_BYTES) != hipSuccess) { fprintf(stderr, "kernel_launch: hipFuncSetAttribute failed\n"); grid = -1; return; }
        int per_cu = 0;
        if (hipOccupancyMaxActiveBlocksPerMultiprocessor(&per_cu, (const void*)fwd_kernel, 512, LDS_BYTES) != hipSuccess || per_cu < 1) { fprintf(stderr, "kernel_launch: occupancy query says %d\n", per_cu); }
        (void)hipGetLastError();
        if (per_cu < 1) { grid = -1; return; }
        grid = cus;
    }
    if (grid < 0) return;
    (void)hipMemsetAsync((char*)d_ws + WS_CTL, 0, CTL_BYTES, stream);
    Args a{};
    for (int i = 0; i < 38; ++i) a.in[i] = (const float*)d_in[i];
    a.out = (float*)d_out; a.ws = (unsigned char*)d_ws;
#if MK_ONE_LAUNCH
    a.ph_lo = 0; a.ph_hi = N_PHASES;
    hipLaunchKernelGGL(fwd_kernel, dim3(grid), dim3(512), LDS_BYTES, stream, a);
#else
    for (int p = 0; p < N_PHASES; ++p) { a.ph_lo = p; a.ph_hi = p + 1; hipLaunchKernelGGL(fwd_kernel, dim3(grid), dim3(512), LDS_BYTES, stream, a); }
#endif
}
```

```cpp
#include <hip/hip_runtime.h>
#include <cstdio>
#include <cstdint>

#ifndef MK_ONE_LAUNCH
#define MK_ONE_LAUNCH 1
#endif

#define DI __device__ __forceinline__
#define LAS __attribute__((address_space(3)))
typedef unsigned short bf16;
typedef short bf16x8 __attribute__((ext_vector_type(8)));
typedef float f32x4 __attribute__((ext_vector_type(4)));
typedef float f32x2 __attribute__((ext_vector_type(2)));
typedef unsigned u32x4 __attribute__((ext_vector_type(4)));
typedef unsigned u32x2 __attribute__((ext_vector_type(2)));
typedef short s16x4 __attribute__((ext_vector_type(4)));

constexpr int DM = 2048, NB = 4, SEQ = 4096, CTX = 256, DFF = 5632;
constexpr int SROW = CTX + SEQ;
constexpr int MROWS = NB * SROW;
constexpr int NCH = SROW / 64;
constexpr float EPS = 1e-6f;
constexpr int IN0_LD = 5120;
constexpr int INB_LD = 6144;

constexpr size_t MiB = 1u << 20;
constexpr size_t WS_CTL = 0, CTL_BYTES = 1 * MiB;
constexpr size_t WS_MOD = 1 * MiB;
constexpr size_t WS_TAB = 2 * MiB;
constexpr size_t WS_XC = 4 * MiB;
constexpr size_t WS_W = 12 * MiB;
constexpr size_t W_IN = 0, W_OUT = 32 * MiB, W_GLU = 44 * MiB, W_UP = 46 * MiB, W_DN = 90 * MiB;
constexpr size_t WS_H = 124 * MiB;
constexpr size_t WS_MIX = 192 * MiB;
constexpr size_t WS_BIG = 294 * MiB;
constexpr size_t B_IN0 = 0, B_AB = 170 * MiB, B_DNQ = 173 * MiB, B_DNK = 207 * MiB, B_DNV = 241 * MiB, B_DNG = 275 * MiB, B_DNB = 277 * MiB,
                 B_DNO0 = 279 * MiB, B_DNO1 = 313 * MiB, B_S5Y = 347 * MiB, B_S5E = 381 * MiB, B_S5S = 398 * MiB, B_GCUM = 415 * MiB, B_END0 = 417 * MiB;
constexpr size_t MIX_TINV = 68 * MiB;
constexpr size_t B_INA = 0, B_XCV = 68 * MiB, B_LA = 102 * MiB, B_BB = 170 * MiB, B_LEP = 238 * MiB, B_LST = 243 * MiB;
constexpr size_t B_INB = 0, B_RO0 = 204 * MiB, B_RO1 = 268 * MiB;
constexpr size_t B_G = 0;
constexpr size_t WS_END = WS_BIG + B_END0;

DI float bf2f(unsigned v) { return __uint_as_float(v << 16); }
DI unsigned f2bf(float f) { unsigned u = __float_as_uint(f); return (u + 0x7fffu + ((u >> 16) & 1u)) >> 16; }
DI unsigned pk2(float lo, float hi) { return f2bf(lo) | (f2bf(hi) << 16); }
DI float lo16(unsigned w) { return __uint_as_float(w << 16); }
DI float hi16(unsigned w) { return __uint_as_float(w & 0xffff0000u); }
DI float sigmoidf_(float x) { return 1.f / (1.f + expf(-x)); }
DI float siluf_(float x) { return x / (1.f + expf(-x)); }
DI float softplusf_(float x) { return fmaxf(x, 0.f) + log1pf(expf(-fabsf(x))); }
DI float gelu_tanh(float x) { const float u = 0.7978845608028654f * (x + 0.044715f * x * x * x); return 0.5f * x * (1.f + tanhf(u)); }
DI float wave_sum(float v) {
#pragma unroll
    for (int o = 1; o < 64; o <<= 1) v += __shfl_xor(v, o);
    return v;
}

DI bf16x8 frag_rows(LAS unsigned char* base, int RSB, int row0, int k0, int r, int q) { return *(const LAS bf16x8*)(base + (row0 + r) * RSB + (k0 + 8 * q) * 2); }
DI bf16x8 frag_tr(LAS unsigned char* base, int RSB, int k0, int n0, int q, int qq, int pp) {
    const s16x4 a = __builtin_amdgcn_ds_read_tr16_b64_v4i16((LAS s16x4*)(base + (k0 + 8 * q + qq) * RSB + (n0 + 4 * pp) * 2));
    const s16x4 b = __builtin_amdgcn_ds_read_tr16_b64_v4i16((LAS s16x4*)(base + (k0 + 8 * q + 4 + qq) * RSB + (n0 + 4 * pp) * 2));
    return (bf16x8){a[0], a[1], a[2], a[3], b[0], b[1], b[2], b[3]}; }
DI bf16x8 frag_rows_perm(LAS unsigned char* base, int RSB, int row0, int k0, int r, int q) {
    const u32x2 a = *(const LAS u32x2*)(base + (row0 + r) * RSB + (k0 + 4 * q) * 2), b = *(const LAS u32x2*)(base + (row0 + r) * RSB + (k0 + 16 + 4 * q) * 2);
    u32x4 w; w.x = a.x; w.y = a.y; w.z = b.x; w.w = b.y; return __builtin_bit_cast(bf16x8, w); }
DI bf16x8 pack_pair(const f32x4& x, const f32x4& y) { u32x4 w; w.x = pk2(x[0], x[1]); w.y = pk2(x[2], x[3]); w.z = pk2(y[0], y[1]); w.w = pk2(y[2], y[3]); return __builtin_bit_cast(bf16x8, w); }
#define MFMA16(a, b, c) __builtin_amdgcn_mfma_f32_16x16x32_bf16((a), (b), (c), 0, 0, 0)
DI void st_hl(LAS unsigned char* p, int lo_off, const f32x4& c) {
    u32x2 h; h.x = pk2(c[0], c[1]); h.y = pk2(c[2], c[3]);
    u32x2 l; l.x = pk2(c[0] - lo16(h.x), c[1] - hi16(h.x)); l.y = pk2(c[2] - lo16(h.y), c[3] - hi16(h.y));
    *(LAS u32x2*)p = h; *(LAS u32x2*)(p + lo_off) = l; }
DI f32x4 mm3(f32x4 c, const bf16x8& ah, const bf16x8& al, const bf16x8& bh, const bf16x8& bl) { c = MFMA16(ah, bh, c); c = MFMA16(ah, bl, c); c = MFMA16(al, bh, c); return c; }
#define LDS_WAIT() asm volatile("s_waitcnt lgkmcnt(0)" ::: "memory")
#define VM_WAIT() asm volatile("s_waitcnt vmcnt(0)" ::: "memory")

namespace pg8 {
constexpr int BM = 256, BK = 64, HALF = 128, HTB = HALF * BK * 2, STAGE_BYTES = 8 * HTB, NXCD = 8, WGM = 8;
DI int lds_byte(int r, int c) { const int st = (r >> 4) * 2 + (c >> 5), rr = r & 15, cc = c & 31, ob = rr * 64 + cc * 2; return st * 1024 + (ob ^ (((ob >> 9) & 1) << 5)); }
DI void stage_rc(int b, int& R, int& C) { const int st = b / 1024, sb = b % 1024, swz = sb ^ (((sb >> 9) & 1) << 5); R = (st >> 1) * 16 + swz / 64; C = (st & 1) * 32 + (swz % 64) / 2; }
DI int perm32(int rho) { const int n = rho >> 4, i = rho & 15; return 8 * (i >> 2) + 4 * n + (i & 3); }
struct Unit { int pm, pn, koff, nt; };
struct Gemm { const bf16* A; const bf16* Bt; int lda, ldb, K; };
struct StaticOrder {
    int nM, nN, nwg, G, c, lat;
    DI void init(int nM_, int nN_, int G_, int c_, int lat_) { nM = nM_; nN = nN_; nwg = nM * nN; G = G_; c = c_; lat = lat_; }
    DI bool next(int i, int& upm, int& upn, int& ukoff, int& unt) const {
        const long L = (long)i * G + c; if (L >= nwg) return false;
        int wgid = (int)L; { const int q = nwg / NXCD, r = nwg % NXCD, xcd = wgid % NXCD, off = wgid / NXCD; wgid = (xcd < r ? xcd * (q + 1) : r * (q + 1) + (xcd - r) * q) + off; }
        const int nig = WGM * nN, gid = wgid / nig, fm = gid * WGM, gsz = (nM - fm) < WGM ? (nM - fm) : WGM;
        int pm = fm + ((wgid % nig) % gsz); upn = (wgid % nig) / gsz;
        if (lat) pm = (pm >> 4) * 17 + 1 + (pm & 15);
        upm = pm; ukoff = 0; unt = 0; return true;
    }
};
template <int NTOT> struct TailOrder {
    int G, c;
    static constexpr int NWG = 512, LO = (NTOT / 8) & ~1, EX2 = (NTOT - LO * 8) >> 1;
    DI void init(int G_, int c_) { G = G_; c = c_; }
    DI bool next(int i, int& upm, int& upn, int& ukoff, int& unt) const {
        const int L = i * G + c; if (L >= NWG + 256) return false;
        const bool mainu = L < NWG; const int T = L - NWG;
        const int wgid = (L & 7) * (NWG / 8) + (L >> 3);
        const int w = wgid & 63, pml = (wgid >> 6) * 8 + (w & 7); const int ctn = T >> 3, sp = T & 7;
        upm = mainu ? (pml >> 4) * 17 + 1 + (pml & 15) : (ctn >> 3) * 17; upn = mainu ? (w >> 3) : (ctn & 7);
        unt = mainu ? 0 : ((LO + (sp < EX2 ? 2 : 0)) | (sp << 8)); ukoff = mainu ? 0 : (LO * sp + 2 * (sp < EX2 ? sp : EX2)) * 128; return true;
    }
};
DI unsigned cvt_pk_bf16(float lo, float hi) { unsigned r; asm volatile("v_cvt_pk_bf16_f32 %0, %1, %2" : "=v"(r) : "v"(lo), "v"(hi)); return r; }

template <class Epi, class Sched = StaticOrder, bool BLKDIAG = false>
DI void gemm_phase(LAS unsigned char* lds, const Gemm g, const Sched& S, const Epi& E) {
    int tid_ = threadIdx.x; asm volatile("" : "+v"(tid_));
    const int tid = tid_, wid = __builtin_amdgcn_readfirstlane(tid >> 6), lane = tid & 63, wr = wid >> 2, wc = wid & 3, fr = lane & 15, fq = lane >> 4;
    int K_ = g.K; asm volatile("" : "+s"(K_));
    const int K = K_, nt = K / BK;
    unsigned voffA[2], voffB[2];
#pragma unroll
    for (int i = 0; i < 2; ++i) { int R, C; stage_rc(tid * 16 + i * 8192, R, C); const int Rb = Epi::PERM ? ((R & ~31) + perm32(R & 31)) : R;
        voffA[i] = (unsigned)(R * g.lda + C) * 2u; voffB[i] = (unsigned)(Rb * g.ldb + C) * 2u; }
    const size_t kstep = (size_t)(BK * 2);
    const size_t hstepA = (size_t)HALF * g.lda * 2, hstepB = (size_t)HALF * g.ldb * 2;
    const size_t tstepA = 2 * hstepA, tstepB = 2 * hstepB;
    const unsigned ldsw = (unsigned)wid * 1024u;
    const int aoff = lds_byte(wr * 64 + fr, fq * 8), boff = lds_byte(wc * 32 + fr, fq * 8);
#define PG8_SA(b, h) (((b) * 2 + (h)) * HTB)
#define PG8_SB(b, h) ((4 + (b) * 2 + (h)) * HTB)
#define PG8_STAGE(bufoff, gbase, voff) do { _Pragma("unroll") for (int _i = 0; _i < 2; ++_i) \
        __builtin_amdgcn_global_load_lds((const unsigned*)((const char*)(gbase) + (voff)[_i]), (LAS unsigned*)(lds + (bufoff) + ldsw + _i * 8192), 16, 0, 0); } while (0)
#define PG8_LDA(dst, b, h) do { _Pragma("unroll") for (int m = 0; m < 4; ++m) _Pragma("unroll") for (int k = 0; k < 2; ++k) dst[m][k] = *(const LAS bf16x8*)(lds + PG8_SA(b, h) + aoff + m * 2048 + k * 1024); } while (0)
#define PG8_LDB(dst, b, h) do { _Pragma("unroll") for (int n = 0; n < 2; ++n) _Pragma("unroll") for (int k = 0; k < 2; ++k) dst[n][k] = *(const LAS bf16x8*)(lds + PG8_SB(b, h) + boff + n * 2048 + k * 1024); } while (0)
#define PG8_MMA(ai, bj, At, Bt) do { __builtin_amdgcn_s_setprio(1); _Pragma("unroll") for (int m = 0; m < 4; ++m) _Pragma("unroll") for (int n = 0; n < 2; ++n) _Pragma("unroll") for (int k = 0; k < 2; ++k) \
        acc[ai][bj][m][n] = __builtin_amdgcn_mfma_f32_16x16x32_bf16(Bt[n][k], At[m][k], acc[ai][bj][m][n], 0, 0, 0); __builtin_amdgcn_s_setprio(0); } while (0)
#define PG8_WAIT_V(n) asm volatile("s_waitcnt vmcnt(" #n ")" ::: "memory")
#define PG8_WAIT_L(n) asm volatile("s_waitcnt lgkmcnt(" #n ")" ::: "memory")
#define PG8_BAR __builtin_amdgcn_s_barrier()
#define PG8_SCHED __builtin_amdgcn_sched_barrier(0)
#define PG8_KOFF(pn_, koff_) ((BLKDIAG ? (size_t)(((pn_) & 7) >> 1) * 512 : (size_t)0) + (size_t)(koff_))
    int cpm, cpn, ckoff, cnt_, npm = 0, npn = 0, nkoff = 0, nnt = 0; int ui = 0;
    if (!S.next(0, cpm, cpn, ckoff, cnt_)) return;
    f32x4 acc[2][2][4][2];
#pragma unroll
    for (int a = 0; a < 2; ++a)
#pragma unroll
        for (int b = 0; b < 2; ++b)
#pragma unroll
            for (int m = 0; m < 4; ++m)
#pragma unroll
                for (int n = 0; n < 2; ++n) acc[a][b][m][n] = (f32x4){0.f, 0.f, 0.f, 0.f};
    bf16x8 At[4][2], B0[2][2], B1[2][2];
    const char* cA = (const char*)g.A + (size_t)cpm * tstepA + PG8_KOFF(cpn, ckoff); const char* cB = (const char*)g.Bt + (size_t)cpn * tstepB + (size_t)ckoff;
    PG8_STAGE(PG8_SB(0, 0), cB, voffB); PG8_STAGE(PG8_SB(0, 1), cB + hstepB, voffB); PG8_STAGE(PG8_SA(0, 0), cA, voffA); PG8_STAGE(PG8_SA(0, 1), cA + hstepA, voffA);
    if (wr == 1) PG8_BAR;
    PG8_WAIT_V(2); PG8_BAR;
    PG8_STAGE(PG8_SB(1, 0), cB + kstep, voffB); PG8_STAGE(PG8_SA(1, 0), cA + kstep, voffA); PG8_STAGE(PG8_SB(1, 1), cB + hstepB + kstep, voffB);
    PG8_WAIT_V(6); PG8_BAR;
    for (;;) {
        const bool has_next = S.next(ui + 1, npm, npn, nkoff, nnt);
        const char* nA = has_next ? (const char*)g.A + (size_t)npm * tstepA + PG8_KOFF(npn, nkoff) : cA; const char* nB = has_next ? (const char*)g.Bt + (size_t)npn * tstepB + (size_t)nkoff : cB;
        const int cnt = cnt_ ? (cnt_ & 255) : nt;
        for (int t = 0; t < cnt; t += 2) {
            const bool last = (t == cnt - 2);
            const char* a1 = cA + (size_t)(t + 1) * kstep;
            const char* a2 = last ? nA : cA + (size_t)(t + 2) * kstep; const char* b2 = last ? nB : cB + (size_t)(t + 2) * kstep;
            const char* a3 = a2 + kstep; const char* b3 = b2 + kstep;
            PG8_LDB(B0, 0, 0); PG8_LDB(B1, 0, 1); PG8_SCHED; PG8_LDA(At, 0, 0); PG8_STAGE(PG8_SA(1, 1), a1 + hstepA, voffA);
            PG8_WAIT_V(8); PG8_WAIT_L(0); PG8_BAR; PG8_MMA(0, 0, At, B0); PG8_MMA(0, 1, At, B1); PG8_BAR; PG8_SCHED;
            PG8_LDA(At, 0, 1); PG8_STAGE(PG8_SB(0, 0), b2, voffB); PG8_STAGE(PG8_SB(0, 1), b2 + hstepB, voffB); PG8_STAGE(PG8_SA(0, 0), a2, voffA);
            PG8_WAIT_V(8); PG8_WAIT_L(0); PG8_BAR; PG8_MMA(1, 0, At, B0); PG8_MMA(1, 1, At, B1); PG8_BAR; PG8_SCHED;
            PG8_LDB(B0, 1, 0); PG8_LDB(B1, 1, 1); PG8_SCHED; PG8_LDA(At, 1, 0); PG8_STAGE(PG8_SA(0, 1), a2 + hstepA, voffA);
            PG8_WAIT_V(8); PG8_WAIT_L(0); PG8_BAR; PG8_MMA(0, 0, At, B0); PG8_MMA(0, 1, At, B1); PG8_BAR; PG8_SCHED;
            PG8_LDA(At, 1, 1); PG8_STAGE(PG8_SB(1, 0), b3, voffB); PG8_STAGE(PG8_SB(1, 1), b3 + hstepB, voffB); PG8_STAGE(PG8_SA(1, 0), a3, voffA);
            PG8_WAIT_V(8); PG8_WAIT_L(0); PG8_BAR; PG8_MMA(1, 0, At, B0); PG8_MMA(1, 1, At, B1); PG8_BAR; PG8_SCHED;
        }
        if (wr == 0) PG8_BAR;
        { Unit cu; cu.pm = cpm; cu.pn = cpn; cu.koff = ckoff; cu.nt = cnt_; E(acc, cu, wr, wc, fr, fq); }
        if (!has_next) break;
#pragma unroll
        for (int a = 0; a < 2; ++a)
#pragma unroll
            for (int b = 0; b < 2; ++b)
#pragma unroll
                for (int m = 0; m < 4; ++m)
#pragma unroll
                    for (int n = 0; n < 2; ++n) acc[a][b][m][n] = (f32x4){0.f, 0.f, 0.f, 0.f};
        cpm = npm; cpn = npn; ckoff = nkoff; cnt_ = nnt; cA = nA; cB = nB; ++ui;
        if (wr == 1) PG8_BAR;
    }
    PG8_WAIT_V(0);
    PG8_BAR;
#undef PG8_SA
#undef PG8_SB
#undef PG8_STAGE
#undef PG8_LDA
#undef PG8_LDB
#undef PG8_MMA
#undef PG8_WAIT_V
#undef PG8_WAIT_L
#undef PG8_BAR
#undef PG8_SCHED
#undef PG8_KOFF
}
}
using pg8::Unit;
typedef f32x4 AccT[2][2][4][2];

struct EpiPlain {
    static constexpr bool PERM = true;
    bf16* O; int ldc;
    DI void operator()(const AccT& acc, const Unit& u, int wr, int wc, int fr, int fq) const {
        const int row0 = u.pm * 256 + wr * 64 + fr, col0 = u.pn * 256 + wc * 32 + 8 * fq;
#pragma unroll
        for (int ai = 0; ai < 2; ++ai)
#pragma unroll
            for (int m = 0; m < 4; ++m) { bf16* rowp = O + (size_t)(row0 + ai * 128 + m * 16) * ldc + col0;
#pragma unroll
                for (int bj = 0; bj < 2; ++bj) { const f32x4 v0 = acc[ai][bj][m][0], v1 = acc[ai][bj][m][1];
                    u32x4 w; w.x = pg8::cvt_pk_bf16(v0[0], v0[1]); w.y = pg8::cvt_pk_bf16(v0[2], v0[3]); w.z = pg8::cvt_pk_bf16(v1[0], v1[1]); w.w = pg8::cvt_pk_bf16(v1[2], v1[3]);
                    *(u32x4*)(rowp + bj * 128) = w; } }
    }
};
struct EpiIn0 {
    static constexpr bool PERM = true;
    bf16* O; float* AB;
    DI void operator()(const AccT& acc, const Unit& u, int wr, int wc, int fr, int fq) const {
        const int row0 = u.pm * 256 + wr * 64 + fr;
        if (u.pn < 20) {
            const int col0 = u.pn * 256 + wc * 32 + 8 * fq;
#pragma unroll
            for (int ai = 0; ai < 2; ++ai)
#pragma unroll
                for (int m = 0; m < 4; ++m) { bf16* rowp = O + (size_t)(row0 + ai * 128 + m * 16) * IN0_LD + col0;
#pragma unroll
                    for (int bj = 0; bj < 2; ++bj) { const f32x4 v0 = acc[ai][bj][m][0], v1 = acc[ai][bj][m][1];
                        u32x4 w; w.x = pg8::cvt_pk_bf16(v0[0], v0[1]); w.y = pg8::cvt_pk_bf16(v0[2], v0[3]); w.z = pg8::cvt_pk_bf16(v1[0], v1[1]); w.w = pg8::cvt_pk_bf16(v1[2], v1[3]);
                        *(u32x4*)(rowp + bj * 128) = w; } }
        } else if (wc == 0) {
#pragma unroll
            for (int ai = 0; ai < 2; ++ai)
#pragma unroll
                for (int m = 0; m < 4; ++m) { float* rowp = AB + (size_t)(row0 + ai * 128 + m * 16) * 32 + 8 * fq;
                    *(f32x4*)(rowp) = acc[ai][0][m][0]; *(f32x4*)(rowp + 4) = acc[ai][0][m][1]; }
        }
    }
};
template <bool XIN_F32> struct EpiRes {
    static constexpr bool PERM = true;
    const void* xin_l; bf16* xout_l; const float* mod; float* slab;
    DI void operator()(const AccT& acc, const Unit& u, int wr, int wc, int fr, int fq) const {
        const int b = u.pm / 17, j = u.pm % 17;
        const int r0 = wr * 64 + fr, col0 = u.pn * 256 + wc * 32 + 8 * fq;
        if (j == 0) {
            float* sp = slab + ((size_t)(u.nt >> 8) * 1024 + (size_t)b * 256) * DM;
#pragma unroll
            for (int ai = 0; ai < 2; ++ai)
#pragma unroll
                for (int m = 0; m < 4; ++m) { const size_t ro = (size_t)(r0 + ai * 128 + m * 16) * DM + col0;
#pragma unroll
                    for (int bj = 0; bj < 2; ++bj) { *(f32x4*)(sp + ro + bj * 128) = acc[ai][bj][m][0]; *(f32x4*)(sp + ro + bj * 128 + 4) = acc[ai][bj][m][1]; } }
            return;
        }
        const size_t off = ((size_t)b * SEQ + (size_t)(j - 1) * 256) * DM; const float* gt = mod + b * 12288;
        f32x4 gv[2][2];
#pragma unroll
        for (int bj = 0; bj < 2; ++bj)
#pragma unroll
            for (int n = 0; n < 2; ++n) gv[bj][n] = *(const f32x4*)(gt + col0 + bj * 128 + 4 * n);
#pragma unroll
        for (int ai = 0; ai < 2; ++ai)
#pragma unroll
            for (int m = 0; m < 4; ++m) { const size_t ro = off + (size_t)(r0 + ai * 128 + m * 16) * DM + col0;
#pragma unroll
                for (int bj = 0; bj < 2; ++bj) { f32x4 x0, x1;
                    if (XIN_F32) { x0 = *(const f32x4*)((const float*)xin_l + ro + bj * 128); x1 = *(const f32x4*)((const float*)xin_l + ro + bj * 128 + 4); }
                    else { const u32x4 w = *(const u32x4*)((const bf16*)xin_l + ro + bj * 128); x0 = (f32x4){lo16(w.x), hi16(w.x), lo16(w.y), hi16(w.y)}; x1 = (f32x4){lo16(w.z), hi16(w.z), lo16(w.w), hi16(w.w)}; }
                    const f32x4 o0 = x0 + gv[bj][0] * acc[ai][bj][m][0], o1 = x1 + gv[bj][1] * acc[ai][bj][m][1];
                    u32x4 w; w.x = pg8::cvt_pk_bf16(o0[0], o0[1]); w.y = pg8::cvt_pk_bf16(o0[2], o0[3]); w.z = pg8::cvt_pk_bf16(o1[0], o1[1]); w.w = pg8::cvt_pk_bf16(o1[2], o1[3]);
                    *(u32x4*)(xout_l + ro + bj * 128) = w; } }
    }
};
struct EpiSwiglu {
    static constexpr bool PERM = true;
    bf16* O;
    DI void operator()(const AccT& acc, const Unit& u, int wr, int wc, int fr, int fq) const {
        const int row0 = u.pm * 256 + wr * 64 + fr, col0 = u.pn * 128 + wc * 32 + 8 * fq;
#pragma unroll
        for (int ai = 0; ai < 2; ++ai)
#pragma unroll
            for (int m = 0; m < 4; ++m) { bf16* rowp = O + (size_t)(row0 + ai * 128 + m * 16) * DFF + col0;
                float v[8];
#pragma unroll
                for (int n = 0; n < 2; ++n)
#pragma unroll
                    for (int j = 0; j < 4; ++j) { const float a = acc[ai][0][m][n][j], b = acc[ai][1][m][n][j]; v[n * 4 + j] = a / (1.f + __expf(-a)) * b; }
                u32x4 w; w.x = pg8::cvt_pk_bf16(v[0], v[1]); w.y = pg8::cvt_pk_bf16(v[2], v[3]); w.z = pg8::cvt_pk_bf16(v[4], v[5]); w.w = pg8::cvt_pk_bf16(v[6], v[7]);
                *(u32x4*)rowp = w; }
    }
};
struct EpiGlu {
    static constexpr bool PERM = true;
    const bf16* Y; bf16* O; const float* gb;
    DI void operator()(const AccT& acc, const Unit& u, int wr, int wc, int fr, int fq) const {
        const int row0 = u.pm * 256 + wr * 64 + fr, col0 = u.pn * 256 + wc * 32 + 8 * fq;
#pragma unroll
        for (int bj = 0; bj < 2; ++bj) {
            const f32x4 b0 = *(const f32x4*)(gb + col0 + bj * 128), b1 = *(const f32x4*)(gb + col0 + bj * 128 + 4);
#pragma unroll
            for (int ai = 0; ai < 2; ++ai)
#pragma unroll
                for (int m = 0; m < 4; ++m) { const size_t r = (size_t)(row0 + ai * 128 + m * 16);
                    const u32x4 yw = *(const u32x4*)(Y + r * 1024 + col0 + bj * 128);
                    const f32x4 v0 = acc[ai][bj][m][0] + b0, v1 = acc[ai][bj][m][1] + b1;
                    float o[8];
                    o[0] = lo16(yw.x) * sigmoidf_(v0[0]); o[1] = hi16(yw.x) * sigmoidf_(v0[1]); o[2] = lo16(yw.y) * sigmoidf_(v0[2]); o[3] = hi16(yw.y) * sigmoidf_(v0[3]);
                    o[4] = lo16(yw.z) * sigmoidf_(v1[0]); o[5] = hi16(yw.z) * sigmoidf_(v1[1]); o[6] = lo16(yw.w) * sigmoidf_(v1[2]); o[7] = hi16(yw.w) * sigmoidf_(v1[3]);
                    u32x4 w; w.x = pg8::cvt_pk_bf16(o[0], o[1]); w.y = pg8::cvt_pk_bf16(o[2], o[3]); w.z = pg8::cvt_pk_bf16(o[4], o[5]); w.w = pg8::cvt_pk_bf16(o[6], o[7]);
                    *(u32x4*)(O + r * 2048 + col0 + bj * 128) = w; }
        }
    }
};
struct EpiGate {
    static constexpr bool PERM = true;
    const bf16* X; bf16* LA; bf16* BB; const float* ba; const float* bx; const float* spl;
    DI void operator()(const AccT& acc, const Unit& u, int wr, int wc, int fr, int fq) const {
        const int dir = u.pn >> 3, blk = u.pn & 7;
        const int row0 = u.pm * 256 + wr * 64 + fr, ch0 = blk * 128 + wc * 32 + 8 * fq;
        const f32x4 ba0 = *(const f32x4*)(ba + dir * 1024 + ch0), ba1 = *(const f32x4*)(ba + dir * 1024 + ch0 + 4);
        const f32x4 bx0 = *(const f32x4*)(bx + dir * 1024 + ch0), bx1 = *(const f32x4*)(bx + dir * 1024 + ch0 + 4);
        const f32x4 sp0 = *(const f32x4*)(spl + dir * 1024 + ch0), sp1 = *(const f32x4*)(spl + dir * 1024 + ch0 + 4);
#pragma unroll
        for (int ai = 0; ai < 2; ++ai)
#pragma unroll
            for (int m = 0; m < 4; ++m) { const size_t r = (size_t)(row0 + ai * 128 + m * 16);
                const u32x4 xw = *(const u32x4*)(X + r * 1024 + ch0);
                const float xv[8] = {lo16(xw.x), hi16(xw.x), lo16(xw.y), hi16(xw.y), lo16(xw.z), hi16(xw.z), lo16(xw.w), hi16(xw.w)};
                float la[8], bb[8];
#pragma unroll
                for (int n = 0; n < 2; ++n)
#pragma unroll
                    for (int j = 0; j < 4; ++j) { const int q = n * 4 + j;
                        const float pa = acc[ai][0][m][n][j] + (n ? ba1[j] : ba0[j]), px = acc[ai][1][m][n][j] + (n ? bx1[j] : bx0[j]);
                        const float rg = __builtin_amdgcn_rcpf(1.f + __expf(-pa)), ig = __builtin_amdgcn_rcpf(1.f + __expf(-px));
                        const float l = rg * (n ? sp1[j] : sp0[j]); la[q] = l;
                        const float x2 = 2.f * l;
                        const float ser = -x2 * (1.f + x2 * 0.5f * (1.f + x2 * (1.f / 3.f) * (1.f + x2 * 0.25f * (1.f + x2 * 0.2f))));
                        const float om = x2 > -0.25f ? ser : 1.f - __expf(x2);
                        bb[q] = __builtin_sqrtf(fmaxf(om, 0.f)) * (ig * xv[q]); }
                u32x4 w; w.x = pg8::cvt_pk_bf16(la[0], la[1]); w.y = pg8::cvt_pk_bf16(la[2], la[3]); w.z = pg8::cvt_pk_bf16(la[4], la[5]); w.w = pg8::cvt_pk_bf16(la[6], la[7]);
                *(u32x4*)(LA + (r * 2 + dir) * 1024 + ch0) = w;
                w.x = pg8::cvt_pk_bf16(bb[0], bb[1]); w.y = pg8::cvt_pk_bf16(bb[2], bb[3]); w.z = pg8::cvt_pk_bf16(bb[4], bb[5]); w.w = pg8::cvt_pk_bf16(bb[6], bb[7]);
                *(u32x4*)(BB + (r * 2 + dir) * 1024 + ch0) = w; }
    }
};
struct EpiRope {
    static constexpr bool PERM = true;
    bf16* O; const f32x2* rope;
    DI void operator()(const AccT& acc, const Unit& u, int wr, int wc, int fr, int fq) const {
        const int row0 = u.pm * 256 + wr * 64 + fr, col0 = u.pn * 256 + wc * 32 + 8 * fq;
        const int jt = u.pm % 17;
        const bool isqk = u.pn < 8, lat = jt != 0;
        const float sc = (u.pn >= 4 && u.pn < 8) ? 0.0625f : 1.f;
#pragma unroll
        for (int ai = 0; ai < 2; ++ai)
#pragma unroll
            for (int m = 0; m < 4; ++m) { const int rl = wr * 64 + fr + ai * 128 + m * 16;
                bf16* rowp = O + (size_t)(u.pm * 256 + rl) * INB_LD + col0;
                float t1[8], t2[8];
#pragma unroll
                for (int n = 0; n < 2; ++n)
#pragma unroll
                    for (int j = 0; j < 4; ++j) { t1[n * 4 + j] = acc[ai][0][m][n][j]; t2[n * 4 + j] = acc[ai][1][m][n][j]; }
                if (isqk && lat) {
                    const int pos = (jt - 1) * 256 + rl;
                    const int p = (wc < 2) ? (pos >> 6) : (pos & 63);
                    const int f0 = (wc & 1) * 32 + 8 * fq;
                    const f32x4* rp = (const f32x4*)(rope + p * 64 + f0);
#pragma unroll
                    for (int q = 0; q < 4; ++q) { const f32x4 cs = rp[q];
                        const float a0 = t1[2 * q], b0 = t2[2 * q], a1 = t1[2 * q + 1], b1 = t2[2 * q + 1];
                        t1[2 * q] = a0 * cs[0] - b0 * cs[1]; t2[2 * q] = a0 * cs[1] + b0 * cs[0];
                        t1[2 * q + 1] = a1 * cs[2] - b1 * cs[3]; t2[2 * q + 1] = a1 * cs[3] + b1 * cs[2]; }
                }
                u32x4 w; w.x = pg8::cvt_pk_bf16(t1[0] * sc, t1[1] * sc); w.y = pg8::cvt_pk_bf16(t1[2] * sc, t1[3] * sc); w.z = pg8::cvt_pk_bf16(t1[4] * sc, t1[5] * sc); w.w = pg8::cvt_pk_bf16(t1[6] * sc, t1[7] * sc);
                *(u32x4*)(rowp) = w;
                w.x = pg8::cvt_pk_bf16(t2[0] * sc, t2[1] * sc); w.y = pg8::cvt_pk_bf16(t2[2] * sc, t2[3] * sc); w.z = pg8::cvt_pk_bf16(t2[4] * sc, t2[5] * sc); w.w = pg8::cvt_pk_bf16(t2[6] * sc, t2[7] * sc);
                *(u32x4*)(rowp + 128) = w; }
    }
};

#define XB_TMO      128
#define XB_XCNT(j)  (256  + 64 * (j))
#define XB_XSUB(j)  (1280 + 64 * (j))
#define XB_XGEN(j)  (2304 + 64 * (j))
#define XB_TOP      3328
#define XB_TOPGEN   3392
#define XCD_BAR_WORDS 3456
#define XB_SPIN_CAP (1u << 22)
__device__ __forceinline__ unsigned xb_ld(unsigned* p)              { return __hip_atomic_load(p, __ATOMIC_RELAXED, __HIP_MEMORY_SCOPE_AGENT); }
__device__ __forceinline__ unsigned xb_add(unsigned* p, unsigned v) { return __hip_atomic_fetch_add(p, v, __ATOMIC_RELAXED, __HIP_MEMORY_SCOPE_AGENT); }
__device__ __forceinline__ unsigned xb_xcc_id() { return (unsigned)__builtin_amdgcn_s_getreg((3 << 11) | 20) & 0xFu; }
#define XB_SPIN(cond, bar) do { unsigned _sp = 0; while (cond) { __builtin_amdgcn_s_sleep(1); \
    if ((++_sp & 255u) == 0u) { if (xb_ld(&(bar)[XB_TMO])) break; if (_sp > XB_SPIN_CAP) { atomicAdd(&(bar)[XB_TMO], 1u); break; } } } } while (0)
struct XcdBarrier { unsigned* bar; unsigned x; volatile LAS unsigned* st; };
__device__ __forceinline__ XcdBarrier xcd_barrier_post(unsigned* bar, volatile LAS unsigned* st) {
    XcdBarrier b; b.bar = bar; b.x = xb_xcc_id(); b.st = st;
    if (threadIdx.x == 0) (void)xb_add(&bar[XB_XCNT(b.x)], 1u);
    return b;
}
__device__ __forceinline__ void xcd_barrier_complete(unsigned* bar, unsigned x, unsigned& nloc, unsigned& nx) {
    const unsigned G = gridDim.x * gridDim.y * gridDim.z;
    unsigned sum, cnt, mine, sp = 0u;
    for (;;) {
        sum = 0u; cnt = 0u; mine = 0u;
#pragma unroll
        for (unsigned j = 0; j < 16; ++j) { const unsigned c = xb_ld(&bar[XB_XCNT(j)]); sum += c; cnt += (c > 0u) ? 1u : 0u; mine = (j == x) ? c : mine; }
        if (sum == G) break;
        __builtin_amdgcn_s_sleep(1);
        if ((++sp & 255u) == 0u) { if (xb_ld(&bar[XB_TMO])) break; if (sp > XB_SPIN_CAP) { atomicAdd(&bar[XB_TMO], 1u); break; } }
    }
    nloc = mine > 0u ? mine : 1u; nx = cnt > 0u ? cnt : 1u;
}
__device__ __forceinline__ void xcd_barrier(const XcdBarrier& b) {
    asm volatile("s_waitcnt vmcnt(0)" ::: "memory");
    __syncthreads();
    if (threadIdx.x == 0) {
        unsigned* bar = b.bar;
        __builtin_amdgcn_s_waitcnt(0);
        unsigned nloc = b.st[0], nx = b.st[1];
        if (nloc == 0u) { xcd_barrier_complete(bar, b.x, nloc, nx); b.st[0] = nloc; b.st[1] = nx; }
        const unsigned old = xb_add(&bar[XB_XSUB(b.x)], 1u);
        const unsigned gen = old / nloc;
        if (old + 1u == (gen + 1u) * nloc) {
            __builtin_amdgcn_fence(__ATOMIC_RELEASE, "agent");
            asm volatile("s_waitcnt vmcnt(0)" ::: "memory");
            const unsigned og = xb_add(&bar[XB_TOP], 1u);
            const unsigned tg = og / nx;
            if (og + 1u == (tg + 1u) * nx) xb_add(&bar[XB_TOPGEN], 1u);
            else XB_SPIN(xb_ld(&bar[XB_TOPGEN]) == tg, bar);
            __builtin_amdgcn_fence(__ATOMIC_ACQUIRE, "agent");
            xb_add(&bar[XB_XGEN(b.x)], 1u);
            asm volatile("s_waitcnt vmcnt(0)" ::: "memory");
        } else {
            XB_SPIN(xb_ld(&bar[XB_XGEN(b.x)]) == gen, bar);
            __builtin_amdgcn_fence(__ATOMIC_ACQUIRE, "agent");
            asm volatile("s_waitcnt vmcnt(0)" ::: "memory");
        }
    }
    __syncthreads();
}

struct Args { const float* in[38]; float* out; unsigned char* ws; int ph_lo, ph_hi; };
enum { I_X = 0, I_C, I_CTX, I_CCTX, I_MODW, I_MODB, I_N1G, I_N2G, I_W1, I_W3, I_W2, I_FING, I_EWIN, I_EWOUT, I_LRE, I_LIM, I_LSTEP, I_BRE, I_BIM, I_CRE, I_CIM,
       I_S5D, I_GLUW, I_GLUB, I_DNCW, I_DNALOG, I_DNDT, I_DNNG, I_OWIN, I_OWOUT, I_LCW, I_LCB, I_LWA, I_LBA, I_LWX, I_LBX, I_LLAM, I_RTH };

constexpr int LDS_RING = 131072, LDS_CTL_OFF = 131072, LDS_BYTES = 147456;
constexpr int NW = 8;

DI void transpose_item(const float* W, int ldw, int k0, int n_src0, bf16* WT, int ldk, int dst_row0, LAS float* scr, int lane) {
#pragma unroll 8
    for (int i = 0; i < 32; ++i) { const int kk = 2 * i + (lane >> 5); scr[kk * 33 + (lane & 31)] = W[(size_t)(k0 + kk) * ldw + n_src0 + (lane & 31)]; }
    LDS_WAIT();
    const int c = lane & 7;
#pragma unroll
    for (int j = 0; j < 4; ++j) { const int n = (lane >> 3) + 8 * j; const LAS float* s = scr + (8 * c) * 33 + n;
        u32x4 o; o.x = pk2(s[0 * 33], s[1 * 33]); o.y = pk2(s[2 * 33], s[3 * 33]); o.z = pk2(s[4 * 33], s[5 * 33]); o.w = pk2(s[6 * 33], s[7 * 33]);
        *(u32x4*)(WT + (size_t)(dst_row0 + n) * ldk + k0 + 8 * c) = o; }
    LDS_WAIT();
}
DI void transpose_job(int it, const float* W, int K, int N, bf16* WT, int mode, int add, LAS float* scr, int lane) {
    const int nblk = N / 32, kb = it / nblk, nb = it % nblk, n0 = nb * 32;
    const int dr = mode ? ((n0 >> 7) * 256 + (n0 & 127) + add) : n0;
    transpose_item(W, N, kb * 64, n0, WT, K, dr, scr, lane);
}


#define BGW_ITEMS 67584
#define BGW_DECODE(it, LAYER) \
    const int job_ = (it) / 22528, idx_ = (it) - job_ * 22528; \
    const int KK_ = job_ < 2 ? 2048 : 5632, NN_ = job_ < 2 ? 5632 : 2048, kbs_ = KK_ >> 3; \
    const int nblk_ = idx_ / kbs_, kblk_ = idx_ - nblk_ * kbs_, n_ = nblk_ * 64 + lane; \
    const float* src_ = args.in[job_ == 0 ? I_W1 : (job_ == 1 ? I_W3 : I_W2)] + (size_t)(LAYER) * 2048 * 5632 + (size_t)(kblk_ * 8) * NN_ + n_; \
    const int row_ = job_ < 2 ? ((n_ >> 7) * 256 + (n_ & 127) + (job_ == 1 ? 128 : 0)) : n_; \
    bf16* dst_ = (bf16*)(WB + (job_ < 2 ? W_UP : W_DN)) + (size_t)row_ * KK_ + kblk_ * 8;
#define BGW_ISSUE(it, LAYER) do { if ((it) < BGW_ITEMS) { BGW_DECODE(it, LAYER) (void)dst_; \
        _Pragma("unroll") for (int e_ = 0; e_ < 8; ++e_) bgv[e_] = src_[(size_t)e_ * NN_]; bg_cur = (it); } else bg_cur = -1; } while (0)
#define BGW_STORE(LAYER) do { if (bg_cur >= 0) { BGW_DECODE(bg_cur, LAYER) (void)src_; \
        u32x4 w_; w_.x = pk2(bgv[0], bgv[1]); w_.y = pk2(bgv[2], bgv[3]); w_.z = pk2(bgv[4], bgv[5]); w_.w = pk2(bgv[6], bgv[7]); *(u32x4*)dst_ = w_; bg_cur = -1; } } while (0)

__global__ void __launch_bounds__(512, 2) fwd_kernel(Args args) {
    extern __shared__ __attribute__((aligned(16))) unsigned char lds_raw[];
    LAS unsigned char* lds = (LAS unsigned char*)lds_raw;
    const int tid0 = threadIdx.x;
    const int G = gridDim.x, bid = blockIdx.x;
    const int NGW = G * NW;
    unsigned char* ws = args.ws;
    float* MOD = (float*)(ws + WS_MOD);
    float* XC = (float*)(ws + WS_XC);
    bf16* XLb = (bf16*)(ws + WS_BIG + 340 * MiB);
    bf16* Hb = (bf16*)(ws + WS_H);
    bf16* MIX = (bf16*)(ws + WS_MIX);
    unsigned char* BIG = ws + WS_BIG;
    unsigned char* WB = ws + WS_W;
    float* SLAB = (float*)(BIG + 200 * MiB);
    float* T_ABAR = (float*)(ws + WS_TAB); float* T_APOW = (float*)(ws + WS_TAB + 65536); f32x2* T_ROPE = (f32x2*)(ws + WS_TAB + 131072);
    float* T_SPL = (float*)(ws + WS_TAB + 163840);
    float* T_BBR = (float*)(ws + WS_XC); float* T_BBI = (float*)(ws + WS_XC + MiB / 2);
    bf16* T_BBF = (bf16*)(ws + WS_TAB + MiB);
    bf16* T_CF = (bf16*)(ws + WS_TAB + MiB + MiB / 2);

    volatile LAS unsigned* CTLW = (volatile LAS unsigned*)(lds + LDS_CTL_OFF);
    for (int u = tid0; u < (LDS_BYTES - LDS_CTL_OFF) / 4; u += 512) CTLW[u] = 0u;
    __syncthreads();
#if MK_ONE_LAUNCH
    XcdBarrier bar = xcd_barrier_post((unsigned*)(ws + WS_CTL) + 4096, CTLW + 8);
#define SEAM() xcd_barrier(bar)
#else
#define SEAM() do {} while (0)
#endif
    const int lo = args.ph_lo, hi = args.ph_hi;
    int ph = 0;
#define PHASE_BEGIN if (ph >= lo && ph < hi) { int tid = tid0; asm volatile("" : "+v"(tid)); const int lane = tid & 63, wave = __builtin_amdgcn_readfirstlane(tid >> 6), gw = bid * NW + wave; (void)lane; (void)gw;
#define PHASE_END   if (ph + 1 < hi) SEAM(); } ++ph;

    PHASE_BEGIN
    {
        LAS float* sc = (LAS float*)lds;
        LAS float* red = (LAS float*)(lds + 40960);
        if (bid < 96) {
            for (int i = tid; i < 5 * 2048; i += 512) { const int r = i >> 11, k = i & 2047; const float v = r < 4 ? args.in[I_C][r * 2048 + k] : args.in[I_CCTX][k]; sc[i] = siluf_(v); }
            __syncthreads();
            for (int cb = bid; cb < 96; cb += G) {
                const int n0 = cb * 256, layer = n0 / 12288, nn = n0 % 12288;
                const float* W = args.in[I_MODW] + (size_t)layer * 2048 * 12288 + nn + lane * 4;
                float a[5][4];
#pragma unroll
                for (int r = 0; r < 5; ++r)
#pragma unroll
                    for (int j = 0; j < 4; ++j) a[r][j] = 0.f;
                const int kb = wave * 256;
#pragma unroll 8
                for (int k = kb; k < kb + 256; ++k) { const f32x4 w = *(const f32x4*)(W + (size_t)k * 12288);
#pragma unroll
                    for (int r = 0; r < 5; ++r) { const float s = sc[r * 2048 + k];
#pragma unroll
                        for (int j = 0; j < 4; ++j) a[r][j] += s * w[j]; } }
#pragma unroll
                for (int r = 0; r < 5; ++r)
#pragma unroll
                    for (int j = 0; j < 4; ++j) red[(wave * 5 + r) * 256 + lane * 4 + j] = a[r][j];
                __syncthreads();
                for (int i = tid; i < 5 * 256; i += 512) { const int r = i >> 8, cc = i & 255; float s = args.in[I_MODB][layer * 12288 + nn + cc];
#pragma unroll
                    for (int w = 0; w < 8; ++w) s += red[(w * 5 + r) * 256 + cc];
                    MOD[(size_t)(layer * 5 + r) * 12288 + nn + cc] = s; }
                __syncthreads();
            }
        }
        for (int i = bid * 512 + tid; i < 2 * 64 * 64 * 16; i += G * 512) {
            const int s = i & 15, p = (i >> 4) & 63, g = (i >> 10) & 63, d = i >> 16;
            const int ip = (d * 64 + g) * 64 + p;
            const float lre = fminf(args.in[I_LRE][ip], -1e-4f), lim = args.in[I_LIM][ip];
            const float dt = expf(args.in[I_LSTEP][d * 64 + g]);
            const float mag = expf(lre * dt); const float ar = mag * cosf(lim * dt), ai = mag * sinf(lim * dt);
            const float nr = ar - 1.f, ni = ai, den = lre * lre + lim * lim;
            const float cre = (nr * lre + ni * lim) / den, cim = (ni * lre - nr * lim) / den;
            const float br = args.in[I_BRE][(size_t)ip * 16 + s], bi = args.in[I_BIM][(size_t)ip * 16 + s];
            T_BBR[(size_t)ip * 16 + s] = cre * br - cim * bi; T_BBI[(size_t)ip * 16 + s] = cre * bi + cim * br;
            T_BBF[((size_t)(d * 64 + g) * 128 + p) * 16 + s] = (bf16)f2bf(cre * br - cim * bi); T_BBF[((size_t)(d * 64 + g) * 128 + 64 + p) * 16 + s] = (bf16)f2bf(cre * bi + cim * br);
            T_CF[((size_t)(d * 64 + g) * 16 + s) * 128 + p] = (bf16)f2bf(args.in[I_CRE][((size_t)(d * 64 + g) * 16 + s) * 64 + p]); T_CF[((size_t)(d * 64 + g) * 16 + s) * 128 + 64 + p] = (bf16)f2bf(-args.in[I_CIM][((size_t)(d * 64 + g) * 16 + s) * 64 + p]);
            if (s == 0) { T_ABAR[ip * 2] = ar; T_ABAR[ip * 2 + 1] = ai; float pr = ar, pi = ai;
#pragma unroll
                for (int q = 0; q < 6; ++q) { const float tr = pr * pr - pi * pi, ti = 2.f * pr * pi; pr = tr; pi = ti; }
                T_APOW[ip * 2] = pr; T_APOW[ip * 2 + 1] = pi; }
        }
        for (int i = bid * 512 + tid; i < 4096; i += G * 512) { const int p = i >> 6, f = i & 63; const float inv = powf(10000.f, -(float)f / 64.f); const float ang = (float)p * inv;
            f32x2 v; v.x = cosf(ang); v.y = sinf(ang); T_ROPE[i] = v; }
        for (int i = bid * 512 + tid; i < 2048; i += G * 512) T_SPL[i] = -8.f * softplusf_(-args.in[I_LLAM][i]);
        __syncthreads();
        LAS float* scr = (LAS float*)(lds + wave * 16384);
        constexpr int J0 = 32 * 161, J1 = 32 * 64, J2 = 16 * 32, J3 = 32 * 176, J4 = J3, J5 = 88 * 64;
        (void)J3; (void)J4; (void)J5;
        for (int it = gw; it < J0 + J1 + J2; it += NGW) {
            int r = it;
            if (r < J0) { transpose_job(r, args.in[I_EWIN], 2048, 5152, (bf16*)(WB + W_IN), 0, 0, scr, lane); continue; } r -= J0;
            if (r < J1) { transpose_job(r, args.in[I_EWOUT], 2048, 2048, (bf16*)(WB + W_OUT), 0, 0, scr, lane); continue; } r -= J1;
            transpose_job(r, args.in[I_GLUW], 1024, 1024, (bf16*)(WB + W_GLU), 0, 0, scr, lane);
        }
    }
    PHASE_END

#define ADALN(LAYER, WHICH, SRCBF, SRC_L, SRC_C, LATONLY, SLABP, SGATE) \
    for (int R = gw; R < MROWS; R += NGW) { const int b = R / SROW, s = R % SROW; const bool cx = s < CTX; if ((LATONLY) && cx) continue; \
        const float* md = MOD + (size_t)((LAYER) * 5 + (cx ? 4 : b)) * 12288 + (WHICH) * 3 * 2048; \
        const float* gn = args.in[(WHICH) ? I_N2G : I_N1G] + (LAYER) * 2048; \
        f32x4 v[8]; float ss = 0.f; \
        if ((SRCBF) && !cx) { const bf16* srcb = (const bf16*)(SRC_L) + ((size_t)b * SEQ + (s - CTX)) * DM; \
            _Pragma("unroll") for (int j = 0; j < 8; ++j) { const u32x2 w = *(const u32x2*)(srcb + lane * 4 + j * 256); v[j] = (f32x4){lo16(w.x), hi16(w.x), lo16(w.y), hi16(w.y)}; } } \
        else { const float* src = cx ? (SRC_C) + ((size_t)b * CTX + s) * DM : (const float*)(SRC_L) + ((size_t)b * SEQ + (s - CTX)) * DM; \
            _Pragma("unroll") for (int j = 0; j < 8; ++j) v[j] = *(const f32x4*)(src + lane * 4 + j * 256); } \
        if ((SLABP) != nullptr && cx) { const size_t crow = (size_t)b * CTX + s; \
            _Pragma("unroll") for (int j = 0; j < 8; ++j) { const int c = lane * 4 + j * 256; f32x4 a = (f32x4){0.f, 0.f, 0.f, 0.f}; \
                _Pragma("unroll") for (int sp = 0; sp < 8; ++sp) a += *(const f32x4*)((SLABP) + ((size_t)sp * 1024 + crow) * DM + c); \
                v[j] = v[j] + *(const f32x4*)((SGATE) + c) * a; *(f32x4*)(XC + crow * DM + c) = v[j]; } } \
        _Pragma("unroll") for (int j = 0; j < 8; ++j) ss += (v[j][0] * v[j][0] + v[j][1] * v[j][1]) + (v[j][2] * v[j][2] + v[j][3] * v[j][3]); \
        const float rstd = 1.f / sqrtf(wave_sum(ss) * (1.f / DM) + EPS); \
        _Pragma("unroll") for (int j = 0; j < 8; ++j) { const int c = lane * 4 + j * 256; const f32x4 gg = *(const f32x4*)(gn + c), sh = *(const f32x4*)(md + c), sl = *(const f32x4*)(md + 2048 + c); \
            const f32x4 o = v[j] * rstd * gg * (sl + 1.f) + sh; u32x2 w; w.x = pk2(o[0], o[1]); w.y = pk2(o[2], o[3]); *(u32x2*)(Hb + (size_t)R * DM + c) = w; } }

    PHASE_BEGIN
    ADALN(0, 0, false, args.in[I_X], args.in[I_CTX], false, (const float*)nullptr, (const float*)nullptr)
    PHASE_END

    PHASE_BEGIN
    { pg8::Gemm g{Hb, (const bf16*)(WB + W_IN), DM, DM, DM}; pg8::StaticOrder S; S.init(68, 21, G, bid, 0);
      EpiIn0 E{(bf16*)(BIG + B_IN0), (float*)(BIG + B_AB)};
      pg8::gemm_phase<EpiIn0>(lds, g, S, E); }
    PHASE_END

#define S5_PASS(READOUT) { \
        const bf16* IN0 = (const bf16*)(BIG + B_IN0); \
        LAS float* BU = (LAS float*)(lds + wave * 12800); LAS unsigned char* HB = lds + wave * 12800 + 8448; \
        const int r = lane & 15, q = lane >> 4; \
        const int NU = (READOUT) ? NB * 64 * NCH : NB * 64 * 2 * NCH; \
        for (int unit = gw; unit < NU; unit += NGW) { \
            const int c = unit % NCH; int rest = unit / NCH; const int g = rest & 63; rest >>= 6; \
            int dsel = 0, b; if (READOUT) b = rest; else { dsel = rest & 1; b = rest >> 1; } \
            const int R0 = b * SROW + c * 64; \
            bf16x8 Uf[4]; \
            _Pragma("unroll") for (int tt = 0; tt < 4; ++tt) { Uf[tt] = (bf16x8){0, 0, 0, 0, 0, 0, 0, 0}; if (q < 2) Uf[tt] = *(const bf16x8*)(IN0 + (size_t)(R0 + 16 * tt + r) * IN0_LD + g * 16 + 8 * q); } \
            f32x4 Y[4]; \
            _Pragma("unroll") for (int tt = 0; tt < 4; ++tt) Y[tt] = (f32x4){0.f, 0.f, 0.f, 0.f}; \
            for (int dd = 0; dd < ((READOUT) ? 2 : 1); ++dd) { \
                const int dir = (READOUT) ? dd : dsel; \
                bf16x8 Bf[8], Cf[4]; \
                _Pragma("unroll") for (int pt = 0; pt < 8; ++pt) { Bf[pt] = (bf16x8){0, 0, 0, 0, 0, 0, 0, 0}; if (q < 2) Bf[pt] = *(const bf16x8*)(T_BBF + ((size_t)(dir * 64 + g) * 128 + 16 * pt + r) * 16 + 8 * q); } \
                if (READOUT) { _Pragma("unroll") for (int ks = 0; ks < 4; ++ks) Cf[ks] = *(const bf16x8*)(T_CF + ((size_t)(dir * 64 + g) * 16 + r) * 128 + 32 * ks + 8 * q); } \
                const int ip = (dir * 64 + g) * 64 + lane; \
                const float ar = T_ABAR[ip * 2], ai = T_ABAR[ip * 2 + 1]; \
                float hr = 0.f, hi = 0.f; \
                if (READOUT) { const float* st = (const float*)(BIG + B_S5S) + ((((size_t)(b * 64 + g) * 2 + dir) * NCH + c) * 64 + lane) * 2; hr = st[0]; hi = st[1]; } \
                for (int ti = 0; ti < 4; ++ti) { const int tt = dir ? 3 - ti : ti; \
                    _Pragma("unroll") for (int pt = 0; pt < 8; ++pt) { const f32x4 cc = MFMA16(Uf[tt], Bf[pt], ((f32x4){0.f, 0.f, 0.f, 0.f})); \
                        _Pragma("unroll") for (int jj = 0; jj < 4; ++jj) BU[(4 * q + jj) * 132 + 16 * pt + r] = cc[jj]; } \
                    LDS_WAIT(); \
                    _Pragma("unroll") for (int i = 0; i < 16; ++i) { const int tl = dir ? 15 - i : i; \
                        const float bur = BU[tl * 132 + lane], bui = BU[tl * 132 + 64 + lane]; \
                        const float nr = ar * hr - ai * hi + bur, ni = ar * hi + ai * hr + bui; hr = nr; hi = ni; \
                        if (READOUT) { *(LAS bf16*)(HB + tl * 272 + lane * 2) = (bf16)f2bf(hr); *(LAS bf16*)(HB + tl * 272 + 128 + lane * 2) = (bf16)f2bf(hi); } } \
                    if (READOUT) { LDS_WAIT(); \
                        _Pragma("unroll") for (int ks = 0; ks < 4; ++ks) Y[tt] = MFMA16(frag_rows(HB, 272, 0, 32 * ks, r, q), Cf[ks], Y[tt]); } \
                    LDS_WAIT(); \
                } \
                if (!(READOUT)) { float* e = (float*)(BIG + B_S5E) + ((((size_t)(b * 64 + g) * 2 + dir) * NCH + c) * 64 + lane) * 2; e[0] = hr; e[1] = hi; } \
            } \
            if (READOUT) { const float dsk = args.in[I_S5D][g * 16 + r]; \
                _Pragma("unroll") for (int tt = 0; tt < 4; ++tt) \
                    _Pragma("unroll") for (int jj = 0; jj < 4; ++jj) { const size_t R = (size_t)(R0 + 16 * tt + 4 * q + jj); const float uu = bf2f(IN0[R * IN0_LD + g * 16 + r]); \
                        ((bf16*)(BIG + B_S5Y))[R * 1024 + g * 16 + r] = (bf16)f2bf(gelu_tanh(Y[tt][jj] + dsk * uu)); } } \
        } }

#define S5_PASS_OLD(READOUT) { \
        const bf16* IN0 = (const bf16*)(BIG + B_IN0); \
        LAS float* ubuf = (LAS float*)(lds + wave * 12288); LAS float* ybuf = ubuf + 1024; LAS float* hbuf = ubuf + 2048; \
        const int NU = (READOUT) ? NB * 64 * NCH : NB * 64 * 2 * NCH; \
        for (int unit = gw; unit < NU; unit += NGW) { \
            const int c = unit % NCH; int rest = unit / NCH; const int g = rest & 63; rest >>= 6; \
            int dsel = 0, b; if (READOUT) b = rest; else { dsel = rest & 1; b = rest >> 1; } \
            const int R0 = b * SROW + c * 64; \
            { const u32x4* up = (const u32x4*)(IN0 + (size_t)(R0 + lane) * IN0_LD + g * 16); const u32x4 w0 = up[0], w1 = up[1]; \
              f32x4 f; f = (f32x4){lo16(w0.x), hi16(w0.x), lo16(w0.y), hi16(w0.y)}; *(LAS f32x4*)(ubuf + lane * 16) = f; \
              f = (f32x4){lo16(w0.z), hi16(w0.z), lo16(w0.w), hi16(w0.w)}; *(LAS f32x4*)(ubuf + lane * 16 + 4) = f; \
              f = (f32x4){lo16(w1.x), hi16(w1.x), lo16(w1.y), hi16(w1.y)}; *(LAS f32x4*)(ubuf + lane * 16 + 8) = f; \
              f = (f32x4){lo16(w1.z), hi16(w1.z), lo16(w1.w), hi16(w1.w)}; *(LAS f32x4*)(ubuf + lane * 16 + 12) = f; } \
            LDS_WAIT(); \
            for (int dd = 0; dd < ((READOUT) ? 2 : 1); ++dd) { \
                const int dir = (READOUT) ? dd : dsel; \
                const int ip = (dir * 64 + g) * 64 + lane; \
                float bbr[16], bbi[16]; \
                _Pragma("unroll") for (int q = 0; q < 4; ++q) { const f32x4 x = *(const f32x4*)(T_BBR + (size_t)ip * 16 + 4 * q), y = *(const f32x4*)(T_BBI + (size_t)ip * 16 + 4 * q); \
                    _Pragma("unroll") for (int j = 0; j < 4; ++j) { bbr[4 * q + j] = x[j]; bbi[4 * q + j] = y[j]; } } \
                const float ar = T_ABAR[ip * 2], ai = T_ABAR[ip * 2 + 1]; \
                float cr[16], ci[16]; const int so = lane & 15, pq = lane >> 4; \
                if (READOUT) { const size_t co = ((size_t)(dir * 64 + g) * 16 + so) * 64 + pq * 16; \
                    _Pragma("unroll") for (int q = 0; q < 4; ++q) { const f32x4 x = *(const f32x4*)(args.in[I_CRE] + co + 4 * q), y = *(const f32x4*)(args.in[I_CIM] + co + 4 * q); \
                        _Pragma("unroll") for (int j = 0; j < 4; ++j) { cr[4 * q + j] = x[j]; ci[4 * q + j] = y[j]; } } } \
                float hr = 0.f, hi = 0.f; \
                if (READOUT) { const float* st = (const float*)(BIG + B_S5S) + ((((size_t)(b * 64 + g) * 2 + dir) * NCH + c) * 64 + lane) * 2; hr = st[0]; hi = st[1]; } \
                for (int tb = 0; tb < 16; ++tb) { \
                    _Pragma("unroll") for (int tt = 0; tt < 4; ++tt) { const int ti = tb * 4 + tt, t = dir ? 63 - ti : ti; \
                        float bur = 0.f, bui = 0.f; \
                        _Pragma("unroll") for (int q = 0; q < 4; ++q) { const f32x4 uu = *(const LAS f32x4*)(ubuf + t * 16 + 4 * q); \
                            _Pragma("unroll") for (int j = 0; j < 4; ++j) { bur += bbr[4 * q + j] * uu[j]; bui += bbi[4 * q + j] * uu[j]; } } \
                        const float nr = ar * hr - ai * hi + bur, ni = ar * hi + ai * hr + bui; hr = nr; hi = ni; \
                        if (READOUT) { hbuf[tt * 128 + lane] = hr; hbuf[tt * 128 + 64 + lane] = hi; } } \
                    if (READOUT) { LDS_WAIT(); \
                        _Pragma("unroll") for (int tt = 0; tt < 4; ++tt) { const int ti = tb * 4 + tt, t = dir ? 63 - ti : ti; float a = 0.f; \
                            _Pragma("unroll") for (int q = 0; q < 4; ++q) { const f32x4 xr = *(const LAS f32x4*)(hbuf + tt * 128 + pq * 16 + 4 * q), xi = *(const LAS f32x4*)(hbuf + tt * 128 + 64 + pq * 16 + 4 * q); \
                                _Pragma("unroll") for (int j = 0; j < 4; ++j) a += xr[j] * cr[4 * q + j] - xi[j] * ci[4 * q + j]; } \
                            a += __shfl_xor(a, 16); a += __shfl_xor(a, 32); \
                            if (pq == 0) { if (dd == 0) ybuf[t * 16 + so] = a; else ybuf[t * 16 + so] += a; } } \
                        LDS_WAIT(); } \
                } \
                if (!(READOUT)) { float* e = (float*)(BIG + B_S5E) + ((((size_t)(b * 64 + g) * 2 + dir) * NCH + c) * 64 + lane) * 2; e[0] = hr; e[1] = hi; } \
            } \
            if (READOUT) { LDS_WAIT(); float o[16]; \
                _Pragma("unroll") for (int q = 0; q < 4; ++q) { const f32x4 yv = *(const LAS f32x4*)(ybuf + lane * 16 + 4 * q), uv = *(const LAS f32x4*)(ubuf + lane * 16 + 4 * q); const f32x4 dv = *(const f32x4*)(args.in[I_S5D] + g * 16 + 4 * q); \
                    _Pragma("unroll") for (int j = 0; j < 4; ++j) o[4 * q + j] = gelu_tanh(yv[j] + dv[j] * uv[j]); } \
                u32x4 w0, w1; w0.x = pk2(o[0], o[1]); w0.y = pk2(o[2], o[3]); w0.z = pk2(o[4], o[5]); w0.w = pk2(o[6], o[7]); w1.x = pk2(o[8], o[9]); w1.y = pk2(o[10], o[11]); w1.z = pk2(o[12], o[13]); w1.w = pk2(o[14], o[15]); \
                u32x4* yp = (u32x4*)((bf16*)(BIG + B_S5Y) + (size_t)(R0 + lane) * 1024 + g * 16); yp[0] = w0; yp[1] = w1; LDS_WAIT(); } \
        } }

    PHASE_BEGIN
    for (int stg_ = 0; stg_ < 2; ++stg_) {
    if ((stg_ == 0) == (wave < 4)) {
    S5_PASS_OLD(false)
    } else {
        const bf16* IN0 = (const bf16*)(BIG + B_IN0); const float* AB = (const float*)(BIG + B_AB);
        bf16* DQ = (bf16*)(BIG + B_DNQ); bf16* DK = (bf16*)(BIG + B_DNK); bf16* DV = (bf16*)(BIG + B_DNV);
        float* DG = (float*)(BIG + B_DNG); float* DBt = (float*)(BIG + B_DNB);
        const float* cw = args.in[I_DNCW];
        int cur_combo = -1; f32x4 wv[8];
        for (int item = gw; item < MROWS * 6; item += NGW) {
            const int combo = item / MROWS, R = item - combo * MROWS, part = combo >> 1, hq = combo & 1;
            const int b = R / SROW, sx = R - b * SROW;
            const int seg_lo = sx < CTX ? 0 : CTX, seg_hi = sx < CTX ? CTX : SROW;
            const int cidx = part * 1024 + hq * 512 + lane * 8;
            if (combo != cur_combo) { cur_combo = combo;
#pragma unroll
                for (int e = 0; e < 8; ++e) wv[e] = *(const f32x4*)(cw + (size_t)(cidx + e) * 4); }
            float acc[8];
#pragma unroll
            for (int e = 0; e < 8; ++e) acc[e] = 0.f;
#pragma unroll
            for (int j = 0; j < 4; ++j) { const int sj = sx + j - 2;
                if (sj >= seg_lo && sj < seg_hi) { const u32x4 w = *(const u32x4*)(IN0 + (size_t)(b * SROW + sj) * IN0_LD + 1024 + cidx);
                    acc[0] += wv[0][j] * lo16(w.x); acc[1] += wv[1][j] * hi16(w.x); acc[2] += wv[2][j] * lo16(w.y); acc[3] += wv[3][j] * hi16(w.y);
                    acc[4] += wv[4][j] * lo16(w.z); acc[5] += wv[5][j] * hi16(w.z); acc[6] += wv[6][j] * lo16(w.w); acc[7] += wv[7][j] * hi16(w.w); } }
            float ss = 0.f;
#pragma unroll
            for (int e = 0; e < 8; ++e) { acc[e] = acc[e] * __builtin_amdgcn_rcpf(1.f + __expf(-acc[e])); ss += acc[e] * acc[e]; }
            ss += __shfl_xor(ss, 1); ss += __shfl_xor(ss, 2); ss += __shfl_xor(ss, 4); ss += __shfl_xor(ss, 8);
            const float sc = part == 0 ? 0.08838834764831845f / sqrtf(ss + EPS) : (part == 1 ? 1.f / sqrtf(ss + EPS) : 1.f);
            u32x4 o; o.x = pk2(acc[0] * sc, acc[1] * sc); o.y = pk2(acc[2] * sc, acc[3] * sc); o.z = pk2(acc[4] * sc, acc[5] * sc); o.w = pk2(acc[6] * sc, acc[7] * sc);
            bf16* dst = part == 0 ? DQ : (part == 1 ? DK : DV);
            *(u32x4*)(dst + (size_t)R * 1024 + hq * 512 + lane * 8) = o;
        }
        for (int i = bid * 512 + tid; i < MROWS * 16; i += G * 512) { const int R = i >> 4, l16 = i & 15;
            const float araw = AB[(size_t)R * 32 + l16], braw = AB[(size_t)R * 32 + 16 + l16];
            DG[i] = -expf(args.in[I_DNALOG][l16]) * softplusf_(araw + args.in[I_DNDT][l16]);
            DBt[i] = sigmoidf_(braw); }
    }
    }
    PHASE_END

    PHASE_BEGIN
    {
        for (int i = bid * 512 + tid; i < NB * 64 * 2 * 64; i += G * 512) {
            const int p = i & 63, dir = (i >> 6) & 1, bg = i >> 7, g = bg & 63;
            const int ip = (dir * 64 + g) * 64 + p; const float pr = T_APOW[ip * 2], pi = T_APOW[ip * 2 + 1];
            const float* E = (const float*)(BIG + B_S5E) + ((size_t)(bg * 2 + dir) * NCH) * 128 + p * 2;
            float* St = (float*)(BIG + B_S5S) + ((size_t)(bg * 2 + dir) * NCH) * 128 + p * 2;
            float sr = 0.f, si = 0.f;
            for (int k = 0; k < NCH; ++k) { const int c = dir == 0 ? k : (k < 4 ? 3 - k : 71 - k);
                St[c * 128] = sr; St[c * 128 + 1] = si; const float er = E[c * 128], ei = E[c * 128 + 1];
                const float nr = pr * sr - pi * si + er, ni = pr * si + pi * sr + ei; sr = nr; si = ni; }
        }
        {
            const bf16* DK = (const bf16*)(BIG + B_DNK); const float* DG = (const float*)(BIG + B_DNG); const float* DBt = (const float*)(BIG + B_DNB);
            bf16* TINV = (bf16*)((unsigned char*)MIX + MIX_TINV); bf16* WT = Hb; float* GCUM = (float*)(BIG + B_GCUM);
            constexpr int KC = 0, KB = 17408, KG = 34816, PA = 52224, PB = 61440, TA = 70656, TB = 79872, LO = 36864, WSo = 52224, GCo = 125952, BTo = 126208, RS = 272, PS = 144;
            const int r = lane & 15, q = lane >> 4, qq = r >> 2, pp = r & 3, it = wave >> 1, nh = wave & 1;
            LAS float* GC = (LAS float*)(lds + GCo); LAS float* BT = (LAS float*)(lds + BTo);
#define DN_ROW(n, row) ((size_t)b * SROW + (dir == 0 ? ((n) * 64 + (row)) : (((n) * 64 + (row)) < CTX ? CTX - 1 - ((n) * 64 + (row)) : SROW + CTX - 1 - ((n) * 64 + (row)))))
            for (int unit = bid; unit < NB * 8 * 2 * NCH; unit += G) {
                const int n = unit % NCH; int rest = unit / NCH; const int dir = rest & 1; rest >>= 1; const int h = rest & 7, b = rest >> 3;
                u32x4 kreg[2];
#pragma unroll
                for (int k = 0; k < 2; ++k) { const int id = tid + 512 * k, row = id >> 4, cp = id & 15; kreg[k] = *(const u32x4*)(DK + DN_ROW(n, row) * 1024 + h * 128 + cp * 8); }
                if (wave == 0) { const size_t R = DN_ROW(n, lane); float g = DG[R * 16 + dir * 8 + h]; const float bt = DBt[R * 16 + dir * 8 + h];
#pragma unroll
                    for (int o = 1; o < 64; o <<= 1) { const float t = __shfl_up(g, o); if (lane >= o) g += t; }
                    GC[lane] = g; BT[lane] = bt; GCUM[(size_t)unit * 64 + lane] = g; }
                __syncthreads();
#pragma unroll
                for (int k = 0; k < 2; ++k) { const int id = tid + 512 * k, row = id >> 4, cp = id & 15; const float bt = BT[row], bg = bt * __expf(GC[row]);
                    const u32x4 w = kreg[k];
                    *(LAS u32x4*)(lds + KC + row * RS + cp * 16) = w;
                    u32x4 x; x.x = pk2(lo16(w.x) * bt, hi16(w.x) * bt); x.y = pk2(lo16(w.y) * bt, hi16(w.y) * bt); x.z = pk2(lo16(w.z) * bt, hi16(w.z) * bt); x.w = pk2(lo16(w.w) * bt, hi16(w.w) * bt);
                    *(LAS u32x4*)(lds + KB + row * RS + cp * 16) = x;
                    x.x = pk2(lo16(w.x) * bg, hi16(w.x) * bg); x.y = pk2(lo16(w.y) * bg, hi16(w.y) * bg); x.z = pk2(lo16(w.z) * bg, hi16(w.z) * bg); x.w = pk2(lo16(w.w) * bg, hi16(w.w) * bg);
                    *(LAS u32x4*)(lds + KG + row * RS + cp * 16) = x; }
                __syncthreads();
#pragma unroll
                for (int e = 0; e < 2; ++e) { const int jt = 2 * nh + e; f32x4 c = (f32x4){0.f, 0.f, 0.f, 0.f};
                    if (jt <= it) {
#pragma unroll
                        for (int ks = 0; ks < 4; ++ks) c = MFMA16(frag_rows(lds + KC, RS, 16 * jt, 32 * ks, r, q), frag_rows(lds + KB, RS, 16 * it, 32 * ks, r, q), c);
                        const float gi = GC[16 * it + r]; const f32x4 gj = *(const LAS f32x4*)(GC + 16 * jt + 4 * q);
#pragma unroll
                        for (int jj = 0; jj < 4; ++jj) c[jj] = (16 * jt + 4 * q + jj < 16 * it + r) ? -c[jj] * __expf(gi - gj[jj]) : 0.f; }
                    st_hl(lds + PA + (16 * it + r) * PS + (16 * jt + 4 * q) * 2, LO, c);
                    if (jt == it) {
#pragma unroll
                        for (int jj = 0; jj < 4; ++jj) if (4 * q + jj == r) c[jj] = 1.f; }
                    st_hl(lds + TA + (16 * it + r) * PS + (16 * jt + 4 * q) * 2, LO, c); }
                __syncthreads();
#pragma unroll
                for (int st = 1; st <= 6; ++st) {
                    LAS unsigned char* Pc = lds + ((st & 1) ? PA : PB); LAS unsigned char* Pn = lds + ((st & 1) ? PB : PA);
                    LAS unsigned char* Tc = lds + ((st & 1) ? TB : TA); LAS unsigned char* Tn = lds + ((st & 1) ? TA : TB);
                    if (st == 1) { Tc = lds + TA; }
#pragma unroll
                    for (int e = 0; e < 2; ++e) { const int nt = 2 * nh + e;
                        if (st <= 5) { f32x4 c = (f32x4){0.f, 0.f, 0.f, 0.f};
#pragma unroll
                            for (int kb = 0; kb < 2; ++kb) c = mm3(c, frag_tr(Pc, PS, 32 * kb, 16 * nt, q, qq, pp), frag_tr(Pc + LO, PS, 32 * kb, 16 * nt, q, qq, pp), frag_rows(Pc, PS, 16 * it, 32 * kb, r, q), frag_rows(Pc + LO, PS, 16 * it, 32 * kb, r, q));
                            st_hl(Pn + (16 * it + r) * PS + (16 * nt + 4 * q) * 2, LO, c); }
                        if (st >= 2) { const u32x2 t0 = *(const LAS u32x2*)(Tc + (16 * it + r) * PS + (16 * nt + 4 * q) * 2), t1 = *(const LAS u32x2*)(Tc + LO + (16 * it + r) * PS + (16 * nt + 4 * q) * 2);
                            f32x4 c = (f32x4){lo16(t0.x) + lo16(t1.x), hi16(t0.x) + hi16(t1.x), lo16(t0.y) + lo16(t1.y), hi16(t0.y) + hi16(t1.y)};
#pragma unroll
                            for (int kb = 0; kb < 2; ++kb) c = mm3(c, frag_tr(Pc, PS, 32 * kb, 16 * nt, q, qq, pp), frag_tr(Pc + LO, PS, 32 * kb, 16 * nt, q, qq, pp), frag_rows(Tc, PS, 16 * it, 32 * kb, r, q), frag_rows(Tc + LO, PS, 16 * it, 32 * kb, r, q));
                            st_hl(Tn + (16 * it + r) * PS + (16 * nt + 4 * q) * 2, LO, c); }
                    }
                    __syncthreads();
                }
#pragma unroll
                for (int e = 0; e < 4; ++e) { const int nt = 4 * nh + e; f32x4 c = (f32x4){0.f, 0.f, 0.f, 0.f};
#pragma unroll
                    for (int kb = 0; kb < 2; ++kb) c = MFMA16(frag_tr(lds + KG, RS, 32 * kb, 16 * nt, q, qq, pp), frag_rows(lds + TB, PS, 16 * it, 32 * kb, r, q), c);
                    u32x2 w; w.x = pk2(-c[0], -c[1]); w.y = pk2(-c[2], -c[3]); *(LAS u32x2*)(lds + WSo + (16 * it + r) * RS + (16 * nt + 4 * q) * 2) = w; }
                __syncthreads();
#pragma unroll
                for (int k = 0; k < 2; ++k) { const int id = tid + 512 * k, row = id >> 4, cp = id & 15; *(u32x4*)(WT + ((size_t)unit * 64 + row) * 128 + cp * 8) = *(const LAS u32x4*)(lds + WSo + row * RS + cp * 16); }
                { const int row = tid >> 3, cp = tid & 7; *(u32x4*)(TINV + ((size_t)unit * 64 + row) * 64 + cp * 8) = *(const LAS u32x4*)(lds + TB + row * PS + cp * 16); }
            }
        }
    }
    PHASE_END

    PHASE_BEGIN
    {
        const bf16* DQ = (const bf16*)(BIG + B_DNQ); const bf16* DK = (const bf16*)(BIG + B_DNK); const bf16* DV = (const bf16*)(BIG + B_DNV);
        const float* DBt = (const float*)(BIG + B_DNB); const bf16* TINV = (const bf16*)((unsigned char*)MIX + MIX_TINV); const bf16* WT = Hb; const float* GCUM = (const float*)(BIG + B_GCUM);
        constexpr int QC0 = 0, KC0 = 17408, QC1 = 34816, KC1 = 52224, WC = 69632, TI = 87040, VB = 96256, VN = 101376, VD = 105984, ST0 = 110592, ST1 = 119296, GS0 = 128000, GS1 = 128768, RS = 272, PS = 144, VBS = 80;
        const int r = lane & 15, q = lane >> 4, qq = r >> 2, pp = r & 3, it = wave >> 1, ct = wave & 1;
        for (int unit0 = bid; unit0 < NB * 8 * 2 * 4; unit0 += G) {
            const int unit = (unit0 & 7) * 32 + (unit0 >> 3);
            const int sl = unit & 3, dir = (unit >> 2) & 1, h = (unit >> 3) & 7, b = unit >> 6;
            const size_t ubase = (size_t)((b * 8 + h) * 2 + dir) * NCH;
            bf16* DO = (bf16*)(BIG + (dir ? B_DNO1 : B_DNO0));
            f32x4 Sacc[2] = {(f32x4){0.f, 0.f, 0.f, 0.f}, (f32x4){0.f, 0.f, 0.f, 0.f}};
            u32x4 rq[2], rk[2], rw[2], rt, rv; float rbeta = 0.f, rgc = 0.f;
#define DNB_LOAD(n) do { _Pragma("unroll") for (int k = 0; k < 2; ++k) { const int id = tid + 512 * k, row = id >> 4, cp = id & 15; const size_t R = DN_ROW(n, row); \
                    rq[k] = *(const u32x4*)(DQ + R * 1024 + h * 128 + cp * 8); rk[k] = *(const u32x4*)(DK + R * 1024 + h * 128 + cp * 8); \
                    rw[k] = *(const u32x4*)(WT + ((ubase + (n)) * 64 + row) * 128 + cp * 8); } \
                { const int row = tid >> 3, cp = tid & 7; rt = *(const u32x4*)(TINV + ((ubase + (n)) * 64 + row) * 64 + cp * 8); } \
                if (tid < 256) { const int row = tid >> 2, cp = tid & 3; const size_t R = DN_ROW(n, row); rv = *(const u32x4*)(DV + R * 1024 + h * 128 + sl * 32 + cp * 8); rbeta = DBt[R * 16 + dir * 8 + h]; } \
                if (tid < 64) rgc = GCUM[(ubase + (n)) * 64 + tid]; } while (0)
#define DNB_STAGE(QCo, KCo, GSo) do { _Pragma("unroll") for (int k = 0; k < 2; ++k) { const int id = tid + 512 * k, row = id >> 4, cp = id & 15; \
                    *(LAS u32x4*)(lds + (QCo) + row * RS + cp * 16) = rq[k]; *(LAS u32x4*)(lds + (KCo) + row * RS + cp * 16) = rk[k]; *(LAS u32x4*)(lds + WC + row * RS + cp * 16) = rw[k]; } \
                { const int row = tid >> 3, cp = tid & 7; *(LAS u32x4*)(lds + TI + row * PS + cp * 16) = rt; } \
                if (tid < 256) { const int row = tid >> 2, cp = tid & 3; u32x4 x; x.x = pk2(lo16(rv.x) * rbeta, hi16(rv.x) * rbeta); x.y = pk2(lo16(rv.y) * rbeta, hi16(rv.y) * rbeta); \
                    x.z = pk2(lo16(rv.z) * rbeta, hi16(rv.z) * rbeta); x.w = pk2(lo16(rv.w) * rbeta, hi16(rv.w) * rbeta); *(LAS u32x4*)(lds + VB + row * VBS + cp * 16) = x; } \
                if (tid < 64) { const float gl = __shfl(rgc, 63); LAS float* gs = (LAS float*)(lds + (GSo)); gs[tid] = rgc; gs[64 + tid] = __expf(rgc); gs[128 + tid] = __expf(gl - rgc); } } while (0)
            for (int i = tid; i < 8704 / 4; i += 512) ((LAS unsigned*)(lds + ST0))[i] = 0u;
            DNB_LOAD(0);
            DNB_STAGE(QC0, KC0, GS0);
            if (NCH > 1) DNB_LOAD(1);
            __syncthreads();
            float bgv[8]; int bg_cur = -1; int bg_it = gw;
            for (int n = 0; n < NCH; ++n) {
                BGW_STORE(0); BGW_ISSUE(bg_it, 0); bg_it += NGW;
                LAS unsigned char* QC = lds + ((n & 1) ? QC1 : QC0); LAS unsigned char* KC = lds + ((n & 1) ? KC1 : KC0);
                LAS float* GS = (LAS float*)(lds + ((n & 1) ? GS1 : GS0));
                LAS unsigned char* STc = lds + ((n & 1) ? ST1 : ST0); LAS unsigned char* STn = lds + ((n & 1) ? ST0 : ST1);
                { f32x4 c = (f32x4){0.f, 0.f, 0.f, 0.f};
#pragma unroll
                  for (int kb = 0; kb < 2; ++kb) c = MFMA16(frag_rows(lds + TI, PS, 16 * it, 32 * kb, r, q), frag_tr(lds + VB, VBS, 32 * kb, 16 * ct, q, qq, pp), c);
#pragma unroll
                  for (int ks = 0; ks < 4; ++ks) c = MFMA16(frag_rows(lds + WC, RS, 16 * it, 32 * ks, r, q), frag_rows(STc, RS, 16 * ct, 32 * ks, r, q), c);
                  const f32x4 ed = *(const LAS f32x4*)(GS + 128 + 16 * it + 4 * q);
                  u32x2 w; w.x = pk2(c[0], c[1]); w.y = pk2(c[2], c[3]); *(LAS u32x2*)(lds + VN + (16 * ct + r) * PS + (16 * it + 4 * q) * 2) = w;
                  w.x = pk2(c[0] * ed[0], c[1] * ed[1]); w.y = pk2(c[2] * ed[2], c[3] * ed[3]); *(LAS u32x2*)(lds + VD + (16 * ct + r) * PS + (16 * it + 4 * q) * 2) = w; }
                __syncthreads();
                if (n + 1 < NCH) { if (n & 1) DNB_STAGE(QC0, KC0, GS0); else DNB_STAGE(QC1, KC1, GS1); }
                if (n + 2 < NCH) DNB_LOAD(n + 2);
                { const float egl = GS[64 + 63];
#pragma unroll
                  for (int e = 0; e < 2; ++e) { f32x4 c = Sacc[e] * egl;
#pragma unroll
                      for (int kb = 0; kb < 2; ++kb) c = MFMA16(frag_tr(KC, RS, 32 * kb, 16 * wave, q, qq, pp), frag_rows(lds + VD, PS, 16 * e, 32 * kb, r, q), c);
                      Sacc[e] = c;
                      u32x2 w; w.x = pk2(c[0], c[1]); w.y = pk2(c[2], c[3]); *(LAS u32x2*)(STn + (16 * e + r) * RS + (16 * wave + 4 * q) * 2) = w; } }
                { f32x4 o = (f32x4){0.f, 0.f, 0.f, 0.f};
                  bf16x8 Qf[4];
#pragma unroll
                  for (int ks = 0; ks < 4; ++ks) Qf[ks] = frag_rows(QC, RS, 16 * it, 32 * ks, r, q);
#pragma unroll
                  for (int ks = 0; ks < 4; ++ks) o = MFMA16(Qf[ks], frag_rows(STc, RS, 16 * ct, 32 * ks, r, q), o);
                  { const f32x4 eg = *(const LAS f32x4*)(GS + 64 + 16 * it + 4 * q); o = o * eg; }
                  const float gi = GS[16 * it + r];
#pragma unroll
                  for (int kp = 0; kp < 2; ++kp) {
                      if (2 * kp <= it) { f32x4 pt[2];
#pragma unroll
                          for (int e = 0; e < 2; ++e) { const int jt = 2 * kp + e; f32x4 c = (f32x4){0.f, 0.f, 0.f, 0.f};
                              if (jt <= it) {
#pragma unroll
                                  for (int ks = 0; ks < 4; ++ks) c = MFMA16(frag_rows(KC, RS, 16 * jt, 32 * ks, r, q), Qf[ks], c);
                                  const f32x4 gj = *(const LAS f32x4*)(GS + 16 * jt + 4 * q);
#pragma unroll
                                  for (int jj = 0; jj < 4; ++jj) c[jj] = (16 * jt + 4 * q + jj <= 16 * it + r) ? c[jj] * __expf(gi - gj[jj]) : 0.f; }
                              pt[e] = c; }
                          o = MFMA16(pack_pair(pt[0], pt[1]), frag_rows_perm(lds + VN, PS, 16 * ct, 32 * kp, r, q), o); }
                  }
#pragma unroll
                  for (int jj = 0; jj < 4; ++jj) { const size_t R = DN_ROW(n, 16 * it + 4 * q + jj); DO[R * 1024 + h * 128 + sl * 32 + 16 * ct + r] = (bf16)f2bf(o[jj]); } }
                __syncthreads();
            }
            BGW_STORE(0);
            for (; bg_it < BGW_ITEMS; bg_it += NGW) { BGW_ISSUE(bg_it, 0); BGW_STORE(0); }
        }
#undef DNB_LOAD
#undef DNB_STAGE
    }
    S5_PASS(true)
    PHASE_END

    PHASE_BEGIN
    {
        const bf16* O0 = (const bf16*)(BIG + B_DNO0); const bf16* O1 = (const bf16*)(BIG + B_DNO1); const bf16* IN0 = (const bf16*)(BIG + B_IN0);
        for (int item = gw; item < MROWS * 8; item += NGW) {
            const int R = item >> 3, h = item & 7; const size_t o = (size_t)R * 1024 + h * 128 + 2 * lane;
            const unsigned a = *(const unsigned*)(O0 + o), c = *(const unsigned*)(O1 + o);
            const float v0 = lo16(a) + lo16(c), v1 = hi16(a) + hi16(c);
            const float ms = wave_sum(v0 * v0 + v1 * v1) * (1.f / 128.f); const float rs = 1.f / sqrtf(ms + EPS);
            const unsigned gt = *(const unsigned*)(IN0 + (size_t)R * IN0_LD + 4096 + h * 128 + 2 * lane);
            const float g0 = args.in[I_DNNG][2 * lane], g1 = args.in[I_DNNG][2 * lane + 1];
            *(unsigned*)(MIX + (size_t)R * 2048 + 1024 + h * 128 + 2 * lane) = pk2(v0 * rs * g0 * siluf_(lo16(gt)), v1 * rs * g1 * siluf_(hi16(gt)));
        }
    }
    { pg8::Gemm g{(const bf16*)(BIG + B_S5Y), (const bf16*)(WB + W_GLU), 1024, 1024, 1024}; pg8::StaticOrder S; S.init(68, 4, G, bid, 0);
      EpiGlu E{(const bf16*)(BIG + B_S5Y), MIX, args.in[I_GLUB]};
      pg8::gemm_phase<EpiGlu>(lds, g, S, E); }
    PHASE_END

    PHASE_BEGIN
    { pg8::Gemm g{MIX, (const bf16*)(WB + W_OUT), 2048, 2048, 2048}; pg8::TailOrder<32> S; S.init(G, bid);
      EpiRes<true> E{args.in[I_X], XLb, MOD + 2 * 2048, SLAB};
      pg8::gemm_phase<EpiRes<true>, pg8::TailOrder<32>>(lds, g, S, E); }
    PHASE_END

    PHASE_BEGIN
    ADALN(0, 1, true, XLb, args.in[I_CTX], false, SLAB, MOD + 4 * 12288 + 2 * 2048)
    PHASE_END

    PHASE_BEGIN
    { pg8::Gemm g{Hb, (const bf16*)(WB + W_UP), DM, DM, DM}; pg8::StaticOrder S; S.init(68, 44, G, bid, 0);
      EpiSwiglu E{(bf16*)(BIG + B_G)};
      pg8::gemm_phase<EpiSwiglu>(lds, g, S, E); }
    PHASE_END

    PHASE_BEGIN
    { pg8::Gemm g{(const bf16*)(BIG + B_G), (const bf16*)(WB + W_DN), DFF, DFF, DFF}; pg8::TailOrder<88> S; S.init(G, bid);
      EpiRes<false> E{XLb, XLb, MOD + 5 * 2048, SLAB};
      pg8::gemm_phase<EpiRes<false>, pg8::TailOrder<88>>(lds, g, S, E); }
    PHASE_END

    PHASE_BEGIN
    ADALN(1, 0, true, XLb, XC, false, SLAB, MOD + 4 * 12288 + 5 * 2048)
    {
        LAS float* scr = (LAS float*)(lds + wave * 16384);
        constexpr int J0 = 32 * 256, J1 = 48 * 64, J3 = 32 * 176, J4 = J3, J5 = 88 * 64;
        (void)J3; (void)J4; (void)J5;
        for (int it = gw; it < J0 + J1; it += NGW) {
            int r = it;
            if (r < J0) { transpose_job(r, args.in[I_OWIN], 2048, 8192, (bf16*)(WB + W_IN), 0, 0, scr, lane); continue; } r -= J0;
            transpose_job(r, args.in[I_OWOUT], 3072, 2048, (bf16*)(WB + W_OUT), 0, 0, scr, lane);
        }
        bf16* WG = (bf16*)(WB + W_GLU);
        for (int i = bid * 512 + tid; i < 4096 * 256 / 2; i += G * 512) {
            const int kk = (i & 127) * 2, np = i >> 7; const int e = np & 127, half = (np >> 7) & 1, q = np >> 8, blk = q & 7, dir = q >> 3;
            unsigned w = 0u;
            if ((kk >> 7) == (blk & 1)) { const float* src = args.in[half ? I_LWX : I_LWA] + ((size_t)(dir * 8 + blk) * 128 + (kk & 127)) * 128 + e; w = pk2(src[0], src[128]); }
            *(unsigned*)(WG + (size_t)np * 256 + kk) = w;
        }
    }
    PHASE_END

    PHASE_BEGIN
    { pg8::Gemm g{Hb, (const bf16*)(WB + W_IN), DM, DM, DM}; pg8::StaticOrder S; S.init(68, 8, G, bid, 0);
      EpiPlain E{(bf16*)(BIG + B_INA), 2048};
      pg8::gemm_phase<EpiPlain>(lds, g, S, E); }
    PHASE_END

    PHASE_BEGIN
    {
        const bf16* INA = (const bf16*)(BIG + B_INA); bf16* XCV = (bf16*)(BIG + B_XCV);
        for (size_t i = (size_t)bid * 512 + tid; i < (size_t)MROWS * 512; i += (size_t)G * 512) {
            const int R = (int)(i >> 9), ch = (int)(i & 511) * 2, b = R / SROW, s = R % SROW;
            const int seg_lo = s < CTX ? 0 : CTX, seg_hi = s < CTX ? CTX : SROW;
            const f32x4 w0 = *(const f32x4*)(args.in[I_LCW] + ch * 4), w1 = *(const f32x4*)(args.in[I_LCW] + ch * 4 + 4);
            float a0 = args.in[I_LCB][ch], a1 = args.in[I_LCB][ch + 1];
#pragma unroll
            for (int j = 0; j < 4; ++j) { const int sx = s + j - 2;
                if (sx >= seg_lo && sx < seg_hi) { const unsigned pr = *(const unsigned*)(INA + (size_t)(b * SROW + sx) * 2048 + ch); a0 += w0[j] * lo16(pr); a1 += w1[j] * hi16(pr); } }
            *(unsigned*)(XCV + (size_t)R * 1024 + ch) = pk2(a0, a1);
        }
    }
    PHASE_END

    PHASE_BEGIN
    { pg8::Gemm g{(const bf16*)(BIG + B_XCV), (const bf16*)(WB + W_GLU), 1024, 256, 256}; pg8::StaticOrder S; S.init(68, 16, G, bid, 0);
      EpiGate E{(const bf16*)(BIG + B_XCV), (bf16*)(BIG + B_LA), (bf16*)(BIG + B_BB), args.in[I_LBA], args.in[I_LBX], T_SPL};
      pg8::gemm_phase<EpiGate, pg8::StaticOrder, true>(lds, g, S, E); }
    PHASE_END

    PHASE_BEGIN
    {
        const bf16* LA = (const bf16*)(BIG + B_LA); const bf16* BBp = (const bf16*)(BIG + B_BB); float* EP = (float*)(BIG + B_LEP);
        for (int i = bid * 512 + tid; i < NB * 2 * NCH * 1024; i += G * 512) {
            const int ch = i & 1023; int rest = i >> 10; const int c = rest % NCH; rest /= NCH; const int dir = rest & 1, b = rest >> 1;
            float P = 1.f, h = 0.f;
            for (int ti = 0; ti < 64; ++ti) { const int t = dir ? 63 - ti : ti; const size_t o = ((size_t)(b * SROW + c * 64 + t) * 2 + dir) * 1024 + ch;
                const float a = expf(bf2f(LA[o])), bb = bf2f(BBp[o]); P *= a; h = a * h + bb; }
            EP[(size_t)i * 2] = P; EP[(size_t)i * 2 + 1] = h;
        }
    }
    PHASE_END

    PHASE_BEGIN
    {
        const float* EP = (const float*)(BIG + B_LEP); float* ST = (float*)(BIG + B_LST);
        for (int i = bid * 512 + tid; i < NB * 2 * 1024; i += G * 512) {
            const int ch = i & 1023, dir = (i >> 10) & 1, b = i >> 11; float s = 0.f;
            for (int k = 0; k < NCH; ++k) { const int c = dir == 0 ? k : (k < 4 ? 3 - k : 71 - k); const size_t o = ((size_t)(b * 2 + dir) * NCH + c) * 1024 + ch;
                ST[o] = s; s = EP[o * 2] * s + EP[o * 2 + 1]; }
        }
    }
    PHASE_END

    PHASE_BEGIN
    {
        const bf16* LA = (const bf16*)(BIG + B_LA); const bf16* BBp = (const bf16*)(BIG + B_BB); const float* ST = (const float*)(BIG + B_LST); const bf16* INA = (const bf16*)(BIG + B_INA);
        LAS float* hb = (LAS float*)lds;
        for (int u = bid; u < NB * 64 * 2; u += G) {
            const int half = u & 1, c = 4 + ((u >> 1) & 63), b = u >> 7, ch = half * 512 + tid;
            float h = ST[((size_t)(b * 2 + 0) * NCH + c) * 1024 + ch];
            for (int t = 0; t < 64; ++t) { const size_t o = ((size_t)(b * SROW + c * 64 + t) * 2 + 0) * 1024 + ch; h = expf(bf2f(LA[o])) * h + bf2f(BBp[o]); hb[t * 512 + tid] = h; }
            h = ST[((size_t)(b * 2 + 1) * NCH + c) * 1024 + ch];
            for (int t = 63; t >= 0; --t) { const size_t R = (size_t)(b * SROW + c * 64 + t); const size_t o = (R * 2 + 1) * 1024 + ch; h = expf(bf2f(LA[o])) * h + bf2f(BBp[o]);
                const float y = hb[t * 512 + tid] + h; const float gt = bf2f(INA[R * 2048 + 1024 + ch]);
                MIX[R * 3072 + ch] = (bf16)f2bf(y * gelu_tanh(gt)); }
        }
    }
    PHASE_END

    PHASE_BEGIN
    { pg8::Gemm g{Hb, (const bf16*)(WB + W_IN) + (size_t)2048 * 2048, DM, DM, DM}; pg8::StaticOrder S; S.init(68, 24, G, bid, 0);
      EpiRope E{(bf16*)(BIG + B_INB), T_ROPE};
      pg8::gemm_phase<EpiRope>(lds, g, S, E); }
    PHASE_END

    PHASE_BEGIN
    {
        const bf16* INB = (const bf16*)(BIG + B_INB);
        constexpr int QS = 0, KS = 33792, VS = 67584, TS = 76800, RS = 528, VRS = 144;
        const int r = lane & 15, q = lane >> 4, qq = r >> 2, pp = r & 3;
        const int it = wave >> 1, dvp = wave & 1;
        for (int unit0 = bid; unit0 < NB * 4 * 2 * 8; unit0 += G) {
            const int unit = (unit0 & 7) * 32 + (unit0 >> 3);
            const int sl = unit & 7, dir = (unit >> 3) & 1, h = (unit >> 4) & 3, b = unit >> 6;
            bf16* RO = (bf16*)(BIG + (dir ? B_RO1 : B_RO0));
            const float lgam = -expf(args.in[I_RTH][dir * 4 + h]);
            const float gC = expf(64.f * lgam);
            f32x4 Tacc[2][4];
#pragma unroll
            for (int a = 0; a < 2; ++a)
#pragma unroll
                for (int d = 0; d < 4; ++d) Tacc[a][d] = (f32x4){0.f, 0.f, 0.f, 0.f};
            const int vrow = tid >> 3, vcp = tid & 7;
            const float vsc = expf(-(float)vrow * lgam);
            u32x4 pq[4], pk[4], pv;
#define RT_ROW(n, row) ((size_t)b * SROW + (dir == 0 ? ((n) * 64 + (row)) : (((n) * 64 + (row)) < CTX ? CTX - 1 - ((n) * 64 + (row)) : SROW + CTX - 1 - ((n) * 64 + (row)))))
#define RT_LOAD(n) do { _Pragma("unroll") for (int k = 0; k < 4; ++k) { const int id = tid + 512 * k, row = id >> 5, cp = id & 31; const bf16* src = INB + RT_ROW(n, row) * INB_LD + h * 256 + cp * 8; \
                pq[k] = *(const u32x4*)src; pk[k] = *(const u32x4*)(src + 1024); } \
                pv = *(const u32x4*)(INB + RT_ROW(n, vrow) * INB_LD + 2048 + h * 512 + sl * 64 + vcp * 8); } while (0)
            RT_LOAD(0);
            float bgv[8]; int bg_cur = -1; int bg_it = gw;
            for (int n = 0; n < NCH; ++n) {
                BGW_STORE(1); BGW_ISSUE(bg_it, 1); bg_it += NGW;
#pragma unroll
                for (int k = 0; k < 4; ++k) { const int id = tid + 512 * k, row = id >> 5, cp = id & 31;
                    *(LAS u32x4*)(lds + QS + row * RS + cp * 16) = pq[k]; *(LAS u32x4*)(lds + KS + row * RS + cp * 16) = pk[k]; }
                { u32x4 w; w.x = pk2(lo16(pv.x) * vsc, hi16(pv.x) * vsc); w.y = pk2(lo16(pv.y) * vsc, hi16(pv.y) * vsc); w.z = pk2(lo16(pv.z) * vsc, hi16(pv.z) * vsc); w.w = pk2(lo16(pv.w) * vsc, hi16(pv.w) * vsc);
                  *(LAS u32x4*)(lds + VS + vrow * VRS + vcp * 16) = w; }
                const bool outp = n >= 4;
                if (outp) {
#pragma unroll
                    for (int a = 0; a < 2; ++a)
#pragma unroll
                        for (int d = 0; d < 4; ++d) { u32x2 w; w.x = pk2(Tacc[a][d][0], Tacc[a][d][1]); w.y = pk2(Tacc[a][d][2], Tacc[a][d][3]);
                            *(LAS u32x2*)(lds + TS + (16 * d + r) * RS + (16 * (2 * wave + a) + 4 * q) * 2) = w; }
                }
                __syncthreads();
                if (n + 1 < NCH) RT_LOAD(n + 1);
                if (outp) {
                    bf16x8 Qf[8];
#pragma unroll
                    for (int ks = 0; ks < 8; ++ks) Qf[ks] = *(const LAS bf16x8*)(lds + QS + (16 * it + r) * RS + (32 * ks + 8 * q) * 2);
                    f32x4 oacc[2];
#pragma unroll
                    for (int dd = 0; dd < 2; ++dd) { f32x4 c = (f32x4){0.f, 0.f, 0.f, 0.f};
#pragma unroll
                        for (int ks = 0; ks < 8; ++ks) { const bf16x8 tf = *(const LAS bf16x8*)(lds + TS + (16 * (2 * dvp + dd) + r) * RS + (32 * ks + 8 * q) * 2);
                            c = __builtin_amdgcn_mfma_f32_16x16x32_bf16(Qf[ks], tf, c, 0, 0, 0); }
                        oacc[dd] = c * gC; }
#pragma unroll
                    for (int kp = 0; kp < 2; ++kp) {
                        if (2 * kp <= it) {
                            f32x4 pt[2];
#pragma unroll
                            for (int e = 0; e < 2; ++e) { const int jt = 2 * kp + e; f32x4 c = (f32x4){0.f, 0.f, 0.f, 0.f};
                                if (jt <= it) {
#pragma unroll
                                    for (int ks = 0; ks < 8; ++ks) { const bf16x8 kf = *(const LAS bf16x8*)(lds + KS + (16 * jt + r) * RS + (32 * ks + 8 * q) * 2);
                                        c = __builtin_amdgcn_mfma_f32_16x16x32_bf16(kf, Qf[ks], c, 0, 0, 0); }
                                    if (jt == it) {
#pragma unroll
                                        for (int jj = 0; jj < 4; ++jj) if (4 * q + jj > r) c[jj] = 0.f; }
                                }
                                pt[e] = c; }
                            u32x4 pw; pw.x = pk2(pt[0][0], pt[0][1]); pw.y = pk2(pt[0][2], pt[0][3]); pw.z = pk2(pt[1][0], pt[1][1]); pw.w = pk2(pt[1][2], pt[1][3]);
                            const bf16x8 pf = __builtin_bit_cast(bf16x8, pw);
#pragma unroll
                            for (int dd = 0; dd < 2; ++dd) { const int dvt = 2 * dvp + dd;
                                const s16x4 v0 = __builtin_amdgcn_ds_read_tr16_b64_v4i16((LAS s16x4*)(lds + VS + (32 * kp + 4 * q + qq) * VRS + (16 * dvt + 4 * pp) * 2));
                                const s16x4 v1 = __builtin_amdgcn_ds_read_tr16_b64_v4i16((LAS s16x4*)(lds + VS + (32 * kp + 16 + 4 * q + qq) * VRS + (16 * dvt + 4 * pp) * 2));
                                const bf16x8 vf = {v0[0], v0[1], v0[2], v0[3], v1[0], v1[1], v1[2], v1[3]};
                                oacc[dd] = __builtin_amdgcn_mfma_f32_16x16x32_bf16(pf, vf, oacc[dd], 0, 0, 0); }
                        }
                    }
#pragma unroll
                    for (int jj = 0; jj < 4; ++jj) { const int i = 16 * it + 4 * q + jj; const float gi = expf((float)i * lgam);
                        const size_t R = RT_ROW(n, i); const size_t Rl = (size_t)b * SEQ + (R - (size_t)b * SROW - CTX);
#pragma unroll
                        for (int dd = 0; dd < 2; ++dd) RO[Rl * 2048 + h * 512 + sl * 64 + 16 * (2 * dvp + dd) + r] = (bf16)f2bf(oacc[dd][jj] * gi); }
                }
#pragma unroll
                for (int a = 0; a < 2; ++a)
#pragma unroll
                    for (int d = 0; d < 4; ++d) Tacc[a][d] = Tacc[a][d] * gC;
#pragma unroll
                for (int ks = 0; ks < 2; ++ks) {
                    bf16x8 kt[2], vf[4];
#pragma unroll
                    for (int a = 0; a < 2; ++a) { const int dkt = 2 * wave + a;
                        const s16x4 k0 = __builtin_amdgcn_ds_read_tr16_b64_v4i16((LAS s16x4*)(lds + KS + (32 * ks + 8 * q + qq) * RS + (16 * dkt + 4 * pp) * 2));
                        const s16x4 k1 = __builtin_amdgcn_ds_read_tr16_b64_v4i16((LAS s16x4*)(lds + KS + (32 * ks + 8 * q + 4 + qq) * RS + (16 * dkt + 4 * pp) * 2));
                        kt[a] = (bf16x8){k0[0], k0[1], k0[2], k0[3], k1[0], k1[1], k1[2], k1[3]}; }
#pragma unroll
                    for (int d = 0; d < 4; ++d) {
                        const s16x4 v0 = __builtin_amdgcn_ds_read_tr16_b64_v4i16((LAS s16x4*)(lds + VS + (32 * ks + 8 * q + qq) * VRS + (16 * d + 4 * pp) * 2));
                        const s16x4 v1 = __builtin_amdgcn_ds_read_tr16_b64_v4i16((LAS s16x4*)(lds + VS + (32 * ks + 8 * q + 4 + qq) * VRS + (16 * d + 4 * pp) * 2));
                        vf[d] = (bf16x8){v0[0], v0[1], v0[2], v0[3], v1[0], v1[1], v1[2], v1[3]}; }
#pragma unroll
                    for (int a = 0; a < 2; ++a)
#pragma unroll
                        for (int d = 0; d < 4; ++d) Tacc[a][d] = __builtin_amdgcn_mfma_f32_16x16x32_bf16(kt[a], vf[d], Tacc[a][d], 0, 0, 0);
                }
                __syncthreads();
            }
            BGW_STORE(1);
            for (; bg_it < BGW_ITEMS; bg_it += NGW) { BGW_ISSUE(bg_it, 1); BGW_STORE(1); }
        }
#undef RT_ROW
#undef RT_LOAD
    }
    PHASE_END

    PHASE_BEGIN
    {
        const bf16* O0 = (const bf16*)(BIG + B_RO0); const bf16* O1 = (const bf16*)(BIG + B_RO1); const bf16* INB = (const bf16*)(BIG + B_INB);
        for (int item = gw; item < NB * SEQ * 4; item += NGW) {
            const int Rl = item >> 2, h = item & 3, b = Rl / SEQ, n = Rl % SEQ; const size_t R = (size_t)b * SROW + CTX + n;
            const size_t o = (size_t)Rl * 2048 + h * 512 + lane * 8;
            const u32x4 a = *(const u32x4*)(O0 + o), c = *(const u32x4*)(O1 + o);
            float v[8] = {lo16(a.x) + lo16(c.x), hi16(a.x) + hi16(c.x), lo16(a.y) + lo16(c.y), hi16(a.y) + hi16(c.y), lo16(a.z) + lo16(c.z), hi16(a.z) + hi16(c.z), lo16(a.w) + lo16(c.w), hi16(a.w) + hi16(c.w)};
            float ss = 0.f;
#pragma unroll
            for (int e = 0; e < 8; ++e) ss += v[e] * v[e];
            const float rs = 1.f / sqrtf(wave_sum(ss) * (1.f / 512.f) + EPS);
            const u32x4 gw4 = *(const u32x4*)(INB + R * INB_LD + 4096 + h * 512 + lane * 8);
            const float gt[8] = {lo16(gw4.x), hi16(gw4.x), lo16(gw4.y), hi16(gw4.y), lo16(gw4.z), hi16(gw4.z), lo16(gw4.w), hi16(gw4.w)};
            u32x4 w; w.x = pk2(v[0] * rs * siluf_(gt[0]), v[1] * rs * siluf_(gt[1])); w.y = pk2(v[2] * rs * siluf_(gt[2]), v[3] * rs * siluf_(gt[3]));
            w.z = pk2(v[4] * rs * siluf_(gt[4]), v[5] * rs * siluf_(gt[5])); w.w = pk2(v[6] * rs * siluf_(gt[6]), v[7] * rs * siluf_(gt[7]));
            *(u32x4*)(MIX + R * 3072 + 1024 + h * 512 + lane * 8) = w;
        }
    }
    PHASE_END

    PHASE_BEGIN
    { pg8::Gemm g{MIX, (const bf16*)(WB + W_OUT), 3072, 3072, 3072}; pg8::StaticOrder S; S.init(64, 8, G, bid, 1);
      EpiRes<false> E{XLb, XLb, MOD + 5 * 12288 + 2 * 2048, SLAB};
      pg8::gemm_phase<EpiRes<false>>(lds, g, S, E); }
    PHASE_END

    PHASE_BEGIN
    ADALN(1, 1, true, XLb, XC, true, (const float*)nullptr, (const float*)nullptr)
    PHASE_END

    PHASE_BEGIN
    { pg8::Gemm g{Hb, (const bf16*)(WB + W_UP), DM, DM, DM}; pg8::StaticOrder S; S.init(64, 44, G, bid, 1);
      EpiSwiglu E{(bf16*)(BIG + B_G)};
      pg8::gemm_phase<EpiSwiglu>(lds, g, S, E); }
    PHASE_END

    PHASE_BEGIN
    { pg8::Gemm g{(const bf16*)(BIG + B_G), (const bf16*)(WB + W_DN), DFF, DFF, DFF}; pg8::StaticOrder S; S.init(64, 8, G, bid, 1);
      EpiRes<false> E{XLb, XLb, MOD + 5 * 12288 + 5 * 2048, SLAB};
      pg8::gemm_phase<EpiRes<false>>(lds, g, S, E); }
    PHASE_END

    PHASE_BEGIN
    {
        const float* fg = args.in[I_FING];
        for (int R = gw; R < NB * SEQ; R += NGW) { const bf16* xr = XLb + (size_t)R * DM; float* orow = args.out + (size_t)R * DM;
            f32x4 v[8]; float ss = 0.f;
#pragma unroll
            for (int j = 0; j < 8; ++j) { const u32x2 w = *(const u32x2*)(xr + lane * 4 + j * 256); v[j] = (f32x4){lo16(w.x), hi16(w.x), lo16(w.y), hi16(w.y)};
                ss += (v[j][0] * v[j][0] + v[j][1] * v[j][1]) + (v[j][2] * v[j][2] + v[j][3] * v[j][3]); }
            const float rstd = 1.f / sqrtf(wave_sum(ss) * (1.f / DM) + EPS);
#pragma unroll
            for (int j = 0; j < 8; ++j) { const f32x4 gg = *(const f32x4*)(fg + lane * 4 + j * 256); *(f32x4*)(orow + lane * 4 + j * 256) = v[j] * rstd * gg; }
        }
    }
    PHASE_END
}
constexpr int N_PHASES = 26;

extern "C" void kernel_launch(void* const* d_in, const int* in_sizes, int n_in, void* d_out, int out_size, void* d_ws, size_t ws_size, hipStream_t stream) {
    static int grid = 0;
    if (grid == 0) {
        if (n_in != 38 || out_size != NB * SEQ * DM || ws_size < WS_END) { fprintf(stderr, "kernel_launch: unexpected problem (n_in %d out %d ws %zu, need %zu)\n", n_in, out_size, ws_size, (size_t)WS_END); grid = -1; return; }
        int dev = 0, cus = 0;
        if (hipGetDevice(&dev) != hipSuccess || hipDeviceGetAttribute(&cus, hipDeviceAttributeMultiprocessorCount, dev) != hipSuccess) { grid = -1; return; }
        if (hipFuncSetAttribute((const void*)fwd_kernel, hipFuncAttributeMaxDynamicSharedMemorySize, LDS_BYTES) != hipSuccess) { fprintf(stderr, "kernel_launch: hipFuncSetAttribute failed\n"); grid = -1; return; }
        int per_cu = 0;
        if (hipOccupancyMaxActiveBlocksPerMultiprocessor(&per_cu, (const void*)fwd_kernel, 512, LDS_BYTES) != hipSuccess || per_cu < 1) { fprintf(stderr, "kernel_launch: occupancy query says %d\n", per_cu); }
        (void)hipGetLastError();
        if (per_cu < 1) { grid = -1; return; }
        grid = cus;
    }
    if (grid < 0) return;
    (void)hipMemsetAsync((char*)d_ws + WS_CTL, 0, CTL_BYTES, stream);
    Args a{};
    for (int i = 0; i < 38; ++i) a.in[i] = (const float*)d_in[i];
    a.out = (float*)d_out; a.ws = (unsigned char*)d_ws;
#if MK_ONE_LAUNCH
    a.ph_lo = 0; a.ph_hi = N_PHASES;
    hipLaunchKernelGGL(fwd_kernel, dim3(grid), dim3(512), LDS_BYTES, stream, a);
#else
    for (int p = 0; p < N_PHASES; ++p) { a.ph_lo = p; a.ph_hi = p + 1; hipLaunchKernelGGL(fwd_kernel, dim3(grid), dim3(512), LDS_BYTES, stream, a); }
#endif
}
```

```cpp
#include <hip/hip_runtime.h>
#include <cstdio>
#include <cstdint>

#ifndef MK_ONE_LAUNCH
#define MK_ONE_LAUNCH 1
#endif

#define DI __device__ __forceinline__
#define LAS __attribute__((address_space(3)))
typedef unsigned short bf16;
typedef short bf16x8 __attribute__((ext_vector_type(8)));
typedef float f32x4 __attribute__((ext_vector_type(4)));
typedef float f32x2 __attribute__((ext_vector_type(2)));
typedef unsigned u32x4 __attribute__((ext_vector_type(4)));
typedef unsigned u32x2 __attribute__((ext_vector_type(2)));
typedef short s16x4 __attribute__((ext_vector_type(4)));

constexpr int DM = 2048, NB = 4, SEQ = 4096, CTX = 256, DFF = 5632;
constexpr int SROW = CTX + SEQ;
constexpr int MROWS = NB * SROW;
constexpr int NCH = SROW / 64;
constexpr float EPS = 1e-6f;
constexpr int IN0_LD = 5120;
constexpr int INB_LD = 6144;

constexpr size_t MiB = 1u << 20;
constexpr size_t WS_CTL = 0, CTL_BYTES = 1 * MiB;
constexpr size_t WS_MOD = 1 * MiB;
constexpr size_t WS_TAB = 2 * MiB;
constexpr size_t WS_XC = 4 * MiB;
constexpr size_t WS_W = 12 * MiB;
constexpr size_t W_IN = 0, W_OUT = 32 * MiB, W_GLU = 44 * MiB, W_UP = 46 * MiB, W_DN = 90 * MiB;
constexpr size_t WS_H = 124 * MiB;
constexpr size_t WS_MIX = 192 * MiB;
constexpr size_t WS_BIG = 294 * MiB;
constexpr size_t B_IN0 = 0, B_AB = 170 * MiB, B_DNQ = 173 * MiB, B_DNK = 207 * MiB, B_DNV = 241 * MiB, B_DNG = 275 * MiB, B_DNB = 277 * MiB,
                 B_DNO0 = 279 * MiB, B_DNO1 = 313 * MiB, B_S5Y = 347 * MiB, B_S5E = 381 * MiB, B_S5S = 398 * MiB, B_GCUM = 415 * MiB, B_END0 = 417 * MiB;
constexpr size_t MIX_TINV = 68 * MiB;
constexpr size_t B_INA = 0, B_XCV = 68 * MiB, B_LA = 102 * MiB, B_BB = 170 * MiB, B_LEP = 238 * MiB, B_LST = 243 * MiB;
constexpr size_t B_INB = 0, B_RO0 = 204 * MiB, B_RO1 = 268 * MiB;
constexpr size_t B_G = 0;
constexpr size_t WS_END = WS_BIG + B_END0;

DI float bf2f(unsigned v) { return __uint_as_float(v << 16); }
DI unsigned f2bf(float f) { unsigned u = __float_as_uint(f); return (u + 0x7fffu + ((u >> 16) & 1u)) >> 16; }
DI unsigned pk2(float lo, float hi) { return f2bf(lo) | (f2bf(hi) << 16); }
DI float lo16(unsigned w) { return __uint_as_float(w << 16); }
DI float hi16(unsigned w) { return __uint_as_float(w & 0xffff0000u); }
DI float sigmoidf_(float x) { return 1.f / (1.f + expf(-x)); }
DI float siluf_(float x) { return x / (1.f + expf(-x)); }
DI float softplusf_(float x) { return fmaxf(x, 0.f) + log1pf(expf(-fabsf(x))); }
DI float gelu_tanh(float x) { const float u = 0.7978845608028654f * (x + 0.044715f * x * x * x); return 0.5f * x * (1.f + tanhf(u)); }
DI float wave_sum(float v) {
#pragma unroll
    for (int o = 1; o < 64; o <<= 1) v += __shfl_xor(v, o);
    return v;
}

DI bf16x8 frag_rows(LAS unsigned char* base, int RSB, int row0, int k0, int r, int q) { return *(const LAS bf16x8*)(base + (row0 + r) * RSB + (k0 + 8 * q) * 2); }
DI bf16x8 frag_tr(LAS unsigned char* base, int RSB, int k0, int n0, int q, int qq, int pp) {
    const s16x4 a = __builtin_amdgcn_ds_read_tr16_b64_v4i16((LAS s16x4*)(base + (k0 + 8 * q + qq) * RSB + (n0 + 4 * pp) * 2));
    const s16x4 b = __builtin_amdgcn_ds_read_tr16_b64_v4i16((LAS s16x4*)(base + (k0 + 8 * q + 4 + qq) * RSB + (n0 + 4 * pp) * 2));
    return (bf16x8){a[0], a[1], a[2], a[3], b[0], b[1], b[2], b[3]}; }
DI bf16x8 frag_rows_perm(LAS unsigned char* base, int RSB, int row0, int k0, int r, int q) {
    const u32x2 a = *(const LAS u32x2*)(base + (row0 + r) * RSB + (k0 + 4 * q) * 2), b = *(const LAS u32x2*)(base + (row0 + r) * RSB + (k0 + 16 + 4 * q) * 2);
    u32x4 w; w.x = a.x; w.y = a.y; w.z = b.x; w.w = b.y; return __builtin_bit_cast(bf16x8, w); }
DI bf16x8 pack_pair(const f32x4& x, const f32x4& y) { u32x4 w; w.x = pk2(x[0], x[1]); w.y = pk2(x[2], x[3]); w.z = pk2(y[0], y[1]); w.w = pk2(y[2], y[3]); return __builtin_bit_cast(bf16x8, w); }
#define MFMA16(a, b, c) __builtin_amdgcn_mfma_f32_16x16x32_bf16((a), (b), (c), 0, 0, 0)
DI void st_hl(LAS unsigned char* p, int lo_off, const f32x4& c) {
    u32x2 h; h.x = pk2(c[0], c[1]); h.y = pk2(c[2], c[3]);
    u32x2 l; l.x = pk2(c[0] - lo16(h.x), c[1] - hi16(h.x)); l.y = pk2(c[2] - lo16(h.y), c[3] - hi16(h.y));
    *(LAS u32x2*)p = h; *(LAS u32x2*)(p + lo_off) = l; }
DI f32x4 mm3(f32x4 c, const bf16x8& ah, const bf16x8& al, const bf16x8& bh, const bf16x8& bl) { c = MFMA16(ah, bh, c); c = MFMA16(ah, bl, c); c = MFMA16(al, bh, c); return c; }
#define LDS_WAIT() asm volatile("s_waitcnt lgkmcnt(0)" ::: "memory")
#define VM_WAIT() asm volatile("s_waitcnt vmcnt(0)" ::: "memory")

namespace pg8 {
constexpr int BM = 256, BK = 64, HALF = 128, HTB = HALF * BK * 2, STAGE_BYTES = 8 * HTB, NXCD = 8, WGM = 8;
DI int lds_byte(int r, int c) { const int st = (r >> 4) * 2 + (c >> 5), rr = r & 15, cc = c & 31, ob = rr * 64 + cc * 2; return st * 1024 + (ob ^ (((ob >> 9) & 1) << 5)); }
DI void stage_rc(int b, int& R, int& C) { const int st = b / 1024, sb = b % 1024, swz = sb ^ (((sb >> 9) & 1) << 5); R = (st >> 1) * 16 + swz / 64; C = (st & 1) * 32 + (swz % 64) / 2; }
DI int perm32(int rho) { const int n = rho >> 4, i = rho & 15; return 8 * (i >> 2) + 4 * n + (i & 3); }
struct Unit { int pm, pn, koff, nt; };
struct Gemm { const bf16* A; const bf16* Bt; int lda, ldb, K; };
struct StaticOrder {
    int nM, nN, nwg, G, c, lat;
    DI void init(int nM_, int nN_, int G_, int c_, int lat_) { nM = nM_; nN = nN_; nwg = nM * nN; G = G_; c = c_; lat = lat_; }
    DI bool next(int i, int& upm, int& upn, int& ukoff, int& unt) const {
        const long L = (long)i * G + c; if (L >= nwg) return false;
        int wgid = (int)L; { const int q = nwg / NXCD, r = nwg % NXCD, xcd = wgid % NXCD, off = wgid / NXCD; wgid = (xcd < r ? xcd * (q + 1) : r * (q + 1) + (xcd - r) * q) + off; }
        const int nig = WGM * nN, gid = wgid / nig, fm = gid * WGM, gsz = (nM - fm) < WGM ? (nM - fm) : WGM;
        int pm = fm + ((wgid % nig) % gsz); upn = (wgid % nig) / gsz;
        if (lat) pm = (pm >> 4) * 17 + 1 + (pm & 15);
        upm = pm; ukoff = 0; unt = 0; return true;
    }
};
template <int NTOT> struct TailOrder {
    int G, c;
    static constexpr int NWG = 512, LO = (NTOT / 8) & ~1, EX2 = (NTOT - LO * 8) >> 1;
    DI void init(int G_, int c_) { G = G_; c = c_; }
    DI bool next(int i, int& upm, int& upn, int& ukoff, int& unt) const {
        const int L = i * G + c; if (L >= NWG + 256) return false;
        const bool mainu = L < NWG; const int T = L - NWG;
        const int wgid = (L & 7) * (NWG / 8) + (L >> 3);
        const int w = wgid & 63, pml = (wgid >> 6) * 8 + (w & 7); const int ctn = T >> 3, sp = T & 7;
        upm = mainu ? (pml >> 4) * 17 + 1 + (pml & 15) : (ctn >> 3) * 17; upn = mainu ? (w >> 3) : (ctn & 7);
        unt = mainu ? 0 : ((LO + (sp < EX2 ? 2 : 0)) | (sp << 8)); ukoff = mainu ? 0 : (LO * sp + 2 * (sp < EX2 ? sp : EX2)) * 128; return true;
    }
};
DI unsigned cvt_pk_bf16(float lo, float hi) { unsigned r; asm volatile("v_cvt_pk_bf16_f32 %0, %1, %2" : "=v"(r) : "v"(lo), "v"(hi)); return r; }

template <class Epi, class Sched = StaticOrder, bool BLKDIAG = false>
DI void gemm_phase(LAS unsigned char* lds, const Gemm g, const Sched& S, const Epi& E) {
    int tid_ = threadIdx.x; asm volatile("" : "+v"(tid_));
    const int tid = tid_, wid = __builtin_amdgcn_readfirstlane(tid >> 6), lane = tid & 63, wr = wid >> 2, wc = wid & 3, fr = lane & 15, fq = lane >> 4;
    int K_ = g.K; asm volatile("" : "+s"(K_));
    const int K = K_, nt = K / BK;
    unsigned voffA[2], voffB[2];
#pragma unroll
    for (int i = 0; i < 2; ++i) { int R, C; stage_rc(tid * 16 + i * 8192, R, C); const int Rb = Epi::PERM ? ((R & ~31) + perm32(R & 31)) : R;
        voffA[i] = (unsigned)(R * g.lda + C) * 2u; voffB[i] = (unsigned)(Rb * g.ldb + C) * 2u; }
    const size_t kstep = (size_t)(BK * 2);
    const size_t hstepA = (size_t)HALF * g.lda * 2, hstepB = (size_t)HALF * g.ldb * 2;
    const size_t tstepA = 2 * hstepA, tstepB = 2 * hstepB;
    const unsigned ldsw = (unsigned)wid * 1024u;
    const int aoff = lds_byte(wr * 64 + fr, fq * 8), boff = lds_byte(wc * 32 + fr, fq * 8);
#define PG8_SA(b, h) (((b) * 2 + (h)) * HTB)
#define PG8_SB(b, h) ((4 + (b) * 2 + (h)) * HTB)
#define PG8_STAGE(bufoff, gbase, voff) do { _Pragma("unroll") for (int _i = 0; _i < 2; ++_i) \
        __builtin_amdgcn_global_load_lds((const unsigned*)((const char*)(gbase) + (voff)[_i]), (LAS unsigned*)(lds + (bufoff) + ldsw + _i * 8192), 16, 0, 0); } while (0)
#define PG8_LDA(dst, b, h) do { _Pragma("unroll") for (int m = 0; m < 4; ++m) _Pragma("unroll") for (int k = 0; k < 2; ++k) dst[m][k] = *(const LAS bf16x8*)(lds + PG8_SA(b, h) + aoff + m * 2048 + k * 1024); } while (0)
#define PG8_LDB(dst, b, h) do { _Pragma("unroll") for (int n = 0; n < 2; ++n) _Pragma("unroll") for (int k = 0; k < 2; ++k) dst[n][k] = *(const LAS bf16x8*)(lds + PG8_SB(b, h) + boff + n * 2048 + k * 1024); } while (0)
#define PG8_MMA(ai, bj, At, Bt) do { __builtin_amdgcn_s_setprio(1); _Pragma("unroll") for (int m = 0; m < 4; ++m) _Pragma("unroll") for (int n = 0; n < 2; ++n) _Pragma("unroll") for (int k = 0; k < 2; ++k) \
        acc[ai][bj][m][n] = __builtin_amdgcn_mfma_f32_16x16x32_bf16(Bt[n][k], At[m][k], acc[ai][bj][m][n], 0, 0, 0); __builtin_amdgcn_s_setprio(0); } while (0)
#define PG8_WAIT_V(n) asm volatile("s_waitcnt vmcnt(" #n ")" ::: "memory")
#define PG8_WAIT_L(n) asm volatile("s_waitcnt lgkmcnt(" #n ")" ::: "memory")
#define PG8_BAR __builtin_amdgcn_s_barrier()
#define PG8_SCHED __builtin_amdgcn_sched_barrier(0)
#define PG8_KOFF(pn_, koff_) ((BLKDIAG ? (size_t)(((pn_) & 7) >> 1) * 512 : (size_t)0) + (size_t)(koff_))
    int cpm, cpn, ckoff, cnt_, npm = 0, npn = 0, nkoff = 0, nnt = 0; int ui = 0;
    if (!S.next(0, cpm, cpn, ckoff, cnt_)) return;
    f32x4 acc[2][2][4][2];
#pragma unroll
    for (int a = 0; a < 2; ++a)
#pragma unroll
        for (int b = 0; b < 2; ++b)
#pragma unroll
            for (int m = 0; m < 4; ++m)
#pragma unroll
                for (int n = 0; n < 2; ++n) acc[a][b][m][n] = (f32x4){0.f, 0.f, 0.f, 0.f};
    bf16x8 At[4][2], B0[2][2], B1[2][2];
    const char* cA = (const char*)g.A + (size_t)cpm * tstepA + PG8_KOFF(cpn, ckoff); const char* cB = (const char*)g.Bt + (size_t)cpn * tstepB + (size_t)ckoff;
    PG8_STAGE(PG8_SB(0, 0), cB, voffB); PG8_STAGE(PG8_SB(0, 1), cB + hstepB, voffB); PG8_STAGE(PG8_SA(0, 0), cA, voffA); PG8_STAGE(PG8_SA(0, 1), cA + hstepA, voffA);
    if (wr == 1) PG8_BAR;
    PG8_WAIT_V(2); PG8_BAR;
    PG8_STAGE(PG8_SB(1, 0), cB + kstep, voffB); PG8_STAGE(PG8_SA(1, 0), cA + kstep, voffA); PG8_STAGE(PG8_SB(1, 1), cB + hstepB + kstep, voffB);
    PG8_WAIT_V(6); PG8_BAR;
    for (;;) {
        const bool has_next = S.next(ui + 1, npm, npn, nkoff, nnt);
        const char* nA = has_next ? (const char*)g.A + (size_t)npm * tstepA + PG8_KOFF(npn, nkoff) : cA; const char* nB = has_next ? (const char*)g.Bt + (size_t)npn * tstepB + (size_t)nkoff : cB;
        const int cnt = cnt_ ? (cnt_ & 255) : nt;
        for (int t = 0; t < cnt; t += 2) {
            const bool last = (t == cnt - 2);
            const char* a1 = cA + (size_t)(t + 1) * kstep;
            const char* a2 = last ? nA : cA + (size_t)(t + 2) * kstep; const char* b2 = last ? nB : cB + (size_t)(t + 2) * kstep;
            const char* a3 = a2 + kstep; const char* b3 = b2 + kstep;
            PG8_LDB(B0, 0, 0); PG8_LDB(B1, 0, 1); PG8_SCHED; PG8_LDA(At, 0, 0); PG8_STAGE(PG8_SA(1, 1), a1 + hstepA, voffA);
            PG8_WAIT_V(8); PG8_WAIT_L(0); PG8_BAR; PG8_MMA(0, 0, At, B0); PG8_MMA(0, 1, At, B1); PG8_BAR; PG8_SCHED;
            PG8_LDA(At, 0, 1); PG8_STAGE(PG8_SB(0, 0), b2, voffB); PG8_STAGE(PG8_SB(0, 1), b2 + hstepB, voffB); PG8_STAGE(PG8_SA(0, 0), a2, voffA);
            PG8_WAIT_V(8); PG8_WAIT_L(0); PG8_BAR; PG8_MMA(1, 0, At, B0); PG8_MMA(1, 1, At, B1); PG8_BAR; PG8_SCHED;
            PG8_LDB(B0, 1, 0); PG8_LDB(B1, 1, 1); PG8_SCHED; PG8_LDA(At, 1, 0); PG8_STAGE(PG8_SA(0, 1), a2 + hstepA, voffA);
            PG8_WAIT_V(8); PG8_WAIT_L(0); PG8_BAR; PG8_MMA(0, 0, At, B0); PG8_MMA(0, 1, At, B1); PG8_BAR; PG8_SCHED;
            PG8_LDA(At, 1, 1); PG8_STAGE(PG8_SB(1, 0), b3, voffB); PG8_STAGE(PG8_SB(1, 1), b3 + hstepB, voffB); PG8_STAGE(PG8_SA(1, 0), a3, voffA);
            PG8_WAIT_V(8); PG8_WAIT_L(0); PG8_BAR; PG8_MMA(1, 0, At, B0); PG8_MMA(1, 1, At, B1); PG8_BAR; PG8_SCHED;
        }
        if (wr == 0) PG8_BAR;
        { Unit cu; cu.pm = cpm; cu.pn = cpn; cu.koff = ckoff; cu.nt = cnt_; E(acc, cu, wr, wc, fr, fq); }
        if (!has_next) break;
#pragma unroll
        for (int a = 0; a < 2; ++a)
#pragma unroll
            for (int b = 0; b < 2; ++b)
#pragma unroll
                for (int m = 0; m < 4; ++m)
#pragma unroll
                    for (int n = 0; n < 2; ++n) acc[a][b][m][n] = (f32x4){0.f, 0.f, 0.f, 0.f};
        cpm = npm; cpn = npn; ckoff = nkoff; cnt_ = nnt; cA = nA; cB = nB; ++ui;
        if (wr == 1) PG8_BAR;
    }
    PG8_WAIT_V(0);
    PG8_BAR;
#undef PG8_SA
#undef PG8_SB
#undef PG8_STAGE
#undef PG8_LDA
#undef PG8_LDB
#undef PG8_MMA
#undef PG8_WAIT_V
#undef PG8_WAIT_L
#undef PG8_BAR
#undef PG8_SCHED
#undef PG8_KOFF
}
}
using pg8::Unit;
typedef f32x4 AccT[2][2][4][2];

struct EpiPlain {
    static constexpr bool PERM = true;
    bf16* O; int ldc;
    DI void operator()(const AccT& acc, const Unit& u, int wr, int wc, int fr, int fq) const {
        const int row0 = u.pm * 256 + wr * 64 + fr, col0 = u.pn * 256 + wc * 32 + 8 * fq;
#pragma unroll
        for (int ai = 0; ai < 2; ++ai)
#pragma unroll
            for (int m = 0; m < 4; ++m) { bf16* rowp = O + (size_t)(row0 + ai * 128 + m * 16) * ldc + col0;
#pragma unroll
                for (int bj = 0; bj < 2; ++bj) { const f32x4 v0 = acc[ai][bj][m][0], v1 = acc[ai][bj][m][1];
                    u32x4 w; w.x = pg8::cvt_pk_bf16(v0[0], v0[1]); w.y = pg8::cvt_pk_bf16(v0[2], v0[3]); w.z = pg8::cvt_pk_bf16(v1[0], v1[1]); w.w = pg8::cvt_pk_bf16(v1[2], v1[3]);
                    *(u32x4*)(rowp + bj * 128) = w; } }
    }
};
struct EpiIn0 {
    static constexpr bool PERM = true;
    bf16* O; float* AB;
    DI void operator()(const AccT& acc, const Unit& u, int wr, int wc, int fr, int fq) const {
        const int row0 = u.pm * 256 + wr * 64 + fr;
        if (u.pn < 20) {
            const int col0 = u.pn * 256 + wc * 32 + 8 * fq;
#pragma unroll
            for (int ai = 0; ai < 2; ++ai)
#pragma unroll
                for (int m = 0; m < 4; ++m) { bf16* rowp = O + (size_t)(row0 + ai * 128 + m * 16) * IN0_LD + col0;
#pragma unroll
                    for (int bj = 0; bj < 2; ++bj) { const f32x4 v0 = acc[ai][bj][m][0], v1 = acc[ai][bj][m][1];
                        u32x4 w; w.x = pg8::cvt_pk_bf16(v0[0], v0[1]); w.y = pg8::cvt_pk_bf16(v0[2], v0[3]); w.z = pg8::cvt_pk_bf16(v1[0], v1[1]); w.w = pg8::cvt_pk_bf16(v1[2], v1[3]);
                        *(u32x4*)(rowp + bj * 128) = w; } }
        } else if (wc == 0) {
#pragma unroll
            for (int ai = 0; ai < 2; ++ai)
#pragma unroll
                for (int m = 0; m < 4; ++m) { float* rowp = AB + (size_t)(row0 + ai * 128 + m * 16) * 32 + 8 * fq;
                    *(f32x4*)(rowp) = acc[ai][0][m][0]; *(f32x4*)(rowp + 4) = acc[ai][0][m][1]; }
        }
    }
};
template <bool XIN_F32> struct EpiRes {
    static constexpr bool PERM = true;
    const void* xin_l; bf16* xout_l; const float* mod; float* slab;
    DI void operator()(const AccT& acc, const Unit& u, int wr, int wc, int fr, int fq) const {
        const int b = u.pm / 17, j = u.pm % 17;
        const int r0 = wr * 64 + fr, col0 = u.pn * 256 + wc * 32 + 8 * fq;
        if (j == 0) {
            float* sp = slab + ((size_t)(u.nt >> 8) * 1024 + (size_t)b * 256) * DM;
#pragma unroll
            for (int ai = 0; ai < 2; ++ai)
#pragma unroll
                for (int m = 0; m < 4; ++m) { const size_t ro = (size_t)(r0 + ai * 128 + m * 16) * DM + col0;
#pragma unroll
                    for (int bj = 0; bj < 2; ++bj) { *(f32x4*)(sp + ro + bj * 128) = acc[ai][bj][m][0]; *(f32x4*)(sp + ro + bj * 128 + 4) = acc[ai][bj][m][1]; } }
            return;
        }
        const size_t off = ((size_t)b * SEQ + (size_t)(j - 1) * 256) * DM; const float* gt = mod + b * 12288;
        f32x4 gv[2][2];
#pragma unroll
        for (int bj = 0; bj < 2; ++bj)
#pragma unroll
            for (int n = 0; n < 2; ++n) gv[bj][n] = *(const f32x4*)(gt + col0 + bj * 128 + 4 * n);
#pragma unroll
        for (int ai = 0; ai < 2; ++ai)
#pragma unroll
            for (int m = 0; m < 4; ++m) { const size_t ro = off + (size_t)(r0 + ai * 128 + m * 16) * DM + col0;
#pragma unroll
                for (int bj = 0; bj < 2; ++bj) { f32x4 x0, x1;
                    if (XIN_F32) { x0 = *(const f32x4*)((const float*)xin_l + ro + bj * 128); x1 = *(const f32x4*)((const float*)xin_l + ro + bj * 128 + 4); }
                    else { const u32x4 w = *(const u32x4*)((const bf16*)xin_l + ro + bj * 128); x0 = (f32x4){lo16(w.x), hi16(w.x), lo16(w.y), hi16(w.y)}; x1 = (f32x4){lo16(w.z), hi16(w.z), lo16(w.w), hi16(w.w)}; }
                    const f32x4 o0 = x0 + gv[bj][0] * acc[ai][bj][m][0], o1 = x1 + gv[bj][1] * acc[ai][bj][m][1];
                    u32x4 w; w.x = pg8::cvt_pk_bf16(o0[0], o0[1]); w.y = pg8::cvt_pk_bf16(o0[2], o0[3]); w.z = pg8::cvt_pk_bf16(o1[0], o1[1]); w.w = pg8::cvt_pk_bf16(o1[2], o1[3]);
                    *(u32x4*)(xout_l + ro + bj * 128) = w; } }
    }
};
struct EpiSwiglu {
    static constexpr bool PERM = true;
    bf16* O;
    DI void operator()(const AccT& acc, const Unit& u, int wr, int wc, int fr, int fq) const {
        const int row0 = u.pm * 256 + wr * 64 + fr, col0 = u.pn * 128 + wc * 32 + 8 * fq;
#pragma unroll
        for (int ai = 0; ai < 2; ++ai)
#pragma unroll
            for (int m = 0; m < 4; ++m) { bf16* rowp = O + (size_t)(row0 + ai * 128 + m * 16) * DFF + col0;
                float v[8];
#pragma unroll
                for (int n = 0; n < 2; ++n)
#pragma unroll
                    for (int j = 0; j < 4; ++j) { const float a = acc[ai][0][m][n][j], b = acc[ai][1][m][n][j]; v[n * 4 + j] = a / (1.f + __expf(-a)) * b; }
                u32x4 w; w.x = pg8::cvt_pk_bf16(v[0], v[1]); w.y = pg8::cvt_pk_bf16(v[2], v[3]); w.z = pg8::cvt_pk_bf16(v[4], v[5]); w.w = pg8::cvt_pk_bf16(v[6], v[7]);
                *(u32x4*)rowp = w; }
    }
};
struct EpiGlu {
    static constexpr bool PERM = true;
    const bf16* Y; bf16* O; const float* gb;
    DI void operator()(const AccT& acc, const Unit& u, int wr, int wc, int fr, int fq) const {
        const int row0 = u.pm * 256 + wr * 64 + fr, col0 = u.pn * 256 + wc * 32 + 8 * fq;
#pragma unroll
        for (int bj = 0; bj < 2; ++bj) {
            const f32x4 b0 = *(const f32x4*)(gb + col0 + bj * 128), b1 = *(const f32x4*)(gb + col0 + bj * 128 + 4);
#pragma unroll
            for (int ai = 0; ai < 2; ++ai)
#pragma unroll
                for (int m = 0; m < 4; ++m) { const size_t r = (size_t)(row0 + ai * 128 + m * 16);
                    const u32x4 yw = *(const u32x4*)(Y + r * 1024 + col0 + bj * 128);
                    const f32x4 v0 = acc[ai][bj][m][0] + b0, v1 = acc[ai][bj][m][1] + b1;
                    float o[8];
                    o[0] = lo16(yw.x) * sigmoidf_(v0[0]); o[1] = hi16(yw.x) * sigmoidf_(v0[1]); o[2] = lo16(yw.y) * sigmoidf_(v0[2]); o[3] = hi16(yw.y) * sigmoidf_(v0[3]);
                    o[4] = lo16(yw.z) * sigmoidf_(v1[0]); o[5] = hi16(yw.z) * sigmoidf_(v1[1]); o[6] = lo16(yw.w) * sigmoidf_(v1[2]); o[7] = hi16(yw.w) * sigmoidf_(v1[3]);
                    u32x4 w; w.x = pg8::cvt_pk_bf16(o[0], o[1]); w.y = pg8::cvt_pk_bf16(o[2], o[3]); w.z = pg8::cvt_pk_bf16(o[4], o[5]); w.w = pg8::cvt_pk_bf16(o[6], o[7]);
                    *(u32x4*)(O + r * 2048 + col0 + bj * 128) = w; }
        }
    }
};
struct EpiGate {
    static constexpr bool PERM = true;
    const bf16* X; bf16* LA; bf16* BB; const float* ba; const float* bx; const float* spl;
    DI void operator()(const AccT& acc, const Unit& u, int wr, int wc, int fr, int fq) const {
        const int dir = u.pn >> 3, blk = u.pn & 7;
        const int row0 = u.pm * 256 + wr * 64 + fr, ch0 = blk * 128 + wc * 32 + 8 * fq;
        const f32x4 ba0 = *(const f32x4*)(ba + dir * 1024 + ch0), ba1 = *(const f32x4*)(ba + dir * 1024 + ch0 + 4);
        const f32x4 bx0 = *(const f32x4*)(bx + dir * 1024 + ch0), bx1 = *(const f32x4*)(bx + dir * 1024 + ch0 + 4);
        const f32x4 sp0 = *(const f32x4*)(spl + dir * 1024 + ch0), sp1 = *(const f32x4*)(spl + dir * 1024 + ch0 + 4);
#pragma unroll
        for (int ai = 0; ai < 2; ++ai)
#pragma unroll
            for (int m = 0; m < 4; ++m) { const size_t r = (size_t)(row0 + ai * 128 + m * 16);
                const u32x4 xw = *(const u32x4*)(X + r * 1024 + ch0);
                const float xv[8] = {lo16(xw.x), hi16(xw.x), lo16(xw.y), hi16(xw.y), lo16(xw.z), hi16(xw.z), lo16(xw.w), hi16(xw.w)};
                float la[8], bb[8];
#pragma unroll
                for (int n = 0; n < 2; ++n)
#pragma unroll
                    for (int j = 0; j < 4; ++j) { const int q = n * 4 + j;
                        const float pa = acc[ai][0][m][n][j] + (n ? ba1[j] : ba0[j]), px = acc[ai][1][m][n][j] + (n ? bx1[j] : bx0[j]);
                        const float rg = __builtin_amdgcn_rcpf(1.f + __expf(-pa)), ig = __builtin_amdgcn_rcpf(1.f + __expf(-px));
                        const float l = rg * (n ? sp1[j] : sp0[j]); la[q] = l;
                        const float x2 = 2.f * l;
                        const float ser = -x2 * (1.f + x2 * 0.5f * (1.f + x2 * (1.f / 3.f) * (1.f + x2 * 0.25f * (1.f + x2 * 0.2f))));
                        const float om = x2 > -0.25f ? ser : 1.f - __expf(x2);
                        bb[q] = __builtin_sqrtf(fmaxf(om, 0.f)) * (ig * xv[q]); }
                u32x4 w; w.x = pg8::cvt_pk_bf16(la[0], la[1]); w.y = pg8::cvt_pk_bf16(la[2], la[3]); w.z = pg8::cvt_pk_bf16(la[4], la[5]); w.w = pg8::cvt_pk_bf16(la[6], la[7]);
                *(u32x4*)(LA + (r * 2 + dir) * 1024 + ch0) = w;
                w.x = pg8::cvt_pk_bf16(bb[0], bb[1]); w.y = pg8::cvt_pk_bf16(bb[2], bb[3]); w.z = pg8::cvt_pk_bf16(bb[4], bb[5]); w.w = pg8::cvt_pk_bf16(bb[6], bb[7]);
                *(u32x4*)(BB + (r * 2 + dir) * 1024 + ch0) = w; }
    }
};
struct EpiRope {
    static constexpr bool PERM = true;
    bf16* O; const f32x2* rope;
    DI void operator()(const AccT& acc, const Unit& u, int wr, int wc, int fr, int fq) const {
        const int row0 = u.pm * 256 + wr * 64 + fr, col0 = u.pn * 256 + wc * 32 + 8 * fq;
        const int jt = u.pm % 17;
        const bool isqk = u.pn < 8, lat = jt != 0;
        const float sc = (u.pn >= 4 && u.pn < 8) ? 0.0625f : 1.f;
#pragma unroll
        for (int ai = 0; ai < 2; ++ai)
#pragma unroll
            for (int m = 0; m < 4; ++m) { const int rl = wr * 64 + fr + ai * 128 + m * 16;
                bf16* rowp = O + (size_t)(u.pm * 256 + rl) * INB_LD + col0;
                float t1[8], t2[8];
#pragma unroll
                for (int n = 0; n < 2; ++n)
#pragma unroll
                    for (int j = 0; j < 4; ++j) { t1[n * 4 + j] = acc[ai][0][m][n][j]; t2[n * 4 + j] = acc[ai][1][m][n][j]; }
                if (isqk && lat) {
                    const int pos = (jt - 1) * 256 + rl;
                    const int p = (wc < 2) ? (pos >> 6) : (pos & 63);
                    const int f0 = (wc & 1) * 32 + 8 * fq;
                    const f32x4* rp = (const f32x4*)(rope + p * 64 + f0);
#pragma unroll
                    for (int q = 0; q < 4; ++q) { const f32x4 cs = rp[q];
                        const float a0 = t1[2 * q], b0 = t2[2 * q], a1 = t1[2 * q + 1], b1 = t2[2 * q + 1];
                        t1[2 * q] = a0 * cs[0] - b0 * cs[1]; t2[2 * q] = a0 * cs[1] + b0 * cs[0];
                        t1[2 * q + 1] = a1 * cs[2] - b1 * cs[3]; t2[2 * q + 1] = a1 * cs[3] + b1 * cs[2]; }
                }
                u32x4 w; w.x = pg8::cvt_pk_bf16(t1[0] * sc, t1[1] * sc); w.y = pg8::cvt_pk_bf16(t1[2] * sc, t1[3] * sc); w.z = pg8::cvt_pk_bf16(t1[4] * sc, t1[5] * sc); w.w = pg8::cvt_pk_bf16(t1[6] * sc, t1[7] * sc);
                *(u32x4*)(rowp) = w;
                w.x = pg8::cvt_pk_bf16(t2[0] * sc, t2[1] * sc); w.y = pg8::cvt_pk_bf16(t2[2] * sc, t2[3] * sc); w.z = pg8::cvt_pk_bf16(t2[4] * sc, t2[5] * sc); w.w = pg8::cvt_pk_bf16(t2[6] * sc, t2[7] * sc);
                *(u32x4*)(rowp + 128) = w; }
    }
};

#define XB_TMO      128
#define XB_XCNT(j)  (256  + 64 * (j))
#define XB_XSUB(j)  (1280 + 64 * (j))
#define XB_XGEN(j)  (2304 + 64 * (j))
#define XB_TOP      3328
#define XB_TOPGEN   3392
#define XCD_BAR_WORDS 3456
#define XB_SPIN_CAP (1u << 22)
__device__ __forceinline__ unsigned xb_ld(unsigned* p)              { return __hip_atomic_load(p, __ATOMIC_RELAXED, __HIP_MEMORY_SCOPE_AGENT); }
__device__ __forceinline__ unsigned xb_add(unsigned* p, unsigned v) { return __hip_atomic_fetch_add(p, v, __ATOMIC_RELAXED, __HIP_MEMORY_SCOPE_AGENT); }
__device__ __forceinline__ unsigned xb_xcc_id() { return (unsigned)__builtin_amdgcn_s_getreg((3 << 11) | 20) & 0xFu; }
#define XB_SPIN(cond, bar) do { unsigned _sp = 0; while (cond) { __builtin_amdgcn_s_sleep(1); \
    if ((++_sp & 255u) == 0u) { if (xb_ld(&(bar)[XB_TMO])) break; if (_sp > XB_SPIN_CAP) { atomicAdd(&(bar)[XB_TMO], 1u); break; } } } } while (0)
struct XcdBarrier { unsigned* bar; unsigned x; volatile LAS unsigned* st; };
__device__ __forceinline__ XcdBarrier xcd_barrier_post(unsigned* bar, volatile LAS unsigned* st) {
    XcdBarrier b; b.bar = bar; b.x = xb_xcc_id(); b.st = st;
    if (threadIdx.x == 0) (void)xb_add(&bar[XB_XCNT(b.x)], 1u);
    return b;
}
__device__ __forceinline__ void xcd_barrier_complete(unsigned* bar, unsigned x, unsigned& nloc, unsigned& nx) {
    const unsigned G = gridDim.x * gridDim.y * gridDim.z;
    unsigned sum, cnt, mine, sp = 0u;
    for (;;) {
        sum = 0u; cnt = 0u; mine = 0u;
#pragma unroll
        for (unsigned j = 0; j < 16; ++j) { const unsigned c = xb_ld(&bar[XB_XCNT(j)]); sum += c; cnt += (c > 0u) ? 1u : 0u; mine = (j == x) ? c : mine; }
        if (sum == G) break;
        __builtin_amdgcn_s_sleep(1);
        if ((++sp & 255u) == 0u) { if (xb_ld(&bar[XB_TMO])) break; if (sp > XB_SPIN_CAP) { atomicAdd(&bar[XB_TMO], 1u); break; } }
    }
    nloc = mine > 0u ? mine : 1u; nx = cnt > 0u ? cnt : 1u;
}
__device__ __forceinline__ void xcd_barrier(const XcdBarrier& b) {
    asm volatile("s_waitcnt vmcnt(0)" ::: "memory");
    __syncthreads();
    if (threadIdx.x == 0) {
        unsigned* bar = b.bar;
        __builtin_amdgcn_s_waitcnt(0);
        unsigned nloc = b.st[0], nx = b.st[1];
        if (nloc == 0u) { xcd_barrier_complete(bar, b.x, nloc, nx); b.st[0] = nloc; b.st[1] = nx; }
        const unsigned old = xb_add(&bar[XB_XSUB(b.x)], 1u);
        const unsigned gen = old / nloc;
        if (old + 1u == (gen + 1u) * nloc) {
            __builtin_amdgcn_fence(__ATOMIC_RELEASE, "agent");
            asm volatile("s_waitcnt vmcnt(0)" ::: "memory");
            const unsigned og = xb_add(&bar[XB_TOP], 1u);
            const unsigned tg = og / nx;
            if (og + 1u == (tg + 1u) * nx) xb_add(&bar[XB_TOPGEN], 1u);
            else XB_SPIN(xb_ld(&bar[XB_TOPGEN]) == tg, bar);
            __builtin_amdgcn_fence(__ATOMIC_ACQUIRE, "agent");
            xb_add(&bar[XB_XGEN(b.x)], 1u);
            asm volatile("s_waitcnt vmcnt(0)" ::: "memory");
        } else {
            XB_SPIN(xb_ld(&bar[XB_XGEN(b.x)]) == gen, bar);
            __builtin_amdgcn_fence(__ATOMIC_ACQUIRE, "agent");
            asm volatile("s_waitcnt vmcnt(0)" ::: "memory");
        }
    }
    __syncthreads();
}

struct Args { const float* in[38]; float* out; unsigned char* ws; int ph_lo, ph_hi; };
enum { I_X = 0, I_C, I_CTX, I_CCTX, I_MODW, I_MODB, I_N1G, I_N2G, I_W1, I_W3, I_W2, I_FING, I_EWIN, I_EWOUT, I_LRE, I_LIM, I_LSTEP, I_BRE, I_BIM, I_CRE, I_CIM,
       I_S5D, I_GLUW, I_GLUB, I_DNCW, I_DNALOG, I_DNDT, I_DNNG, I_OWIN, I_OWOUT, I_LCW, I_LCB, I_LWA, I_LBA, I_LWX, I_LBX, I_LLAM, I_RTH };

constexpr int LDS_RING = 131072, LDS_CTL_OFF = 131072, LDS_BYTES = 147456;
constexpr int NW = 8;

DI void transpose_item(const float* W, int ldw, int k0, int n_src0, bf16* WT, int ldk, int dst_row0, LAS float* scr, int lane) {
#pragma unroll 8
    for (int i = 0; i < 32; ++i) { const int kk = 2 * i + (lane >> 5); scr[kk * 33 + (lane & 31)] = W[(size_t)(k0 + kk) * ldw + n_src0 + (lane & 31)]; }
    LDS_WAIT();
    const int c = lane & 7;
#pragma unroll
    for (int j = 0; j < 4; ++j) { const int n = (lane >> 3) + 8 * j; const LAS float* s = scr + (8 * c) * 33 + n;
        u32x4 o; o.x = pk2(s[0 * 33], s[1 * 33]); o.y = pk2(s[2 * 33], s[3 * 33]); o.z = pk2(s[4 * 33], s[5 * 33]); o.w = pk2(s[6 * 33], s[7 * 33]);
        *(u32x4*)(WT + (size_t)(dst_row0 + n) * ldk + k0 + 8 * c) = o; }
    LDS_WAIT();
}
DI void transpose_job(int it, const float* W, int K, int N, bf16* WT, int mode, int add, LAS float* scr, int lane) {
    const int nblk = N / 32, kb = it / nblk, nb = it % nblk, n0 = nb * 32;
    const int dr = mode ? ((n0 >> 7) * 256 + (n0 & 127) + add) : n0;
    transpose_item(W, N, kb * 64, n0, WT, K, dr, scr, lane);
}


#define BGW_ITEMS 67584
#define BGW_DECODE(it, LAYER) \
    const int job_ = (it) / 22528, idx_ = (it) - job_ * 22528; \
    const int KK_ = job_ < 2 ? 2048 : 5632, NN_ = job_ < 2 ? 5632 : 2048, kbs_ = KK_ >> 3; \
    const int nblk_ = idx_ / kbs_, kblk_ = idx_ - nblk_ * kbs_, n_ = nblk_ * 64 + lane; \
    const float* src_ = args.in[job_ == 0 ? I_W1 : (job_ == 1 ? I_W3 : I_W2)] + (size_t)(LAYER) * 2048 * 5632 + (size_t)(kblk_ * 8) * NN_ + n_; \
    const int row_ = job_ < 2 ? ((n_ >> 7) * 256 + (n_ & 127) + (job_ == 1 ? 128 : 0)) : n_; \
    bf16* dst_ = (bf16*)(WB + (job_ < 2 ? W_UP : W_DN)) + (size_t)row_ * KK_ + kblk_ * 8;
#define BGW_ISSUE(it, LAYER) do { if ((it) < BGW_ITEMS) { BGW_DECODE(it, LAYER) (void)dst_; \
        _Pragma("unroll") for (int e_ = 0; e_ < 8; ++e_) bgv[e_] = src_[(size_t)e_ * NN_]; bg_cur = (it); } else bg_cur = -1; } while (0)
#define BGW_STORE(LAYER) do { if (bg_cur >= 0) { BGW_DECODE(bg_cur, LAYER) (void)src_; \
        u32x4 w_; w_.x = pk2(bgv[0], bgv[1]); w_.y = pk2(bgv[2], bgv[3]); w_.z = pk2(bgv[4], bgv[5]); w_.w = pk2(bgv[6], bgv[7]); *(u32x4*)dst_ = w_; bg_cur = -1; } } while (0)

__global__ void __launch_bounds__(512, 2) fwd_kernel(Args args) {
    extern __shared__ __attribute__((aligned(16))) unsigned char lds_raw[];
    LAS unsigned char* lds = (LAS unsigned char*)lds_raw;
    const int tid0 = threadIdx.x;
    const int G = gridDim.x, bid = blockIdx.x;
    const int NGW = G * NW;
    unsigned char* ws = args.ws;
    float* MOD = (float*)(ws + WS_MOD);
    float* XC = (float*)(ws + WS_XC);
    bf16* XLb = (bf16*)(ws + WS_BIG + 340 * MiB);
    bf16* Hb = (bf16*)(ws + WS_H);
    bf16* MIX = (bf16*)(ws + WS_MIX);
    unsigned char* BIG = ws + WS_BIG;
    unsigned char* WB = ws + WS_W;
    float* SLAB = (float*)(BIG + 200 * MiB);
    float* T_ABAR = (float*)(ws + WS_TAB); float* T_APOW = (float*)(ws + WS_TAB + 65536); f32x2* T_ROPE = (f32x2*)(ws + WS_TAB + 131072);
    float* T_SPL = (float*)(ws + WS_TAB + 163840);
    float* T_BBR = (float*)(ws + WS_XC); float* T_BBI = (float*)(ws + WS_XC + MiB / 2);
    bf16* T_BBF = (bf16*)(ws + WS_TAB + MiB);
    bf16* T_CF = (bf16*)(ws + WS_TAB + MiB + MiB / 2);

    volatile LAS unsigned* CTLW = (volatile LAS unsigned*)(lds + LDS_CTL_OFF);
    for (int u = tid0; u < (LDS_BYTES - LDS_CTL_OFF) / 4; u += 512) CTLW[u] = 0u;
    __syncthreads();
#if MK_ONE_LAUNCH
    XcdBarrier bar = xcd_barrier_post((unsigned*)(ws + WS_CTL) + 4096, CTLW + 8);
#define SEAM() xcd_barrier(bar)
#else
#define SEAM() do {} while (0)
#endif
    const int lo = args.ph_lo, hi = args.ph_hi;
    int ph = 0;
#define PHASE_BEGIN if (ph >= lo && ph < hi) { int tid = tid0; asm volatile("" : "+v"(tid)); const int lane = tid & 63, wave = __builtin_amdgcn_readfirstlane(tid >> 6), gw = bid * NW + wave; (void)lane; (void)gw;
#define PHASE_END   if (ph + 1 < hi) SEAM(); } ++ph;

    PHASE_BEGIN
    {
        LAS float* sc = (LAS float*)lds;
        LAS float* red = (LAS float*)(lds + 40960);
        if (bid < 96) {
            for (int i = tid; i < 5 * 2048; i += 512) { const int r = i >> 11, k = i & 2047; const float v = r < 4 ? args.in[I_C][r * 2048 + k] : args.in[I_CCTX][k]; sc[i] = siluf_(v); }
            __syncthreads();
            for (int cb = bid; cb < 96; cb += G) {
                const int n0 = cb * 256, layer = n0 / 12288, nn = n0 % 12288;
                const float* W = args.in[I_MODW] + (size_t)layer * 2048 * 12288 + nn + lane * 4;
                float a[5][4];
#pragma unroll
                for (int r = 0; r < 5; ++r)
#pragma unroll
                    for (int j = 0; j < 4; ++j) a[r][j] = 0.f;
                const int kb = wave * 256;
#pragma unroll 8
                for (int k = kb; k < kb + 256; ++k) { const f32x4 w = *(const f32x4*)(W + (size_t)k * 12288);
#pragma unroll
                    for (int r = 0; r < 5; ++r) { const float s = sc[r * 2048 + k];
#pragma unroll
                        for (int j = 0; j < 4; ++j) a[r][j] += s * w[j]; } }
#pragma unroll
                for (int r = 0; r < 5; ++r)
#pragma unroll
                    for (int j = 0; j < 4; ++j) red[(wave * 5 + r) * 256 + lane * 4 + j] = a[r][j];
                __syncthreads();
                for (int i = tid; i < 5 * 256; i += 512) { const int r = i >> 8, cc = i & 255; float s = args.in[I_MODB][layer * 12288 + nn + cc];
#pragma unroll
                    for (int w = 0; w < 8; ++w) s += red[(w * 5 + r) * 256 + cc];
                    MOD[(size_t)(layer * 5 + r) * 12288 + nn + cc] = s; }
                __syncthreads();
            }
        }
        for (int i = bid * 512 + tid; i < 2 * 64 * 64 * 16; i += G * 512) {
            const int s = i & 15, p = (i >> 4) & 63, g = (i >> 10) & 63, d = i >> 16;
            const int ip = (d * 64 + g) * 64 + p;
            const float lre = fminf(args.in[I_LRE][ip], -1e-4f), lim = args.in[I_LIM][ip];
            const float dt = expf(args.in[I_LSTEP][d * 64 + g]);
            const float mag = expf(lre * dt); const float ar = mag * cosf(lim * dt), ai = mag * sinf(lim * dt);
            const float nr = ar - 1.f, ni = ai, den = lre * lre + lim * lim;
            const float cre = (nr * lre + ni * lim) / den, cim = (ni * lre - nr * lim) / den;
            const float br = args.in[I_BRE][(size_t)ip * 16 + s], bi = args.in[I_BIM][(size_t)ip * 16 + s];
            T_BBR[(size_t)ip * 16 + s] = cre * br - cim * bi; T_BBI[(size_t)ip * 16 + s] = cre * bi + cim * br;
            T_BBF[((size_t)(d * 64 + g) * 128 + p) * 16 + s] = (bf16)f2bf(cre * br - cim * bi); T_BBF[((size_t)(d * 64 + g) * 128 + 64 + p) * 16 + s] = (bf16)f2bf(cre * bi + cim * br);
            T_CF[((size_t)(d * 64 + g) * 16 + s) * 128 + p] = (bf16)f2bf(args.in[I_CRE][((size_t)(d * 64 + g) * 16 + s) * 64 + p]); T_CF[((size_t)(d * 64 + g) * 16 + s) * 128 + 64 + p] = (bf16)f2bf(-args.in[I_CIM][((size_t)(d * 64 + g) * 16 + s) * 64 + p]);
            if (s == 0) { T_ABAR[ip * 2] = ar; T_ABAR[ip * 2 + 1] = ai; float pr = ar, pi = ai;
#pragma unroll
                for (int q = 0; q < 6; ++q) { const float tr = pr * pr - pi * pi, ti = 2.f * pr * pi; pr = tr; pi = ti; }
                T_APOW[ip * 2] = pr; T_APOW[ip * 2 + 1] = pi; }
        }
        for (int i = bid * 512 + tid; i < 4096; i += G * 512) { const int p = i >> 6, f = i & 63; const float inv = powf(10000.f, -(float)f / 64.f); const float ang = (float)p * inv;
            f32x2 v; v.x = cosf(ang); v.y = sinf(ang); T_ROPE[i] = v; }
        for (int i = bid * 512 + tid; i < 2048; i += G * 512) T_SPL[i] = -8.f * softplusf_(-args.in[I_LLAM][i]);
        __syncthreads();
        LAS float* scr = (LAS float*)(lds + wave * 16384);
        constexpr int J0 = 32 * 161, J1 = 32 * 64, J2 = 16 * 32, J3 = 32 * 176, J4 = J3, J5 = 88 * 64;
        (void)J3; (void)J4; (void)J5;
        for (int it = gw; it < J0 + J1 + J2; it += NGW) {
            int r = it;
            if (r < J0) { transpose_job(r, args.in[I_EWIN], 2048, 5152, (bf16*)(WB + W_IN), 0, 0, scr, lane); continue; } r -= J0;
            if (r < J1) { transpose_job(r, args.in[I_EWOUT], 2048, 2048, (bf16*)(WB + W_OUT), 0, 0, scr, lane); continue; } r -= J1;
            transpose_job(r, args.in[I_GLUW], 1024, 1024, (bf16*)(WB + W_GLU), 0, 0, scr, lane);
        }
    }
    PHASE_END

#define ADALN(LAYER, WHICH, SRCBF, SRC_L, SRC_C, LATONLY, SLABP, SGATE) \
    for (int R = gw; R < MROWS; R += NGW) { const int b = R / SROW, s = R % SROW; const bool cx = s < CTX; if ((LATONLY) && cx) continue; \
        const float* md = MOD + (size_t)((LAYER) * 5 + (cx ? 4 : b)) * 12288 + (WHICH) * 3 * 2048; \
        const float* gn = args.in[(WHICH) ? I_N2G : I_N1G] + (LAYER) * 2048; \
        f32x4 v[8]; float ss = 0.f; \
        if ((SRCBF) && !cx) { const bf16* srcb = (const bf16*)(SRC_L) + ((size_t)b * SEQ + (s - CTX)) * DM; \
            _Pragma("unroll") for (int j = 0; j < 8; ++j) { const u32x2 w = *(const u32x2*)(srcb + lane * 4 + j * 256); v[j] = (f32x4){lo16(w.x), hi16(w.x), lo16(w.y), hi16(w.y)}; } } \
        else { const float* src = cx ? (SRC_C) + ((size_t)b * CTX + s) * DM : (const float*)(SRC_L) + ((size_t)b * SEQ + (s - CTX)) * DM; \
            _Pragma("unroll") for (int j = 0; j < 8; ++j) v[j] = *(const f32x4*)(src + lane * 4 + j * 256); } \
        if ((SLABP) != nullptr && cx) { const size_t crow = (size_t)b * CTX + s; \
            _Pragma("unroll") for (int j = 0; j < 8; ++j) { const int c = lane * 4 + j * 256; f32x4 a = (f32x4){0.f, 0.f, 0.f, 0.f}; \
                _Pragma("unroll") for (int sp = 0; sp < 8; ++sp) a += *(const f32x4*)((SLABP) + ((size_t)sp * 1024 + crow) * DM + c); \
                v[j] = v[j] + *(const f32x4*)((SGATE) + c) * a; *(f32x4*)(XC + crow * DM + c) = v[j]; } } \
        _Pragma("unroll") for (int j = 0; j < 8; ++j) ss += (v[j][0] * v[j][0] + v[j][1] * v[j][1]) + (v[j][2] * v[j][2] + v[j][3] * v[j][3]); \
        const float rstd = 1.f / sqrtf(wave_sum(ss) * (1.f / DM) + EPS); \
        _Pragma("unroll") for (int j = 0; j < 8; ++j) { const int c = lane * 4 + j * 256; const f32x4 gg = *(const f32x4*)(gn + c), sh = *(const f32x4*)(md + c), sl = *(const f32x4*)(md + 2048 + c); \
            const f32x4 o = v[j] * rstd * gg * (sl + 1.f) + sh; u32x2 w; w.x = pk2(o[0], o[1]); w.y = pk2(o[2], o[3]); *(u32x2*)(Hb + (size_t)R * DM + c) = w; } }

    PHASE_BEGIN
    ADALN(0, 0, false, args.in[I_X], args.in[I_CTX], false, (const float*)nullptr, (const float*)nullptr)
    PHASE_END

    PHASE_BEGIN
    { pg8::Gemm g{Hb, (const bf16*)(WB + W_IN), DM, DM, DM}; pg8::StaticOrder S; S.init(68, 21, G, bid, 0);
      EpiIn0 E{(bf16*)(BIG + B_IN0), (float*)(BIG + B_AB)};
      pg8::gemm_phase<EpiIn0>(lds, g, S, E); }
    PHASE_END

#define S5_PASS(READOUT) { \
        const bf16* IN0 = (const bf16*)(BIG + B_IN0); \
        LAS float* BU = (LAS float*)(lds + wave * 12800); LAS unsigned char* HB = lds + wave * 12800 + 8448; \
        const int r = lane & 15, q = lane >> 4; \
        const int NU = (READOUT) ? NB * 64 * NCH : NB * 64 * 2 * NCH; \
        for (int unit = gw; unit < NU; unit += NGW) { \
            const int c = unit % NCH; int rest = unit / NCH; const int g = rest & 63; rest >>= 6; \
            int dsel = 0, b; if (READOUT) b = rest; else { dsel = rest & 1; b = rest >> 1; } \
            const int R0 = b * SROW + c * 64; \
            bf16x8 Uf[4]; \
            _Pragma("unroll") for (int tt = 0; tt < 4; ++tt) { Uf[tt] = (bf16x8){0, 0, 0, 0, 0, 0, 0, 0}; if (q < 2) Uf[tt] = *(const bf16x8*)(IN0 + (size_t)(R0 + 16 * tt + r) * IN0_LD + g * 16 + 8 * q); } \
            f32x4 Y[4]; \
            _Pragma("unroll") for (int tt = 0; tt < 4; ++tt) Y[tt] = (f32x4){0.f, 0.f, 0.f, 0.f}; \
            for (int dd = 0; dd < ((READOUT) ? 2 : 1); ++dd) { \
                const int dir = (READOUT) ? dd : dsel; \
                bf16x8 Bf[8], Cf[4]; \
                _Pragma("unroll") for (int pt = 0; pt < 8; ++pt) { Bf[pt] = (bf16x8){0, 0, 0, 0, 0, 0, 0, 0}; if (q < 2) Bf[pt] = *(const bf16x8*)(T_BBF + ((size_t)(dir * 64 + g) * 128 + 16 * pt + r) * 16 + 8 * q); } \
                if (READOUT) { _Pragma("unroll") for (int ks = 0; ks < 4; ++ks) Cf[ks] = *(const bf16x8*)(T_CF + ((size_t)(dir * 64 + g) * 16 + r) * 128 + 32 * ks + 8 * q); } \
                const int ip = (dir * 64 + g) * 64 + lane; \
                const float ar = T_ABAR[ip * 2], ai = T_ABAR[ip * 2 + 1]; \
                float hr = 0.f, hi = 0.f; \
                if (READOUT) { const float* st = (const float*)(BIG + B_S5S) + ((((size_t)(b * 64 + g) * 2 + dir) * NCH + c) * 64 + lane) * 2; hr = st[0]; hi = st[1]; } \
                for (int ti = 0; ti < 4; ++ti) { const int tt = dir ? 3 - ti : ti; \
                    _Pragma("unroll") for (int pt = 0; pt < 8; ++pt) { const f32x4 cc = MFMA16(Uf[tt], Bf[pt], ((f32x4){0.f, 0.f, 0.f, 0.f})); \
                        _Pragma("unroll") for (int jj = 0; jj < 4; ++jj) BU[(4 * q + jj) * 132 + 16 * pt + r] = cc[jj]; } \
                    LDS_WAIT(); \
                    _Pragma("unroll") for (int i = 0; i < 16; ++i) { const int tl = dir ? 15 - i : i; \
                        const float bur = BU[tl * 132 + lane], bui = BU[tl * 132 + 64 + lane]; \
                        const float nr = ar * hr - ai * hi + bur, ni = ar * hi + ai * hr + bui; hr = nr; hi = ni; \
                        if (READOUT) { *(LAS bf16*)(HB + tl * 272 + lane * 2) = (bf16)f2bf(hr); *(LAS bf16*)(HB + tl * 272 + 128 + lane * 2) = (bf16)f2bf(hi); } } \
                    if (READOUT) { LDS_WAIT(); \
                        _Pragma("unroll") for (int ks = 0; ks < 4; ++ks) Y[tt] = MFMA16(frag_rows(HB, 272, 0, 32 * ks, r, q), Cf[ks], Y[tt]); } \
                    LDS_WAIT(); \
                } \
                if (!(READOUT)) { float* e = (float*)(BIG + B_S5E) + ((((size_t)(b * 64 + g) * 2 + dir) * NCH + c) * 64 + lane) * 2; e[0] = hr; e[1] = hi; } \
            } \
            if (READOUT) { const float dsk = args.in[I_S5D][g * 16 + r]; \
                _Pragma("unroll") for (int tt = 0; tt < 4; ++tt) \
                    _Pragma("unroll") for (int jj = 0; jj < 4; ++jj) { const size_t R = (size_t)(R0 + 16 * tt + 4 * q + jj); const float uu = bf2f(IN0[R * IN0_LD + g * 16 + r]); \
                        ((bf16*)(BIG + B_S5Y))[R * 1024 + g * 16 + r] = (bf16)f2bf(gelu_tanh(Y[tt][jj] + dsk * uu)); } } \
        } }

#define S5_ENDSTATE() { \
        const bf16* IN0 = (const bf16*)(BIG + B_IN0); \
        LAS float* ubuf = (LAS float*)(lds + wave * 4096); \
        for (int unit = gw; unit < NB * 64 * 2 * NCH; unit += NGW) { \
            const int c = unit % NCH; int rest = unit / NCH; const int g = rest & 63; rest >>= 6; const int dir = rest & 1, b = rest >> 1; \
            const int R0 = b * SROW + c * 64; \
            { const u32x4* up = (const u32x4*)(IN0 + (size_t)(R0 + lane) * IN0_LD + g * 16); const u32x4 w0 = up[0], w1 = up[1]; \
              *(LAS f32x4*)(ubuf + lane * 16) = (f32x4){lo16(w0.x), hi16(w0.x), lo16(w0.y), hi16(w0.y)}; *(LAS f32x4*)(ubuf + lane * 16 + 4) = (f32x4){lo16(w0.z), hi16(w0.z), lo16(w0.w), hi16(w0.w)}; \
              *(LAS f32x4*)(ubuf + lane * 16 + 8) = (f32x4){lo16(w1.x), hi16(w1.x), lo16(w1.y), hi16(w1.y)}; *(LAS f32x4*)(ubuf + lane * 16 + 12) = (f32x4){lo16(w1.z), hi16(w1.z), lo16(w1.w), hi16(w1.w)}; } \
            const int ip = (dir * 64 + g) * 64 + lane; \
            f32x2 cB[16]; \
            _Pragma("unroll") for (int q = 0; q < 4; ++q) { const f32x4 x = *(const f32x4*)(T_BBR + (size_t)ip * 16 + 4 * q), y = *(const f32x4*)(T_BBI + (size_t)ip * 16 + 4 * q); \
                _Pragma("unroll") for (int j = 0; j < 4; ++j) cB[4 * q + j] = (f32x2){x[j], y[j]}; } \
            const float ar = T_ABAR[ip * 2], ai = T_ABAR[ip * 2 + 1]; \
            float hr = 0.f, hi = 0.f; \
            LDS_WAIT(); \
            _Pragma("unroll 4") for (int ti = 0; ti < 64; ++ti) { const int t = dir ? 63 - ti : ti; \
                f32x2 bu0 = (f32x2){0.f, 0.f}, bu1 = (f32x2){0.f, 0.f}; \
                _Pragma("unroll") for (int q = 0; q < 4; ++q) { const f32x4 uu = *(const LAS f32x4*)(ubuf + t * 16 + 4 * q); \
                    bu0 = __builtin_elementwise_fma(cB[4 * q], (f32x2){uu[0], uu[0]}, bu0); bu1 = __builtin_elementwise_fma(cB[4 * q + 1], (f32x2){uu[1], uu[1]}, bu1); \
                    bu0 = __builtin_elementwise_fma(cB[4 * q + 2], (f32x2){uu[2], uu[2]}, bu0); bu1 = __builtin_elementwise_fma(cB[4 * q + 3], (f32x2){uu[3], uu[3]}, bu1); } \
                const f32x2 bu = bu0 + bu1; \
                const float nr = ar * hr - ai * hi + bu[0], ni = ar * hi + ai * hr + bu[1]; hr = nr; hi = ni; } \
            { float* e = (float*)(BIG + B_S5E) + ((((size_t)(b * 64 + g) * 2 + dir) * NCH + c) * 64 + lane) * 2; e[0] = hr; e[1] = hi; } \
            LDS_WAIT(); \
        } }

    PHASE_BEGIN
    for (int stg_ = 0; stg_ < 2; ++stg_) {
    if ((stg_ == 0) == (wave < 4)) {
    S5_ENDSTATE()
    } else {
        const bf16* IN0 = (const bf16*)(BIG + B_IN0); const float* AB = (const float*)(BIG + B_AB);
        bf16* DQ = (bf16*)(BIG + B_DNQ); bf16* DK = (bf16*)(BIG + B_DNK); bf16* DV = (bf16*)(BIG + B_DNV);
        float* DG = (float*)(BIG + B_DNG); float* DBt = (float*)(BIG + B_DNB);
        const float* cw = args.in[I_DNCW];
        int cur_combo = -1; f32x4 wv[8];
        for (int item = gw; item < MROWS * 6; item += NGW) {
            const int combo = item / MROWS, R = item - combo * MROWS, part = combo >> 1, hq = combo & 1;
            const int b = R / SROW, sx = R - b * SROW;
            const int seg_lo = sx < CTX ? 0 : CTX, seg_hi = sx < CTX ? CTX : SROW;
            const int cidx = part * 1024 + hq * 512 + lane * 8;
            if (combo != cur_combo) { cur_combo = combo;
#pragma unroll
                for (int e = 0; e < 8; ++e) wv[e] = *(const f32x4*)(cw + (size_t)(cidx + e) * 4); }
            float acc[8];
#pragma unroll
            for (int e = 0; e < 8; ++e) acc[e] = 0.f;
#pragma unroll
            for (int j = 0; j < 4; ++j) { const int sj = sx + j - 2;
                if (sj >= seg_lo && sj < seg_hi) { const u32x4 w = *(const u32x4*)(IN0 + (size_t)(b * SROW + sj) * IN0_LD + 1024 + cidx);
                    acc[0] += wv[0][j] * lo16(w.x); acc[1] += wv[1][j] * hi16(w.x); acc[2] += wv[2][j] * lo16(w.y); acc[3] += wv[3][j] * hi16(w.y);
                    acc[4] += wv[4][j] * lo16(w.z); acc[5] += wv[5][j] * hi16(w.z); acc[6] += wv[6][j] * lo16(w.w); acc[7] += wv[7][j] * hi16(w.w); } }
            float ss = 0.f;
#pragma unroll
            for (int e = 0; e < 8; ++e) { acc[e] = acc[e] * __builtin_amdgcn_rcpf(1.f + __expf(-acc[e])); ss += acc[e] * acc[e]; }
            ss += __shfl_xor(ss, 1); ss += __shfl_xor(ss, 2); ss += __shfl_xor(ss, 4); ss += __shfl_xor(ss, 8);
            const float sc = part == 0 ? 0.08838834764831845f / sqrtf(ss + EPS) : (part == 1 ? 1.f / sqrtf(ss + EPS) : 1.f);
            u32x4 o; o.x = pk2(acc[0] * sc, acc[1] * sc); o.y = pk2(acc[2] * sc, acc[3] * sc); o.z = pk2(acc[4] * sc, acc[5] * sc); o.w = pk2(acc[6] * sc, acc[7] * sc);
            bf16* dst = part == 0 ? DQ : (part == 1 ? DK : DV);
            *(u32x4*)(dst + (size_t)R * 1024 + hq * 512 + lane * 8) = o;
        }
        for (int i = bid * 512 + tid; i < MROWS * 16; i += G * 512) { const int R = i >> 4, l16 = i & 15;
            const float araw = AB[(size_t)R * 32 + l16], braw = AB[(size_t)R * 32 + 16 + l16];
            DG[i] = -expf(args.in[I_DNALOG][l16]) * softplusf_(araw + args.in[I_DNDT][l16]);
            DBt[i] = sigmoidf_(braw); }
    }
    }
    PHASE_END

    PHASE_BEGIN
    {
        for (int i = bid * 512 + tid; i < NB * 64 * 2 * 64; i += G * 512) {
            const int p = i & 63, dir = (i >> 6) & 1, bg = i >> 7, g = bg & 63;
            const int ip = (dir * 64 + g) * 64 + p; const float pr = T_APOW[ip * 2], pi = T_APOW[ip * 2 + 1];
            const float* E = (const float*)(BIG + B_S5E) + ((size_t)(bg * 2 + dir) * NCH) * 128 + p * 2;
            float* St = (float*)(BIG + B_S5S) + ((size_t)(bg * 2 + dir) * NCH) * 128 + p * 2;
            float sr = 0.f, si = 0.f;
            for (int k = 0; k < NCH; ++k) { const int c = dir == 0 ? k : (k < 4 ? 3 - k : 71 - k);
                St[c * 128] = sr; St[c * 128 + 1] = si; const float er = E[c * 128], ei = E[c * 128 + 1];
                const float nr = pr * sr - pi * si + er, ni = pr * si + pi * sr + ei; sr = nr; si = ni; }
        }
        {
            const bf16* DK = (const bf16*)(BIG + B_DNK); const float* DG = (const float*)(BIG + B_DNG); const float* DBt = (const float*)(BIG + B_DNB);
            bf16* TINV = (bf16*)((unsigned char*)MIX + MIX_TINV); bf16* WT = Hb; float* GCUM = (float*)(BIG + B_GCUM);
            constexpr int KC = 0, KB = 17408, KG = 34816, PA = 52224, PB = 61440, TA = 70656, TB = 79872, LO = 36864, WSo = 0  , GCo = 125952, BTo = 126208, RS = 272, PS = 144;
            const int r = lane & 15, q = lane >> 4, qq = r >> 2, pp = r & 3, it = wave >> 1, nh = wave & 1;
            LAS float* GC = (LAS float*)(lds + GCo); LAS float* BT = (LAS float*)(lds + BTo);
#define DN_ROW(n, row) ((size_t)b * SROW + (dir == 0 ? ((n) * 64 + (row)) : (((n) * 64 + (row)) < CTX ? CTX - 1 - ((n) * 64 + (row)) : SROW + CTX - 1 - ((n) * 64 + (row)))))
            for (int i = tid; i < 36864 / 4; i += 512) { ((LAS unsigned*)(lds + PA))[i] = 0u; ((LAS unsigned*)(lds + PA + LO))[i] = 0u; }
            __syncthreads();
            for (int unit = bid; unit < NB * 8 * 2 * NCH; unit += G) {
                const int n = unit % NCH; int rest = unit / NCH; const int dir = rest & 1; rest >>= 1; const int h = rest & 7, b = rest >> 3;
                u32x4 kreg[2];
#pragma unroll
                for (int k = 0; k < 2; ++k) { const int id = tid + 512 * k, row = id >> 4, cp = id & 15; kreg[k] = *(const u32x4*)(DK + DN_ROW(n, row) * 1024 + h * 128 + cp * 8); }
                if (wave == 0) { const size_t R = DN_ROW(n, lane); float g = DG[R * 16 + dir * 8 + h]; const float bt = DBt[R * 16 + dir * 8 + h];
#pragma unroll
                    for (int o = 1; o < 64; o <<= 1) { const float t = __shfl_up(g, o); if (lane >= o) g += t; }
                    GC[lane] = g; BT[lane] = bt; GCUM[(size_t)unit * 64 + lane] = g; }
                __syncthreads();
#pragma unroll
                for (int k = 0; k < 2; ++k) { const int id = tid + 512 * k, row = id >> 4, cp = id & 15; const float bt = BT[row], bg = bt * __expf(GC[row]);
                    const u32x4 w = kreg[k];
                    *(LAS u32x4*)(lds + KC + row * RS + cp * 16) = w;
                    u32x4 x; x.x = pk2(lo16(w.x) * bt, hi16(w.x) * bt); x.y = pk2(lo16(w.y) * bt, hi16(w.y) * bt); x.z = pk2(lo16(w.z) * bt, hi16(w.z) * bt); x.w = pk2(lo16(w.w) * bt, hi16(w.w) * bt);
                    *(LAS u32x4*)(lds + KB + row * RS + cp * 16) = x;
                    x.x = pk2(lo16(w.x) * bg, hi16(w.x) * bg); x.y = pk2(lo16(w.y) * bg, hi16(w.y) * bg); x.z = pk2(lo16(w.z) * bg, hi16(w.z) * bg); x.w = pk2(lo16(w.w) * bg, hi16(w.w) * bg);
                    *(LAS u32x4*)(lds + KG + row * RS + cp * 16) = x; }
                __syncthreads();
#pragma unroll
                for (int e = 0; e < 2; ++e) { const int jt = 2 * nh + e; f32x4 c = (f32x4){0.f, 0.f, 0.f, 0.f};
                    if (jt <= it) {
#pragma unroll
                        for (int ks = 0; ks < 4; ++ks) c = MFMA16(frag_rows(lds + KC, RS, 16 * jt, 32 * ks, r, q), frag_rows(lds + KB, RS, 16 * it, 32 * ks, r, q), c);
                        const float gi = GC[16 * it + r]; const f32x4 gj = *(const LAS f32x4*)(GC + 16 * jt + 4 * q);
#pragma unroll
                        for (int jj = 0; jj < 4; ++jj) c[jj] = (16 * jt + 4 * q + jj < 16 * it + r) ? -c[jj] * __expf(gi - gj[jj]) : 0.f; }
                    st_hl(lds + PA + (16 * it + r) * PS + (16 * jt + 4 * q) * 2, LO, c);
                    if (jt == it) {
#pragma unroll
                        for (int jj = 0; jj < 4; ++jj) if (4 * q + jj == r) c[jj] = 1.f; }
                    st_hl(lds + TA + (16 * it + r) * PS + (16 * jt + 4 * q) * 2, LO, c); }
                __syncthreads();
#pragma unroll
                for (int st = 1; st <= 6; ++st) {
                    LAS unsigned char* Pc = lds + ((st & 1) ? PA : PB); LAS unsigned char* Pn = lds + ((st & 1) ? PB : PA);
                    LAS unsigned char* Tc = lds + ((st & 1) ? TB : TA); LAS unsigned char* Tn = lds + ((st & 1) ? TA : TB);
                    if (st == 1) { Tc = lds + TA; }
                    f32x4 cP[2], cT[2];
#pragma unroll
                    for (int e = 0; e < 2; ++e) { const int nt = 2 * nh + e; cP[e] = (f32x4){0.f, 0.f, 0.f, 0.f}; cT[e] = (f32x4){0.f, 0.f, 0.f, 0.f};
                        if (st >= 2) { const u32x2 t0 = *(const LAS u32x2*)(Tc + (16 * it + r) * PS + (16 * nt + 4 * q) * 2), t1 = *(const LAS u32x2*)(Tc + LO + (16 * it + r) * PS + (16 * nt + 4 * q) * 2);
                            cT[e] = (f32x4){lo16(t0.x) + lo16(t1.x), hi16(t0.x) + hi16(t1.x), lo16(t0.y) + lo16(t1.y), hi16(t0.y) + hi16(t1.y)}; } }
                    {
#pragma unroll
                        for (int kb = 0; kb < 2; ++kb) {
                            bf16x8 rPh, rPl, rTh, rTl;
                            if (st <= 5) { rPh = frag_rows(Pc, PS, 16 * it, 32 * kb, r, q); rPl = frag_rows(Pc + LO, PS, 16 * it, 32 * kb, r, q); }
                            if (st >= 2) { rTh = frag_rows(Tc, PS, 16 * it, 32 * kb, r, q); rTl = frag_rows(Tc + LO, PS, 16 * it, 32 * kb, r, q); }
#pragma unroll
                            for (int e = 0; e < 2; ++e) { const int nt = 2 * nh + e;
                                { const bf16x8 th = frag_tr(Pc, PS, 32 * kb, 16 * nt, q, qq, pp), tl = frag_tr(Pc + LO, PS, 32 * kb, 16 * nt, q, qq, pp);
                                    if (st <= 5) cP[e] = mm3(cP[e], th, tl, rPh, rPl);
                                    if (st >= 2) cT[e] = mm3(cT[e], th, tl, rTh, rTl); } }
                        }
#pragma unroll
                        for (int e = 0; e < 2; ++e) { const int nt = 2 * nh + e;
                            { if (st <= 5) st_hl(Pn + (16 * it + r) * PS + (16 * nt + 4 * q) * 2, LO, cP[e]);
                                if (st >= 2) st_hl(Tn + (16 * it + r) * PS + (16 * nt + 4 * q) * 2, LO, cT[e]); } }
                    }
                    __syncthreads();
                }
#pragma unroll
                for (int e = 0; e < 4; ++e) { const int nt = 4 * nh + e; f32x4 c = (f32x4){0.f, 0.f, 0.f, 0.f};
#pragma unroll
                    for (int kb = 0; kb < 2; ++kb) c = MFMA16(frag_tr(lds + KG, RS, 32 * kb, 16 * nt, q, qq, pp), frag_rows(lds + TB, PS, 16 * it, 32 * kb, r, q), c);
                    u32x2 w; w.x = pk2(-c[0], -c[1]); w.y = pk2(-c[2], -c[3]); *(LAS u32x2*)(lds + WSo + (16 * it + r) * RS + (16 * nt + 4 * q) * 2) = w; }
                __syncthreads();
#pragma unroll
                for (int k = 0; k < 2; ++k) { const int id = tid + 512 * k, row = id >> 4, cp = id & 15; *(u32x4*)(WT + ((size_t)unit * 64 + row) * 128 + cp * 8) = *(const LAS u32x4*)(lds + WSo + row * RS + cp * 16); }
                { const int row = tid >> 3, cp = tid & 7; *(u32x4*)(TINV + ((size_t)unit * 64 + row) * 64 + cp * 8) = *(const LAS u32x4*)(lds + TB + row * PS + cp * 16); }
            }
        }
    }
    PHASE_END

    PHASE_BEGIN
    {
        const bf16* DQ = (const bf16*)(BIG + B_DNQ); const bf16* DK = (const bf16*)(BIG + B_DNK); const bf16* DV = (const bf16*)(BIG + B_DNV);
        const float* DBt = (const float*)(BIG + B_DNB); const bf16* TINV = (const bf16*)((unsigned char*)MIX + MIX_TINV); const bf16* WT = Hb; const float* GCUM = (const float*)(BIG + B_GCUM);
        constexpr int QC0 = 0, KC0 = 17408, QC1 = 34816, KC1 = 52224, WC = 69632, TI = 87040, VB = 96256, VN = 101376, VD = 105984, ST0 = 110592, ST1 = 119296, GS0 = 128000, GS1 = 128768, RS = 272, PS = 144, VBS = 80;
        const int r = lane & 15, q = lane >> 4, qq = r >> 2, pp = r & 3, it = wave >> 1, ct = wave & 1;
        for (int unit0 = bid; unit0 < NB * 8 * 2 * 4; unit0 += G) {
            const int unit = (unit0 & 7) * 32 + (unit0 >> 3);
            const int sl = unit & 3, dir = (unit >> 2) & 1, h = (unit >> 3) & 7, b = unit >> 6;
            const size_t ubase = (size_t)((b * 8 + h) * 2 + dir) * NCH;
            bf16* DO = (bf16*)(BIG + (dir ? B_DNO1 : B_DNO0));
            f32x4 Sacc[2] = {(f32x4){0.f, 0.f, 0.f, 0.f}, (f32x4){0.f, 0.f, 0.f, 0.f}};
            u32x4 rq[2], rk[2], rw[2], rt, rv; float rbeta = 0.f, rgc = 0.f;
#define DNB_LOAD(n) do { _Pragma("unroll") for (int k = 0; k < 2; ++k) { const int id = tid + 512 * k, row = id >> 4, cp = id & 15; const size_t R = DN_ROW(n, row); \
                    rq[k] = *(const u32x4*)(DQ + R * 1024 + h * 128 + cp * 8); rk[k] = *(const u32x4*)(DK + R * 1024 + h * 128 + cp * 8); \
                    rw[k] = *(const u32x4*)(WT + ((ubase + (n)) * 64 + row) * 128 + cp * 8); } \
                { const int row = tid >> 3, cp = tid & 7; rt = *(const u32x4*)(TINV + ((ubase + (n)) * 64 + row) * 64 + cp * 8); } \
                if (tid < 256) { const int row = tid >> 2, cp = tid & 3; const size_t R = DN_ROW(n, row); rv = *(const u32x4*)(DV + R * 1024 + h * 128 + sl * 32 + cp * 8); rbeta = DBt[R * 16 + dir * 8 + h]; } \
                if (tid < 64) rgc = GCUM[(ubase + (n)) * 64 + tid]; } while (0)
#define DNB_STAGE(QCo, KCo, GSo) do { _Pragma("unroll") for (int k = 0; k < 2; ++k) { const int id = tid + 512 * k, row = id >> 4, cp = id & 15; \
                    *(LAS u32x4*)(lds + (QCo) + row * RS + cp * 16) = rq[k]; *(LAS u32x4*)(lds + (KCo) + row * RS + cp * 16) = rk[k]; *(LAS u32x4*)(lds + WC + row * RS + cp * 16) = rw[k]; } \
                { const int row = tid >> 3, cp = tid & 7; *(LAS u32x4*)(lds + TI + row * PS + cp * 16) = rt; } \
                if (tid < 256) { const int row = tid >> 2, cp = tid & 3; u32x4 x; x.x = pk2(lo16(rv.x) * rbeta, hi16(rv.x) * rbeta); x.y = pk2(lo16(rv.y) * rbeta, hi16(rv.y) * rbeta); \
                    x.z = pk2(lo16(rv.z) * rbeta, hi16(rv.z) * rbeta); x.w = pk2(lo16(rv.w) * rbeta, hi16(rv.w) * rbeta); *(LAS u32x4*)(lds + VB + row * VBS + cp * 16) = x; } \
                if (tid < 64) { const float gl = __shfl(rgc, 63); LAS float* gs = (LAS float*)(lds + (GSo)); gs[tid] = rgc; gs[64 + tid] = __expf(rgc); gs[128 + tid] = __expf(gl - rgc); } } while (0)
            for (int i = tid; i < 8704 / 4; i += 512) ((LAS unsigned*)(lds + ST0))[i] = 0u;
            DNB_LOAD(0);
            DNB_STAGE(QC0, KC0, GS0);
            if (NCH > 1) DNB_LOAD(1);
            __syncthreads();
            float bgv[8]; int bg_cur = -1; int bg_it = gw;
            for (int n = 0; n < NCH; ++n) {
                BGW_STORE(0); BGW_ISSUE(bg_it, 0); bg_it += NGW;
                LAS unsigned char* QC = lds + ((n & 1) ? QC1 : QC0); LAS unsigned char* KC = lds + ((n & 1) ? KC1 : KC0);
                LAS float* GS = (LAS float*)(lds + ((n & 1) ? GS1 : GS0));
                LAS unsigned char* STc = lds + ((n & 1) ? ST1 : ST0); LAS unsigned char* STn = lds + ((n & 1) ? ST0 : ST1);
                { f32x4 c = (f32x4){0.f, 0.f, 0.f, 0.f};
#pragma unroll
                  for (int kb = 0; kb < 2; ++kb) c = MFMA16(frag_rows(lds + TI, PS, 16 * it, 32 * kb, r, q), frag_tr(lds + VB, VBS, 32 * kb, 16 * ct, q, qq, pp), c);
#pragma unroll
                  for (int ks = 0; ks < 4; ++ks) c = MFMA16(frag_rows(lds + WC, RS, 16 * it, 32 * ks, r, q), frag_rows(STc, RS, 16 * ct, 32 * ks, r, q), c);
                  const f32x4 ed = *(const LAS f32x4*)(GS + 128 + 16 * it + 4 * q);
                  u32x2 w; w.x = pk2(c[0], c[1]); w.y = pk2(c[2], c[3]); *(LAS u32x2*)(lds + VN + (16 * ct + r) * PS + (16 * it + 4 * q) * 2) = w;
                  w.x = pk2(c[0] * ed[0], c[1] * ed[1]); w.y = pk2(c[2] * ed[2], c[3] * ed[3]); *(LAS u32x2*)(lds + VD + (16 * ct + r) * PS + (16 * it + 4 * q) * 2) = w; }
                __syncthreads();
                if (n + 1 < NCH) { if (n & 1) DNB_STAGE(QC0, KC0, GS0); else DNB_STAGE(QC1, KC1, GS1); }
                if (n + 2 < NCH) DNB_LOAD(n + 2);
                { const float egl = GS[64 + 63];
#pragma unroll
                  for (int e = 0; e < 2; ++e) { f32x4 c = Sacc[e] * egl;
#pragma unroll
                      for (int kb = 0; kb < 2; ++kb) c = MFMA16(frag_tr(KC, RS, 32 * kb, 16 * wave, q, qq, pp), frag_rows(lds + VD, PS, 16 * e, 32 * kb, r, q), c);
                      Sacc[e] = c;
                      u32x2 w; w.x = pk2(c[0], c[1]); w.y = pk2(c[2], c[3]); *(LAS u32x2*)(STn + (16 * e + r) * RS + (16 * wave + 4 * q) * 2) = w; } }
                { f32x4 o = (f32x4){0.f, 0.f, 0.f, 0.f};
                  bf16x8 Qf[4];
#pragma unroll
                  for (int ks = 0; ks < 4; ++ks) Qf[ks] = frag_rows(QC, RS, 16 * it, 32 * ks, r, q);
#pragma unroll
                  for (int ks = 0; ks < 4; ++ks) o = MFMA16(Qf[ks], frag_rows(STc, RS, 16 * ct, 32 * ks, r, q), o);
                  { const f32x4 eg = *(const LAS f32x4*)(GS + 64 + 16 * it + 4 * q); o = o * eg; }
                  const float gi = GS[16 * it + r];
#pragma unroll
                  for (int kp = 0; kp < 2; ++kp) {
                      if (2 * kp <= it) { f32x4 pt[2];
#pragma unroll
                          for (int e = 0; e < 2; ++e) { const int jt = 2 * kp + e; f32x4 c = (f32x4){0.f, 0.f, 0.f, 0.f};
                              if (jt <= it) {
#pragma unroll
                                  for (int ks = 0; ks < 4; ++ks) c = MFMA16(frag_rows(KC, RS, 16 * jt, 32 * ks, r, q), Qf[ks], c);
                                  const f32x4 gj = *(const LAS f32x4*)(GS + 16 * jt + 4 * q);
#pragma unroll
                                  for (int jj = 0; jj < 4; ++jj) c[jj] = (16 * jt + 4 * q + jj <= 16 * it + r) ? c[jj] * __expf(gi - gj[jj]) : 0.f; }
                              pt[e] = c; }
                          o = MFMA16(pack_pair(pt[0], pt[1]), frag_rows_perm(lds + VN, PS, 16 * ct, 32 * kp, r, q), o); }
                  }
#pragma unroll
                  for (int jj = 0; jj < 4; ++jj) { const size_t R = DN_ROW(n, 16 * it + 4 * q + jj); DO[R * 1024 + h * 128 + sl * 32 + 16 * ct + r] = (bf16)f2bf(o[jj]); } }
                __syncthreads();
            }
            BGW_STORE(0);
            for (; bg_it < BGW_ITEMS; bg_it += NGW) { BGW_ISSUE(bg_it, 0); BGW_STORE(0); }
        }
#undef DNB_LOAD
#undef DNB_STAGE
    }
    S5_PASS(true)
    PHASE_END

    PHASE_BEGIN
    {
        const bf16* O0 = (const bf16*)(BIG + B_DNO0); const bf16* O1 = (const bf16*)(BIG + B_DNO1); const bf16* IN0 = (const bf16*)(BIG + B_IN0);
        for (int item = gw; item < MROWS * 8; item += NGW) {
            const int R = item >> 3, h = item & 7; const size_t o = (size_t)R * 1024 + h * 128 + 2 * lane;
            const unsigned a = *(const unsigned*)(O0 + o), c = *(const unsigned*)(O1 + o);
            const float v0 = lo16(a) + lo16(c), v1 = hi16(a) + hi16(c);
            const float ms = wave_sum(v0 * v0 + v1 * v1) * (1.f / 128.f); const float rs = 1.f / sqrtf(ms + EPS);
            const unsigned gt = *(const unsigned*)(IN0 + (size_t)R * IN0_LD + 4096 + h * 128 + 2 * lane);
            const float g0 = args.in[I_DNNG][2 * lane], g1 = args.in[I_DNNG][2 * lane + 1];
            *(unsigned*)(MIX + (size_t)R * 2048 + 1024 + h * 128 + 2 * lane) = pk2(v0 * rs * g0 * siluf_(lo16(gt)), v1 * rs * g1 * siluf_(hi16(gt)));
        }
    }
    { pg8::Gemm g{(const bf16*)(BIG + B_S5Y), (const bf16*)(WB + W_GLU), 1024, 1024, 1024}; pg8::StaticOrder S; S.init(68, 4, G, bid, 0);
      EpiGlu E{(const bf16*)(BIG + B_S5Y), MIX, args.in[I_GLUB]};
      pg8::gemm_phase<EpiGlu>(lds, g, S, E); }
    PHASE_END

    PHASE_BEGIN
    { pg8::Gemm g{MIX, (const bf16*)(WB + W_OUT), 2048, 2048, 2048}; pg8::TailOrder<32> S; S.init(G, bid);
      EpiRes<true> E{args.in[I_X], XLb, MOD + 2 * 2048, SLAB};
      pg8::gemm_phase<EpiRes<true>, pg8::TailOrder<32>>(lds, g, S, E); }
    PHASE_END

    PHASE_BEGIN
    ADALN(0, 1, true, XLb, args.in[I_CTX], false, SLAB, MOD + 4 * 12288 + 2 * 2048)
    PHASE_END

    PHASE_BEGIN
    { pg8::Gemm g{Hb, (const bf16*)(WB + W_UP), DM, DM, DM}; pg8::StaticOrder S; S.init(68, 44, G, bid, 0);
      EpiSwiglu E{(bf16*)(BIG + B_G)};
      pg8::gemm_phase<EpiSwiglu>(lds, g, S, E); }
    PHASE_END

    PHASE_BEGIN
    { pg8::Gemm g{(const bf16*)(BIG + B_G), (const bf16*)(WB + W_DN), DFF, DFF, DFF}; pg8::TailOrder<88> S; S.init(G, bid);
      EpiRes<false> E{XLb, XLb, MOD + 5 * 2048, SLAB};
      pg8::gemm_phase<EpiRes<false>, pg8::TailOrder<88>>(lds, g, S, E); }
    PHASE_END

    PHASE_BEGIN
    ADALN(1, 0, true, XLb, XC, false, SLAB, MOD + 4 * 12288 + 5 * 2048)
    {
        LAS float* scr = (LAS float*)(lds + wave * 16384);
        constexpr int J0 = 32 * 256, J1 = 48 * 64, J3 = 32 * 176, J4 = J3, J5 = 88 * 64;
        (void)J3; (void)J4; (void)J5;
        for (int it = gw; it < J0 + J1; it += NGW) {
            int r = it;
            if (r < J0) { transpose_job(r, args.in[I_OWIN], 2048, 8192, (bf16*)(WB + W_IN), 0, 0, scr, lane); continue; } r -= J0;
            transpose_job(r, args.in[I_OWOUT], 3072, 2048, (bf16*)(WB + W_OUT), 0, 0, scr, lane);
        }
        bf16* WG = (bf16*)(WB + W_GLU);
        for (int i = bid * 512 + tid; i < 4096 * 256 / 2; i += G * 512) {
            const int kk = (i & 127) * 2, np = i >> 7; const int e = np & 127, half = (np >> 7) & 1, q = np >> 8, blk = q & 7, dir = q >> 3;
            unsigned w = 0u;
            if ((kk >> 7) == (blk & 1)) { const float* src = args.in[half ? I_LWX : I_LWA] + ((size_t)(dir * 8 + blk) * 128 + (kk & 127)) * 128 + e; w = pk2(src[0], src[128]); }
            *(unsigned*)(WG + (size_t)np * 256 + kk) = w;
        }
    }
    PHASE_END

    PHASE_BEGIN
    { pg8::Gemm g{Hb, (const bf16*)(WB + W_IN), DM, DM, DM}; pg8::StaticOrder S; S.init(68, 8, G, bid, 0);
      EpiPlain E{(bf16*)(BIG + B_INA), 2048};
      pg8::gemm_phase<EpiPlain>(lds, g, S, E); }
    PHASE_END

    PHASE_BEGIN
    {
        const bf16* INA = (const bf16*)(BIG + B_INA); bf16* XCV = (bf16*)(BIG + B_XCV);
        for (size_t i = (size_t)bid * 512 + tid; i < (size_t)MROWS * 512; i += (size_t)G * 512) {
            const int R = (int)(i >> 9), ch = (int)(i & 511) * 2, b = R / SROW, s = R % SROW;
            const int seg_lo = s < CTX ? 0 : CTX, seg_hi = s < CTX ? CTX : SROW;
            const f32x4 w0 = *(const f32x4*)(args.in[I_LCW] + ch * 4), w1 = *(const f32x4*)(args.in[I_LCW] + ch * 4 + 4);
            float a0 = args.in[I_LCB][ch], a1 = args.in[I_LCB][ch + 1];
#pragma unroll
            for (int j = 0; j < 4; ++j) { const int sx = s + j - 2;
                if (sx >= seg_lo && sx < seg_hi) { const unsigned pr = *(const unsigned*)(INA + (size_t)(b * SROW + sx) * 2048 + ch); a0 += w0[j] * lo16(pr); a1 += w1[j] * hi16(pr); } }
            *(unsigned*)(XCV + (size_t)R * 1024 + ch) = pk2(a0, a1);
        }
    }
    PHASE_END

    PHASE_BEGIN
    { pg8::Gemm g{(const bf16*)(BIG + B_XCV), (const bf16*)(WB + W_GLU), 1024, 256, 256}; pg8::StaticOrder S; S.init(68, 16, G, bid, 0);
      EpiGate E{(const bf16*)(BIG + B_XCV), (bf16*)(BIG + B_LA), (bf16*)(BIG + B_BB), args.in[I_LBA], args.in[I_LBX], T_SPL};
      pg8::gemm_phase<EpiGate, pg8::StaticOrder, true>(lds, g, S, E); }
    PHASE_END

    PHASE_BEGIN
    {
        const bf16* LA = (const bf16*)(BIG + B_LA); const bf16* BBp = (const bf16*)(BIG + B_BB); float* EP = (float*)(BIG + B_LEP);
        for (int i = bid * 512 + tid; i < NB * 2 * NCH * 1024; i += G * 512) {
            const int ch = i & 1023; int rest = i >> 10; const int c = rest % NCH; rest /= NCH; const int dir = rest & 1, b = rest >> 1;
            float P = 1.f, h = 0.f;
            for (int ti = 0; ti < 64; ++ti) { const int t = dir ? 63 - ti : ti; const size_t o = ((size_t)(b * SROW + c * 64 + t) * 2 + dir) * 1024 + ch;
                const float a = expf(bf2f(LA[o])), bb = bf2f(BBp[o]); P *= a; h = a * h + bb; }
            EP[(size_t)i * 2] = P; EP[(size_t)i * 2 + 1] = h;
        }
    }
    PHASE_END

    PHASE_BEGIN
    {
        const float* EP = (const float*)(BIG + B_LEP); float* ST = (float*)(BIG + B_LST);
        for (int i = bid * 512 + tid; i < NB * 2 * 1024; i += G * 512) {
            const int ch = i & 1023, dir = (i >> 10) & 1, b = i >> 11; float s = 0.f;
            for (int k = 0; k < NCH; ++k) { const int c = dir == 0 ? k : (k < 4 ? 3 - k : 71 - k); const size_t o = ((size_t)(b * 2 + dir) * NCH + c) * 1024 + ch;
                ST[o] = s; s = EP[o * 2] * s + EP[o * 2 + 1]; }
        }
    }
    PHASE_END

    PHASE_BEGIN
    {
        const bf16* LA = (const bf16*)(BIG + B_LA); const bf16* BBp = (const bf16*)(BIG + B_BB); const float* ST = (const float*)(BIG + B_LST); const bf16* INA = (const bf16*)(BIG + B_INA);
        LAS float* hb = (LAS float*)lds;
        for (int u = bid; u < NB * 64 * 2; u += G) {
            const int half = u & 1, c = 4 + ((u >> 1) & 63), b = u >> 7, ch = half * 512 + tid;
            float h = ST[((size_t)(b * 2 + 0) * NCH + c) * 1024 + ch];
            for (int t = 0; t < 64; ++t) { const size_t o = ((size_t)(b * SROW + c * 64 + t) * 2 + 0) * 1024 + ch; h = expf(bf2f(LA[o])) * h + bf2f(BBp[o]); hb[t * 512 + tid] = h; }
            h = ST[((size_t)(b * 2 + 1) * NCH + c) * 1024 + ch];
            for (int t = 63; t >= 0; --t) { const size_t R = (size_t)(b * SROW + c * 64 + t); const size_t o = (R * 2 + 1) * 1024 + ch; h = expf(bf2f(LA[o])) * h + bf2f(BBp[o]);
                const float y = hb[t * 512 + tid] + h; const float gt = bf2f(INA[R * 2048 + 1024 + ch]);
                MIX[R * 3072 + ch] = (bf16)f2bf(y * gelu_tanh(gt)); }
        }
    }
    PHASE_END

    PHASE_BEGIN
    { pg8::Gemm g{Hb, (const bf16*)(WB + W_IN) + (size_t)2048 * 2048, DM, DM, DM}; pg8::StaticOrder S; S.init(68, 24, G, bid, 0);
      EpiRope E{(bf16*)(BIG + B_INB), T_ROPE};
      pg8::gemm_phase<EpiRope>(lds, g, S, E); }
    PHASE_END

    PHASE_BEGIN
    {
        const bf16* INB = (const bf16*)(BIG + B_INB);
        constexpr int QS = 0, KS = 33792, VS = 67584, TS = 76800, RS = 528, VRS = 144;
        const int r = lane & 15, q = lane >> 4, qq = r >> 2, pp = r & 3;
        const int it = wave >> 1, dvp = wave & 1;
        for (int unit0 = bid; unit0 < NB * 4 * 2 * 8; unit0 += G) {
            const int unit = (unit0 & 7) * 32 + (unit0 >> 3);
            const int sl = unit & 7, dir = (unit >> 3) & 1, h = (unit >> 4) & 3, b = unit >> 6;
            bf16* RO = (bf16*)(BIG + (dir ? B_RO1 : B_RO0));
            const float lgam = -expf(args.in[I_RTH][dir * 4 + h]);
            const float gC = expf(64.f * lgam);
            f32x4 Tacc[2][4];
#pragma unroll
            for (int a = 0; a < 2; ++a)
#pragma unroll
                for (int d = 0; d < 4; ++d) Tacc[a][d] = (f32x4){0.f, 0.f, 0.f, 0.f};
            const int vrow = tid >> 3, vcp = tid & 7;
            const float vsc = expf(-(float)vrow * lgam);
            u32x4 pq[4], pk[4], pv;
#define RT_ROW(n, row) ((size_t)b * SROW + (dir == 0 ? ((n) * 64 + (row)) : (((n) * 64 + (row)) < CTX ? CTX - 1 - ((n) * 64 + (row)) : SROW + CTX - 1 - ((n) * 64 + (row)))))
#define RT_LOAD(n) do { _Pragma("unroll") for (int k = 0; k < 4; ++k) { const int id = tid + 512 * k, row = id >> 5, cp = id & 31; const bf16* src = INB + RT_ROW(n, row) * INB_LD + h * 256 + cp * 8; \
                pq[k] = *(const u32x4*)src; pk[k] = *(const u32x4*)(src + 1024); } \
                pv = *(const u32x4*)(INB + RT_ROW(n, vrow) * INB_LD + 2048 + h * 512 + sl * 64 + vcp * 8); } while (0)
            RT_LOAD(0);
            float bgv[8]; int bg_cur = -1; int bg_it = gw;
            for (int n = 0; n < NCH; ++n) {
                BGW_STORE(1); BGW_ISSUE(bg_it, 1); bg_it += NGW;
#pragma unroll
                for (int k = 0; k < 4; ++k) { const int id = tid + 512 * k, row = id >> 5, cp = id & 31;
                    *(LAS u32x4*)(lds + QS + row * RS + cp * 16) = pq[k]; *(LAS u32x4*)(lds + KS + row * RS + cp * 16) = pk[k]; }
                { u32x4 w; w.x = pk2(lo16(pv.x) * vsc, hi16(pv.x) * vsc); w.y = pk2(lo16(pv.y) * vsc, hi16(pv.y) * vsc); w.z = pk2(lo16(pv.z) * vsc, hi16(pv.z) * vsc); w.w = pk2(lo16(pv.w) * vsc, hi16(pv.w) * vsc);
                  *(LAS u32x4*)(lds + VS + vrow * VRS + vcp * 16) = w; }
                const bool outp = n >= 4;
                if (outp) {
#pragma unroll
                    for (int a = 0; a < 2; ++a)
#pragma unroll
                        for (int d = 0; d < 4; ++d) { u32x2 w; w.x = pk2(Tacc[a][d][0], Tacc[a][d][1]); w.y = pk2(Tacc[a][d][2], Tacc[a][d][3]);
                            *(LAS u32x2*)(lds + TS + (16 * d + r) * RS + (16 * (2 * wave + a) + 4 * q) * 2) = w; }
                }
                __syncthreads();
                if (n + 1 < NCH) RT_LOAD(n + 1);
                if (outp) {
                    bf16x8 Qf[8];
#pragma unroll
                    for (int ks = 0; ks < 8; ++ks) Qf[ks] = *(const LAS bf16x8*)(lds + QS + (16 * it + r) * RS + (32 * ks + 8 * q) * 2);
                    f32x4 oacc[2];
#pragma unroll
                    for (int dd = 0; dd < 2; ++dd) { f32x4 c = (f32x4){0.f, 0.f, 0.f, 0.f};
#pragma unroll
                        for (int ks = 0; ks < 8; ++ks) { const bf16x8 tf = *(const LAS bf16x8*)(lds + TS + (16 * (2 * dvp + dd) + r) * RS + (32 * ks + 8 * q) * 2);
                            c = __builtin_amdgcn_mfma_f32_16x16x32_bf16(Qf[ks], tf, c, 0, 0, 0); }
                        oacc[dd] = c * gC; }
#pragma unroll
                    for (int kp = 0; kp < 2; ++kp) {
                        if (2 * kp <= it) {
                            f32x4 pt[2];
#pragma unroll
                            for (int e = 0; e < 2; ++e) { const int jt = 2 * kp + e; f32x4 c = (f32x4){0.f, 0.f, 0.f, 0.f};
                                if (jt <= it) {
#pragma unroll
                                    for (int ks = 0; ks < 8; ++ks) { const bf16x8 kf = *(const LAS bf16x8*)(lds + KS + (16 * jt + r) * RS + (32 * ks + 8 * q) * 2);
                                        c = __builtin_amdgcn_mfma_f32_16x16x32_bf16(kf, Qf[ks], c, 0, 0, 0); }
                                    if (jt == it) {
#pragma unroll
                                        for (int jj = 0; jj < 4; ++jj) if (4 * q + jj > r) c[jj] = 0.f; }
                                }
                                pt[e] = c; }
                            u32x4 pw; pw.x = pk2(pt[0][0], pt[0][1]); pw.y = pk2(pt[0][2], pt[0][3]); pw.z = pk2(pt[1][0], pt[1][1]); pw.w = pk2(pt[1][2], pt[1][3]);
                            const bf16x8 pf = __builtin_bit_cast(bf16x8, pw);
#pragma unroll
                            for (int dd = 0; dd < 2; ++dd) { const int dvt = 2 * dvp + dd;
                                const s16x4 v0 = __builtin_amdgcn_ds_read_tr16_b64_v4i16((LAS s16x4*)(lds + VS + (32 * kp + 4 * q + qq) * VRS + (16 * dvt + 4 * pp) * 2));
                                const s16x4 v1 = __builtin_amdgcn_ds_read_tr16_b64_v4i16((LAS s16x4*)(lds + VS + (32 * kp + 16 + 4 * q + qq) * VRS + (16 * dvt + 4 * pp) * 2));
                                const bf16x8 vf = {v0[0], v0[1], v0[2], v0[3], v1[0], v1[1], v1[2], v1[3]};
                                oacc[dd] = __builtin_amdgcn_mfma_f32_16x16x32_bf16(pf, vf, oacc[dd], 0, 0, 0); }
                        }
                    }
#pragma unroll
                    for (int jj = 0; jj < 4; ++jj) { const int i = 16 * it + 4 * q + jj; const float gi = expf((float)i * lgam);
                        const size_t R = RT_ROW(n, i); const size_t Rl = (size_t)b * SEQ + (R - (size_t)b * SROW - CTX);
#pragma unroll
                        for (int dd = 0; dd < 2; ++dd) RO[Rl * 2048 + h * 512 + sl * 64 + 16 * (2 * dvp + dd) + r] = (bf16)f2bf(oacc[dd][jj] * gi); }
                }
#pragma unroll
                for (int a = 0; a < 2; ++a)
#pragma unroll
                    for (int d = 0; d < 4; ++d) Tacc[a][d] = Tacc[a][d] * gC;
#pragma unroll
                for (int ks = 0; ks < 2; ++ks) {
                    bf16x8 kt[2], vf[4];
#pragma unroll
                    for (int a = 0; a < 2; ++a) { const int dkt = 2 * wave + a;
                        const s16x4 k0 = __builtin_amdgcn_ds_read_tr16_b64_v4i16((LAS s16x4*)(lds + KS + (32 * ks + 8 * q + qq) * RS + (16 * dkt + 4 * pp) * 2));
                        const s16x4 k1 = __builtin_amdgcn_ds_read_tr16_b64_v4i16((LAS s16x4*)(lds + KS + (32 * ks + 8 * q + 4 + qq) * RS + (16 * dkt + 4 * pp) * 2));
                        kt[a] = (bf16x8){k0[0], k0[1], k0[2], k0[3], k1[0], k1[1], k1[2], k1[3]}; }
#pragma unroll
                    for (int d = 0; d < 4; ++d) {
                        const s16x4 v0 = __builtin_amdgcn_ds_read_tr16_b64_v4i16((LAS s16x4*)(lds + VS + (32 * ks + 8 * q + qq) * VRS + (16 * d + 4 * pp) * 2));
                        const s16x4 v1 = __builtin_amdgcn_ds_read_tr16_b64_v4i16((LAS s16x4*)(lds + VS + (32 * ks + 8 * q + 4 + qq) * VRS + (16 * d + 4 * pp) * 2));
                        vf[d] = (bf16x8){v0[0], v0[1], v0[2], v0[3], v1[0], v1[1], v1[2], v1[3]}; }
#pragma unroll
                    for (int a = 0; a < 2; ++a)
#pragma unroll
                        for (int d = 0; d < 4; ++d) Tacc[a][d] = __builtin_amdgcn_mfma_f32_16x16x32_bf16(kt[a], vf[d], Tacc[a][d], 0, 0, 0);
                }
                __syncthreads();
            }
            BGW_STORE(1);
            for (; bg_it < BGW_ITEMS; bg_it += NGW) { BGW_ISSUE(bg_it, 1); BGW_STORE(1); }
        }
#undef RT_ROW
#undef RT_LOAD
    }
    PHASE_END

    PHASE_BEGIN
    {
        const bf16* O0 = (const bf16*)(BIG + B_RO0); const bf16* O1 = (const bf16*)(BIG + B_RO1); const bf16* INB = (const bf16*)(BIG + B_INB);
        for (int item = gw; item < NB * SEQ * 4; item += NGW) {
            const int Rl = item >> 2, h = item & 3, b = Rl / SEQ, n = Rl % SEQ; const size_t R = (size_t)b * SROW + CTX + n;
            const size_t o = (size_t)Rl * 2048 + h * 512 + lane * 8;
            const u32x4 a = *(const u32x4*)(O0 + o), c = *(const u32x4*)(O1 + o);
            float v[8] = {lo16(a.x) + lo16(c.x), hi16(a.x) + hi16(c.x), lo16(a.y) + lo16(c.y), hi16(a.y) + hi16(c.y), lo16(a.z) + lo16(c.z), hi16(a.z) + hi16(c.z), lo16(a.w) + lo16(c.w), hi16(a.w) + hi16(c.w)};
            float ss = 0.f;
#pragma unroll
            for (int e = 0; e < 8; ++e) ss += v[e] * v[e];
            const float rs = 1.f / sqrtf(wave_sum(ss) * (1.f / 512.f) + EPS);
            const u32x4 gw4 = *(const u32x4*)(INB + R * INB_LD + 4096 + h * 512 + lane * 8);
            const float gt[8] = {lo16(gw4.x), hi16(gw4.x), lo16(gw4.y), hi16(gw4.y), lo16(gw4.z), hi16(gw4.z), lo16(gw4.w), hi16(gw4.w)};
            u32x4 w; w.x = pk2(v[0] * rs * siluf_(gt[0]), v[1] * rs * siluf_(gt[1])); w.y = pk2(v[2] * rs * siluf_(gt[2]), v[3] * rs * siluf_(gt[3]));
            w.z = pk2(v[4] * rs * siluf_(gt[4]), v[5] * rs * siluf_(gt[5])); w.w = pk2(v[6] * rs * siluf_(gt[6]), v[7] * rs * siluf_(gt[7]));
            *(u32x4*)(MIX + R * 3072 + 1024 + h * 512 + lane * 8) = w;
        }
    }
    PHASE_END

    PHASE_BEGIN
    { pg8::Gemm g{MIX, (const bf16*)(WB + W_OUT), 3072, 3072, 3072}; pg8::StaticOrder S; S.init(64, 8, G, bid, 1);
      EpiRes<false> E{XLb, XLb, MOD + 5 * 12288 + 2 * 2048, SLAB};
      pg8::gemm_phase<EpiRes<false>>(lds, g, S, E); }
    PHASE_END

    PHASE_BEGIN
    ADALN(1, 1, true, XLb, XC, true, (const float*)nullptr, (const float*)nullptr)
    PHASE_END

    PHASE_BEGIN
    { pg8::Gemm g{Hb, (const bf16*)(WB + W_UP), DM, DM, DM}; pg8::StaticOrder S; S.init(64, 44, G, bid, 1);
      EpiSwiglu E{(bf16*)(BIG + B_G)};
      pg8::gemm_phase<EpiSwiglu>(lds, g, S, E); }
    PHASE_END

    PHASE_BEGIN
    { pg8::Gemm g{(const bf16*)(BIG + B_G), (const bf16*)(WB + W_DN), DFF, DFF, DFF}; pg8::StaticOrder S; S.init(64, 8, G, bid, 1);
      EpiRes<false> E{XLb, XLb, MOD + 5 * 12288 + 5 * 2048, SLAB};
      pg8::gemm_phase<EpiRes<false>>(lds, g, S, E); }
    PHASE_END

    PHASE_BEGIN
    {
        const float* fg = args.in[I_FING];
        for (int R = gw; R < NB * SEQ; R += NGW) { const bf16* xr = XLb + (size_t)R * DM; float* orow = args.out + (size_t)R * DM;
            f32x4 v[8]; float ss = 0.f;
#pragma unroll
            for (int j = 0; j < 8; ++j) { const u32x2 w = *(const u32x2*)(xr + lane * 4 + j * 256); v[j] = (f32x4){lo16(w.x), hi16(w.x), lo16(w.y), hi16(w.y)};
                ss += (v[j][0] * v[j][0] + v[j][1] * v[j][1]) + (v[j][2] * v[j][2] + v[j][3] * v[j][3]); }
            const float rstd = 1.f / sqrtf(wave_sum(ss) * (1.f / DM) + EPS);
#pragma unroll
            for (int j = 0; j < 8; ++j) { const f32x4 gg = *(const f32x4*)(fg + lane * 4 + j * 256); *(f32x4*)(orow + lane * 4 + j * 256) = v[j] * rstd * gg; }
        }
    }
    PHASE_END
}
constexpr int N_PHASES = 26;

extern "C" void kernel_launch(void* const* d_in, const int* in_sizes, int n_in, void* d_out, int out_size, void* d_ws, size_t ws_size, hipStream_t stream) {
    static int grid = 0;
    if (grid == 0) {
        if (n_in != 38 || out_size != NB * SEQ * DM || ws_size < WS_END) { fprintf(stderr, "kernel_launch: unexpected problem (n_in %d out %d ws %zu, need %zu)\n", n_in, out_size, ws_size, (size_t)WS_END); grid = -1; return; }
        int dev = 0, cus = 0;
        if (hipGetDevice(&dev) != hipSuccess || hipDeviceGetAttribute(&cus, hipDeviceAttributeMultiprocessorCount, dev) != hipSuccess) { grid = -1; return; }
        if (hipFuncSetAttribute((const void*)fwd_kernel, hipFuncAttributeMaxDynamicSharedMemorySize, LDS_BYTES) != hipSuccess) { fprintf(stderr, "kernel_launch: hipFuncSetAttribute failed\n"); grid = -1; return; }
        int per_cu = 0;
        if (hipOccupancyMaxActiveBlocksPerMultiprocessor(&per_cu, (const void*)fwd_kernel, 512, LDS_BYTES) != hipSuccess || per_cu < 1) { fprintf(stderr, "kernel_launch: occupancy query says %d\n", per_cu); }
        (void)hipGetLastError();
        if (per_cu < 1) { grid = -1; return; }
        grid = cus;
    }
    if (grid < 0) return;
    (void)hipMemsetAsync((char*)d_ws + WS_CTL, 0, CTL_BYTES, stream);
    Args a{};
    for (int i = 0; i < 38; ++i) a.in[i] = (const float*)d_in[i];
    a.out = (float*)d_out; a.ws = (unsigned char*)d_ws;
#if MK_ONE_LAUNCH
    a.ph_lo = 0; a.ph_hi = N_PHASES;
    hipLaunchKernelGGL(fwd_kernel, dim3(grid), dim3(512), LDS_BYTES, stream, a);
#else
    for (int p = 0; p < N_PHASES; ++p) { a.ph_lo = p; a.ph_hi = p + 1; hipLaunchKernelGGL(fwd_kernel, dim3(grid), dim3(512), LDS_BYTES, stream, a); }
#endif
}
```

```cpp
#include <hip/hip_runtime.h>
#include <cstdio>
#include <cstdint>

#ifndef MK_ONE_LAUNCH
#define MK_ONE_LAUNCH 1
#endif

#define DI __device__ __forceinline__
#define LAS __attribute__((address_space(3)))
typedef unsigned short bf16;
typedef short bf16x8 __attribute__((ext_vector_type(8)));
typedef float f32x4 __attribute__((ext_vector_type(4)));
typedef float f32x2 __attribute__((ext_vector_type(2)));
typedef unsigned u32x4 __attribute__((ext_vector_type(4)));
typedef unsigned u32x2 __attribute__((ext_vector_type(2)));
typedef short s16x4 __attribute__((ext_vector_type(4)));

constexpr int DM = 2048, NB = 4, SEQ = 4096, CTX = 256, DFF = 5632;
constexpr int SROW = CTX + SEQ;
constexpr int MROWS = NB * SROW;
constexpr int NCH = SROW / 64;
constexpr float EPS = 1e-6f;
constexpr int IN0_LD = 5120;
constexpr int INB_LD = 6144;

constexpr size_t MiB = 1u << 20;
constexpr size_t WS_CTL = 0, CTL_BYTES = 1 * MiB;
constexpr size_t WS_MOD = 1 * MiB;
constexpr size_t WS_TAB = 2 * MiB;
constexpr size_t WS_XC = 4 * MiB;
constexpr size_t WS_W = 12 * MiB;
constexpr size_t W_IN = 0, W_OUT = 32 * MiB, W_GLU = 44 * MiB, W_UP = 46 * MiB, W_DN = 90 * MiB;
constexpr size_t WS_H = 124 * MiB;
constexpr size_t WS_MIX = 192 * MiB;
constexpr size_t WS_BIG = 294 * MiB;
constexpr size_t B_IN0 = 0, B_AB = 170 * MiB, B_DNQ = 173 * MiB, B_DNK = 207 * MiB, B_DNV = 241 * MiB, B_DNG = 275 * MiB, B_DNB = 277 * MiB,
                 B_DNO0 = 279 * MiB, B_DNO1 = 313 * MiB, B_S5Y = 347 * MiB, B_S5E = 381 * MiB, B_S5S = 398 * MiB, B_GCUM = 415 * MiB, B_END0 = 417 * MiB;
constexpr size_t MIX_TINV = 68 * MiB;
constexpr size_t B_INA = 0, B_XCV = 68 * MiB, B_LA = 102 * MiB, B_BB = 170 * MiB, B_LEP = 238 * MiB, B_LST = 243 * MiB;
constexpr size_t B_INB = 0, B_RO0 = 204 * MiB, B_RO1 = 268 * MiB;
constexpr size_t B_G = 0;
constexpr size_t WS_END = WS_BIG + B_END0;

DI float bf2f(unsigned v) { return __uint_as_float(v << 16); }
typedef __bf16 bf16x2_t __attribute__((ext_vector_type(2)));
DI unsigned pk2(float lo, float hi) { const bf16x2_t v = __builtin_convertvector((f32x2){lo, hi}, bf16x2_t); return __builtin_bit_cast(unsigned, v); }
DI unsigned f2bf(float f) { return pk2(f, 0.f) & 0xffffu; }
DI float lo16(unsigned w) { return __uint_as_float(w << 16); }
DI float hi16(unsigned w) { return __uint_as_float(w & 0xffff0000u); }
DI float sigmoidf_(float x) { return __builtin_amdgcn_rcpf(1.f + __expf(-x)); }
DI float siluf_(float x) { return x * __builtin_amdgcn_rcpf(1.f + __expf(-x)); }
DI float softplusf_(float x) { return fmaxf(x, 0.f) + log1pf(expf(-fabsf(x))); }
DI float gelu_tanh(float x) { const float u = 0.7978845608028654f * (x + 0.044715f * x * x * x); return x * __builtin_amdgcn_rcpf(1.f + __expf(-2.f * u)); }
DI float wave_sum(float v) {
#pragma unroll
    for (int o = 1; o < 64; o <<= 1) v += __shfl_xor(v, o);
    return v;
}

DI bf16x8 frag_rows(LAS unsigned char* base, int RSB, int row0, int k0, int r, int q) { return *(const LAS bf16x8*)(base + (row0 + r) * RSB + (k0 + 8 * q) * 2); }
DI bf16x8 frag_tr(LAS unsigned char* base, int RSB, int k0, int n0, int q, int qq, int pp) {
    const s16x4 a = __builtin_amdgcn_ds_read_tr16_b64_v4i16((LAS s16x4*)(base + (k0 + 8 * q + qq) * RSB + (n0 + 4 * pp) * 2));
    const s16x4 b = __builtin_amdgcn_ds_read_tr16_b64_v4i16((LAS s16x4*)(base + (k0 + 8 * q + 4 + qq) * RSB + (n0 + 4 * pp) * 2));
    return (bf16x8){a[0], a[1], a[2], a[3], b[0], b[1], b[2], b[3]}; }
DI bf16x8 frag_rows_perm(LAS unsigned char* base, int RSB, int row0, int k0, int r, int q) {
    const u32x2 a = *(const LAS u32x2*)(base + (row0 + r) * RSB + (k0 + 4 * q) * 2), b = *(const LAS u32x2*)(base + (row0 + r) * RSB + (k0 + 16 + 4 * q) * 2);
    u32x4 w; w.x = a.x; w.y = a.y; w.z = b.x; w.w = b.y; return __builtin_bit_cast(bf16x8, w); }
DI bf16x8 pack_pair(const f32x4& x, const f32x4& y) { u32x4 w; w.x = pk2(x[0], x[1]); w.y = pk2(x[2], x[3]); w.z = pk2(y[0], y[1]); w.w = pk2(y[2], y[3]); return __builtin_bit_cast(bf16x8, w); }
#define MFMA16(a, b, c) __builtin_amdgcn_mfma_f32_16x16x32_bf16((a), (b), (c), 0, 0, 0)
DI void st_hl(LAS unsigned char* p, int lo_off, const f32x4& c) {
    u32x2 h; h.x = pk2(c[0], c[1]); h.y = pk2(c[2], c[3]);
    u32x2 l; l.x = pk2(c[0] - lo16(h.x), c[1] - hi16(h.x)); l.y = pk2(c[2] - lo16(h.y), c[3] - hi16(h.y));
    *(LAS u32x2*)p = h; *(LAS u32x2*)(p + lo_off) = l; }
DI f32x4 mm3(f32x4 c, const bf16x8& ah, const bf16x8& al, const bf16x8& bh, const bf16x8& bl) { c = MFMA16(ah, bh, c); c = MFMA16(ah, bl, c); c = MFMA16(al, bh, c); return c; }
#define LDS_WAIT() asm volatile("s_waitcnt lgkmcnt(0)" ::: "memory")
#define VM_WAIT() asm volatile("s_waitcnt vmcnt(0)" ::: "memory")

namespace pg8 {
constexpr int BM = 256, BK = 64, HALF = 128, HTB = HALF * BK * 2, STAGE_BYTES = 8 * HTB, NXCD = 8, WGM = 8;
DI int lds_byte(int r, int c) { const int st = (r >> 4) * 2 + (c >> 5), rr = r & 15, cc = c & 31, ob = rr * 64 + cc * 2; return st * 1024 + (ob ^ (((ob >> 9) & 1) << 5)); }
DI void stage_rc(int b, int& R, int& C) { const int st = b / 1024, sb = b % 1024, swz = sb ^ (((sb >> 9) & 1) << 5); R = (st >> 1) * 16 + swz / 64; C = (st & 1) * 32 + (swz % 64) / 2; }
DI int perm32(int rho) { const int n = rho >> 4, i = rho & 15; return 8 * (i >> 2) + 4 * n + (i & 3); }
struct Unit { int pm, pn, koff, nt; };
struct Gemm { const bf16* A; const bf16* Bt; int lda, ldb, K; };
struct StaticOrder {
    int nM, nN, nwg, G, c, lat;
    DI void init(int nM_, int nN_, int G_, int c_, int lat_) { nM = nM_; nN = nN_; nwg = nM * nN; G = G_; c = c_; lat = lat_; }
    DI bool next(int i, int& upm, int& upn, int& ukoff, int& unt) const {
        const long L = (long)i * G + c; if (L >= nwg) return false;
        int wgid = (int)L; { const int q = nwg / NXCD, r = nwg % NXCD, xcd = wgid % NXCD, off = wgid / NXCD; wgid = (xcd < r ? xcd * (q + 1) : r * (q + 1) + (xcd - r) * q) + off; }
        const int nig = WGM * nN, gid = wgid / nig, fm = gid * WGM, gsz = (nM - fm) < WGM ? (nM - fm) : WGM;
        int pm = fm + ((wgid % nig) % gsz); upn = (wgid % nig) / gsz;
        if (lat) pm = (pm >> 4) * 17 + 1 + (pm & 15);
        upm = pm; ukoff = 0; unt = 0; return true;
    }
};
template <int NTOT> struct TailOrder {
    int G, c;
    static constexpr int NWG = 512, LO = (NTOT / 8) & ~1, EX2 = (NTOT - LO * 8) >> 1;
    DI void init(int G_, int c_) { G = G_; c = c_; }
    DI bool next(int i, int& upm, int& upn, int& ukoff, int& unt) const {
        const int L = i * G + c; if (L >= NWG + 256) return false;
        const bool mainu = L < NWG; const int T = L - NWG;
        const int wgid = (L & 7) * (NWG / 8) + (L >> 3);
        const int w = wgid & 63, pml = (wgid >> 6) * 8 + (w & 7); const int ctn = T >> 3, sp = T & 7;
        upm = mainu ? (pml >> 4) * 17 + 1 + (pml & 15) : (ctn >> 3) * 17; upn = mainu ? (w >> 3) : (ctn & 7);
        unt = mainu ? 0 : ((LO + (sp < EX2 ? 2 : 0)) | (sp << 8)); ukoff = mainu ? 0 : (LO * sp + 2 * (sp < EX2 ? sp : EX2)) * 128; return true;
    }
};
DI unsigned cvt_pk_bf16(float lo, float hi) { unsigned r; asm volatile("v_cvt_pk_bf16_f32 %0, %1, %2" : "=v"(r) : "v"(lo), "v"(hi)); return r; }

template <class Epi, class Sched = StaticOrder, bool BLKDIAG = false>
DI void gemm_phase(LAS unsigned char* lds, const Gemm g, const Sched& S, const Epi& E) {
    int tid_ = threadIdx.x; asm volatile("" : "+v"(tid_));
    const int tid = tid_, wid = __builtin_amdgcn_readfirstlane(tid >> 6), lane = tid & 63, wr = wid >> 2, wc = wid & 3, fr = lane & 15, fq = lane >> 4;
    int K_ = g.K; asm volatile("" : "+s"(K_));
    const int K = K_, nt = K / BK;
    unsigned voffA[2], voffB[2];
#pragma unroll
    for (int i = 0; i < 2; ++i) { int R, C; stage_rc(tid * 16 + i * 8192, R, C); const int Rb = Epi::PERM ? ((R & ~31) + perm32(R & 31)) : R;
        voffA[i] = (unsigned)(R * g.lda + C) * 2u; voffB[i] = (unsigned)(Rb * g.ldb + C) * 2u; }
    const size_t kstep = (size_t)(BK * 2);
    const size_t hstepA = (size_t)HALF * g.lda * 2, hstepB = (size_t)HALF * g.ldb * 2;
    const size_t tstepA = 2 * hstepA, tstepB = 2 * hstepB;
    const unsigned ldsw = (unsigned)wid * 1024u;
    const int aoff = lds_byte(wr * 64 + fr, fq * 8), boff = lds_byte(wc * 32 + fr, fq * 8);
#define PG8_SA(b, h) (((b) * 2 + (h)) * HTB)
#define PG8_SB(b, h) ((4 + (b) * 2 + (h)) * HTB)
#define PG8_STAGE(bufoff, gbase, voff) do { _Pragma("unroll") for (int _i = 0; _i < 2; ++_i) \
        __builtin_amdgcn_global_load_lds((const unsigned*)((const char*)(gbase) + (voff)[_i]), (LAS unsigned*)(lds + (bufoff) + ldsw + _i * 8192), 16, 0, 0); } while (0)
#define PG8_LDA(dst, b, h) do { _Pragma("unroll") for (int m = 0; m < 4; ++m) _Pragma("unroll") for (int k = 0; k < 2; ++k) dst[m][k] = *(const LAS bf16x8*)(lds + PG8_SA(b, h) + aoff + m * 2048 + k * 1024); } while (0)
#define PG8_LDB(dst, b, h) do { _Pragma("unroll") for (int n = 0; n < 2; ++n) _Pragma("unroll") for (int k = 0; k < 2; ++k) dst[n][k] = *(const LAS bf16x8*)(lds + PG8_SB(b, h) + boff + n * 2048 + k * 1024); } while (0)
#define PG8_MMA(ai, bj, At, Bt) do { __builtin_amdgcn_s_setprio(1); _Pragma("unroll") for (int m = 0; m < 4; ++m) _Pragma("unroll") for (int n = 0; n < 2; ++n) _Pragma("unroll") for (int k = 0; k < 2; ++k) \
        acc[ai][bj][m][n] = __builtin_amdgcn_mfma_f32_16x16x32_bf16(Bt[n][k], At[m][k], acc[ai][bj][m][n], 0, 0, 0); __builtin_amdgcn_s_setprio(0); } while (0)
#define PG8_WAIT_V(n) asm volatile("s_waitcnt vmcnt(" #n ")" ::: "memory")
#define PG8_WAIT_L(n) asm volatile("s_waitcnt lgkmcnt(" #n ")" ::: "memory")
#define PG8_BAR __builtin_amdgcn_s_barrier()
#define PG8_SCHED __builtin_amdgcn_sched_barrier(0)
#define PG8_KOFF(pn_, koff_) ((BLKDIAG ? (size_t)(((pn_) & 7) >> 1) * 512 : (size_t)0) + (size_t)(koff_))
    int cpm, cpn, ckoff, cnt_, npm = 0, npn = 0, nkoff = 0, nnt = 0; int ui = 0;
    if (!S.next(0, cpm, cpn, ckoff, cnt_)) return;
    f32x4 acc[2][2][4][2];
#pragma unroll
    for (int a = 0; a < 2; ++a)
#pragma unroll
        for (int b = 0; b < 2; ++b)
#pragma unroll
            for (int m = 0; m < 4; ++m)
#pragma unroll
                for (int n = 0; n < 2; ++n) acc[a][b][m][n] = (f32x4){0.f, 0.f, 0.f, 0.f};
    bf16x8 At[4][2], B0[2][2], B1[2][2];
    const char* cA = (const char*)g.A + (size_t)cpm * tstepA + PG8_KOFF(cpn, ckoff); const char* cB = (const char*)g.Bt + (size_t)cpn * tstepB + (size_t)ckoff;
    PG8_STAGE(PG8_SB(0, 0), cB, voffB); PG8_STAGE(PG8_SB(0, 1), cB + hstepB, voffB); PG8_STAGE(PG8_SA(0, 0), cA, voffA); PG8_STAGE(PG8_SA(0, 1), cA + hstepA, voffA);
    if (wr == 1) PG8_BAR;
    PG8_WAIT_V(2); PG8_BAR;
    PG8_STAGE(PG8_SB(1, 0), cB + kstep, voffB); PG8_STAGE(PG8_SA(1, 0), cA + kstep, voffA); PG8_STAGE(PG8_SB(1, 1), cB + hstepB + kstep, voffB);
    PG8_WAIT_V(6); PG8_BAR;
    for (;;) {
        const bool has_next = S.next(ui + 1, npm, npn, nkoff, nnt);
        const char* nA = has_next ? (const char*)g.A + (size_t)npm * tstepA + PG8_KOFF(npn, nkoff) : cA; const char* nB = has_next ? (const char*)g.Bt + (size_t)npn * tstepB + (size_t)nkoff : cB;
        const int cnt = cnt_ ? (cnt_ & 255) : nt;
        for (int t = 0; t < cnt; t += 2) {
            const bool last = (t == cnt - 2);
            const char* a1 = cA + (size_t)(t + 1) * kstep;
            const char* a2 = last ? nA : cA + (size_t)(t + 2) * kstep; const char* b2 = last ? nB : cB + (size_t)(t + 2) * kstep;
            const char* a3 = a2 + kstep; const char* b3 = b2 + kstep;
            PG8_LDB(B0, 0, 0); PG8_LDB(B1, 0, 1); PG8_SCHED; PG8_LDA(At, 0, 0); PG8_STAGE(PG8_SA(1, 1), a1 + hstepA, voffA);
            PG8_WAIT_V(8); PG8_WAIT_L(0); PG8_BAR; PG8_MMA(0, 0, At, B0); PG8_MMA(0, 1, At, B1); PG8_BAR; PG8_SCHED;
            PG8_LDA(At, 0, 1); PG8_STAGE(PG8_SB(0, 0), b2, voffB); PG8_STAGE(PG8_SB(0, 1), b2 + hstepB, voffB); PG8_STAGE(PG8_SA(0, 0), a2, voffA);
            PG8_WAIT_V(8); PG8_WAIT_L(0); PG8_BAR; PG8_MMA(1, 0, At, B0); PG8_MMA(1, 1, At, B1); PG8_BAR; PG8_SCHED;
            PG8_LDB(B0, 1, 0); PG8_LDB(B1, 1, 1); PG8_SCHED; PG8_LDA(At, 1, 0); PG8_STAGE(PG8_SA(0, 1), a2 + hstepA, voffA);
            PG8_WAIT_V(8); PG8_WAIT_L(0); PG8_BAR; PG8_MMA(0, 0, At, B0); PG8_MMA(0, 1, At, B1); PG8_BAR; PG8_SCHED;
            PG8_LDA(At, 1, 1); PG8_STAGE(PG8_SB(1, 0), b3, voffB); PG8_STAGE(PG8_SB(1, 1), b3 + hstepB, voffB); PG8_STAGE(PG8_SA(1, 0), a3, voffA);
            PG8_WAIT_V(8); PG8_WAIT_L(0); PG8_BAR; PG8_MMA(1, 0, At, B0); PG8_MMA(1, 1, At, B1); PG8_BAR; PG8_SCHED;
        }
        if (wr == 0) PG8_BAR;
        { Unit cu; cu.pm = cpm; cu.pn = cpn; cu.koff = ckoff; cu.nt = cnt_; E(acc, cu, wr, wc, fr, fq); }
        if (!has_next) break;
#pragma unroll
        for (int a = 0; a < 2; ++a)
#pragma unroll
            for (int b = 0; b < 2; ++b)
#pragma unroll
                for (int m = 0; m < 4; ++m)
#pragma unroll
                    for (int n = 0; n < 2; ++n) acc[a][b][m][n] = (f32x4){0.f, 0.f, 0.f, 0.f};
        cpm = npm; cpn = npn; ckoff = nkoff; cnt_ = nnt; cA = nA; cB = nB; ++ui;
        if (wr == 1) PG8_BAR;
    }
    PG8_WAIT_V(0);
    PG8_BAR;
#undef PG8_SA
#undef PG8_SB
#undef PG8_STAGE
#undef PG8_LDA
#undef PG8_LDB
#undef PG8_MMA
#undef PG8_WAIT_V
#undef PG8_WAIT_L
#undef PG8_BAR
#undef PG8_SCHED
#undef PG8_KOFF
}
}
using pg8::Unit;
typedef f32x4 AccT[2][2][4][2];

struct EpiPlain {
    static constexpr bool PERM = true;
    bf16* O; int ldc;
    DI void operator()(const AccT& acc, const Unit& u, int wr, int wc, int fr, int fq) const {
        const int row0 = u.pm * 256 + wr * 64 + fr, col0 = u.pn * 256 + wc * 32 + 8 * fq;
#pragma unroll
        for (int ai = 0; ai < 2; ++ai)
#pragma unroll
            for (int m = 0; m < 4; ++m) { bf16* rowp = O + (size_t)(row0 + ai * 128 + m * 16) * ldc + col0;
#pragma unroll
                for (int bj = 0; bj < 2; ++bj) { const f32x4 v0 = acc[ai][bj][m][0], v1 = acc[ai][bj][m][1];
                    u32x4 w; w.x = pg8::cvt_pk_bf16(v0[0], v0[1]); w.y = pg8::cvt_pk_bf16(v0[2], v0[3]); w.z = pg8::cvt_pk_bf16(v1[0], v1[1]); w.w = pg8::cvt_pk_bf16(v1[2], v1[3]);
                    *(u32x4*)(rowp + bj * 128) = w; } }
    }
};
struct EpiIn0 {
    static constexpr bool PERM = true;
    bf16* O; float* AB;
    DI void operator()(const AccT& acc, const Unit& u, int wr, int wc, int fr, int fq) const {
        const int row0 = u.pm * 256 + wr * 64 + fr;
        if (u.pn < 20) {
            const int col0 = u.pn * 256 + wc * 32 + 8 * fq;
#pragma unroll
            for (int ai = 0; ai < 2; ++ai)
#pragma unroll
                for (int m = 0; m < 4; ++m) { bf16* rowp = O + (size_t)(row0 + ai * 128 + m * 16) * IN0_LD + col0;
#pragma unroll
                    for (int bj = 0; bj < 2; ++bj) { const f32x4 v0 = acc[ai][bj][m][0], v1 = acc[ai][bj][m][1];
                        u32x4 w; w.x = pg8::cvt_pk_bf16(v0[0], v0[1]); w.y = pg8::cvt_pk_bf16(v0[2], v0[3]); w.z = pg8::cvt_pk_bf16(v1[0], v1[1]); w.w = pg8::cvt_pk_bf16(v1[2], v1[3]);
                        *(u32x4*)(rowp + bj * 128) = w; } }
        } else if (wc == 0) {
#pragma unroll
            for (int ai = 0; ai < 2; ++ai)
#pragma unroll
                for (int m = 0; m < 4; ++m) { float* rowp = AB + (size_t)(row0 + ai * 128 + m * 16) * 32 + 8 * fq;
                    *(f32x4*)(rowp) = acc[ai][0][m][0]; *(f32x4*)(rowp + 4) = acc[ai][0][m][1]; }
        }
    }
};
template <bool XIN_F32> struct EpiRes {
    static constexpr bool PERM = true;
    const void* xin_l; bf16* xout_l; const float* mod; float* slab;
    DI void operator()(const AccT& acc, const Unit& u, int wr, int wc, int fr, int fq) const {
        const int b = u.pm / 17, j = u.pm % 17;
        const int r0 = wr * 64 + fr, col0 = u.pn * 256 + wc * 32 + 8 * fq;
        if (j == 0) {
            float* sp = slab + ((size_t)(u.nt >> 8) * 1024 + (size_t)b * 256) * DM;
#pragma unroll
            for (int ai = 0; ai < 2; ++ai)
#pragma unroll
                for (int m = 0; m < 4; ++m) { const size_t ro = (size_t)(r0 + ai * 128 + m * 16) * DM + col0;
#pragma unroll
                    for (int bj = 0; bj < 2; ++bj) { *(f32x4*)(sp + ro + bj * 128) = acc[ai][bj][m][0]; *(f32x4*)(sp + ro + bj * 128 + 4) = acc[ai][bj][m][1]; } }
            return;
        }
        const size_t off = ((size_t)b * SEQ + (size_t)(j - 1) * 256) * DM; const float* gt = mod + b * 12288;
        f32x4 gv[2][2];
#pragma unroll
        for (int bj = 0; bj < 2; ++bj)
#pragma unroll
            for (int n = 0; n < 2; ++n) gv[bj][n] = *(const f32x4*)(gt + col0 + bj * 128 + 4 * n);
#pragma unroll
        for (int ai = 0; ai < 2; ++ai)
#pragma unroll
            for (int m = 0; m < 4; ++m) { const size_t ro = off + (size_t)(r0 + ai * 128 + m * 16) * DM + col0;
#pragma unroll
                for (int bj = 0; bj < 2; ++bj) { f32x4 x0, x1;
                    if (XIN_F32) { x0 = *(const f32x4*)((const float*)xin_l + ro + bj * 128); x1 = *(const f32x4*)((const float*)xin_l + ro + bj * 128 + 4); }
                    else { const u32x4 w = *(const u32x4*)((const bf16*)xin_l + ro + bj * 128); x0 = (f32x4){lo16(w.x), hi16(w.x), lo16(w.y), hi16(w.y)}; x1 = (f32x4){lo16(w.z), hi16(w.z), lo16(w.w), hi16(w.w)}; }
                    const f32x4 o0 = x0 + gv[bj][0] * acc[ai][bj][m][0], o1 = x1 + gv[bj][1] * acc[ai][bj][m][1];
                    u32x4 w; w.x = pg8::cvt_pk_bf16(o0[0], o0[1]); w.y = pg8::cvt_pk_bf16(o0[2], o0[3]); w.z = pg8::cvt_pk_bf16(o1[0], o1[1]); w.w = pg8::cvt_pk_bf16(o1[2], o1[3]);
                    *(u32x4*)(xout_l + ro + bj * 128) = w; } }
    }
};
struct EpiSwiglu {
    static constexpr bool PERM = true;
    bf16* O;
    DI void operator()(const AccT& acc, const Unit& u, int wr, int wc, int fr, int fq) const {
        const int row0 = u.pm * 256 + wr * 64 + fr, col0 = u.pn * 128 + wc * 32 + 8 * fq;
#pragma unroll
        for (int ai = 0; ai < 2; ++ai)
#pragma unroll
            for (int m = 0; m < 4; ++m) { bf16* rowp = O + (size_t)(row0 + ai * 128 + m * 16) * DFF + col0;
                float v[8];
#pragma unroll
                for (int n = 0; n < 2; ++n)
#pragma unroll
                    for (int j = 0; j < 4; ++j) { const float a = acc[ai][0][m][n][j], b = acc[ai][1][m][n][j]; v[n * 4 + j] = a * __builtin_amdgcn_rcpf(1.f + __expf(-a)) * b; }
                u32x4 w; w.x = pg8::cvt_pk_bf16(v[0], v[1]); w.y = pg8::cvt_pk_bf16(v[2], v[3]); w.z = pg8::cvt_pk_bf16(v[4], v[5]); w.w = pg8::cvt_pk_bf16(v[6], v[7]);
                *(u32x4*)rowp = w; }
    }
};
struct EpiGlu {
    static constexpr bool PERM = true;
    const bf16* Y; bf16* O; const float* gb;
    DI void operator()(const AccT& acc, const Unit& u, int wr, int wc, int fr, int fq) const {
        const int row0 = u.pm * 256 + wr * 64 + fr, col0 = u.pn * 256 + wc * 32 + 8 * fq;
#pragma unroll
        for (int bj = 0; bj < 2; ++bj) {
            const f32x4 b0 = *(const f32x4*)(gb + col0 + bj * 128), b1 = *(const f32x4*)(gb + col0 + bj * 128 + 4);
#pragma unroll
            for (int ai = 0; ai < 2; ++ai)
#pragma unroll
                for (int m = 0; m < 4; ++m) { const size_t r = (size_t)(row0 + ai * 128 + m * 16);
                    const u32x4 yw = *(const u32x4*)(Y + r * 1024 + col0 + bj * 128);
                    const f32x4 v0 = acc[ai][bj][m][0] + b0, v1 = acc[ai][bj][m][1] + b1;
                    float o[8];
#define FSIG(x) __builtin_amdgcn_rcpf(1.f + __expf(-(x)))
                    o[0] = lo16(yw.x) * FSIG(v0[0]); o[1] = hi16(yw.x) * FSIG(v0[1]); o[2] = lo16(yw.y) * FSIG(v0[2]); o[3] = hi16(yw.y) * FSIG(v0[3]);
                    o[4] = lo16(yw.z) * FSIG(v1[0]); o[5] = hi16(yw.z) * FSIG(v1[1]); o[6] = lo16(yw.w) * FSIG(v1[2]); o[7] = hi16(yw.w) * FSIG(v1[3]);
#undef FSIG
                    u32x4 w; w.x = pg8::cvt_pk_bf16(o[0], o[1]); w.y = pg8::cvt_pk_bf16(o[2], o[3]); w.z = pg8::cvt_pk_bf16(o[4], o[5]); w.w = pg8::cvt_pk_bf16(o[6], o[7]);
                    *(u32x4*)(O + r * 2048 + col0 + bj * 128) = w; }
        }
    }
};
struct EpiGate {
    static constexpr bool PERM = true;
    const bf16* X; bf16* LA; bf16* BB; const float* ba; const float* bx; const float* spl;
    DI void operator()(const AccT& acc, const Unit& u, int wr, int wc, int fr, int fq) const {
        const int dir = u.pn >> 3, blk = u.pn & 7;
        const int row0 = u.pm * 256 + wr * 64 + fr, ch0 = blk * 128 + wc * 32 + 8 * fq;
        const f32x4 ba0 = *(const f32x4*)(ba + dir * 1024 + ch0), ba1 = *(const f32x4*)(ba + dir * 1024 + ch0 + 4);
        const f32x4 bx0 = *(const f32x4*)(bx + dir * 1024 + ch0), bx1 = *(const f32x4*)(bx + dir * 1024 + ch0 + 4);
        const f32x4 sp0 = *(const f32x4*)(spl + dir * 1024 + ch0), sp1 = *(const f32x4*)(spl + dir * 1024 + ch0 + 4);
#pragma unroll
        for (int ai = 0; ai < 2; ++ai)
#pragma unroll
            for (int m = 0; m < 4; ++m) { const size_t r = (size_t)(row0 + ai * 128 + m * 16);
                const u32x4 xw = *(const u32x4*)(X + r * 1024 + ch0);
                const float xv[8] = {lo16(xw.x), hi16(xw.x), lo16(xw.y), hi16(xw.y), lo16(xw.z), hi16(xw.z), lo16(xw.w), hi16(xw.w)};
                float la[8], bb[8];
#pragma unroll
                for (int n = 0; n < 2; ++n)
#pragma unroll
                    for (int j = 0; j < 4; ++j) { const int q = n * 4 + j;
                        const float pa = acc[ai][0][m][n][j] + (n ? ba1[j] : ba0[j]), px = acc[ai][1][m][n][j] + (n ? bx1[j] : bx0[j]);
                        const float rg = __builtin_amdgcn_rcpf(1.f + __expf(-pa)), ig = __builtin_amdgcn_rcpf(1.f + __expf(-px));
                        const float l = rg * (n ? sp1[j] : sp0[j]); la[q] = l;
                        const float x2 = 2.f * l;
                        const float ser = -x2 * (1.f + x2 * 0.5f * (1.f + x2 * (1.f / 3.f) * (1.f + x2 * 0.25f * (1.f + x2 * 0.2f))));
                        const float om = x2 > -0.25f ? ser : 1.f - __expf(x2);
                        bb[q] = __builtin_sqrtf(fmaxf(om, 0.f)) * (ig * xv[q]); }
                u32x4 w; w.x = pg8::cvt_pk_bf16(la[0], la[1]); w.y = pg8::cvt_pk_bf16(la[2], la[3]); w.z = pg8::cvt_pk_bf16(la[4], la[5]); w.w = pg8::cvt_pk_bf16(la[6], la[7]);
                *(u32x4*)(LA + (r * 2 + dir) * 1024 + ch0) = w;
                w.x = pg8::cvt_pk_bf16(bb[0], bb[1]); w.y = pg8::cvt_pk_bf16(bb[2], bb[3]); w.z = pg8::cvt_pk_bf16(bb[4], bb[5]); w.w = pg8::cvt_pk_bf16(bb[6], bb[7]);
                *(u32x4*)(BB + (r * 2 + dir) * 1024 + ch0) = w; }
    }
};
struct EpiRope {
    static constexpr bool PERM = true;
    bf16* O; const f32x2* rope;
    DI void operator()(const AccT& acc, const Unit& u, int wr, int wc, int fr, int fq) const {
        const int row0 = u.pm * 256 + wr * 64 + fr, col0 = u.pn * 256 + wc * 32 + 8 * fq;
        const int jt = u.pm % 17;
        const bool isqk = u.pn < 8, lat = jt != 0;
        const float sc = (u.pn >= 4 && u.pn < 8) ? 0.0625f : 1.f;
#pragma unroll
        for (int ai = 0; ai < 2; ++ai)
#pragma unroll
            for (int m = 0; m < 4; ++m) { const int rl = wr * 64 + fr + ai * 128 + m * 16;
                bf16* rowp = O + (size_t)(u.pm * 256 + rl) * INB_LD + col0;
                float t1[8], t2[8];
#pragma unroll
                for (int n = 0; n < 2; ++n)
#pragma unroll
                    for (int j = 0; j < 4; ++j) { t1[n * 4 + j] = acc[ai][0][m][n][j]; t2[n * 4 + j] = acc[ai][1][m][n][j]; }
                if (isqk && lat) {
                    const int pos = (jt - 1) * 256 + rl;
                    const int p = (wc < 2) ? (pos >> 6) : (pos & 63);
                    const int f0 = (wc & 1) * 32 + 8 * fq;
                    const f32x4* rp = (const f32x4*)(rope + p * 64 + f0);
#pragma unroll
                    for (int q = 0; q < 4; ++q) { const f32x4 cs = rp[q];
                        const float a0 = t1[2 * q], b0 = t2[2 * q], a1 = t1[2 * q + 1], b1 = t2[2 * q + 1];
                        t1[2 * q] = a0 * cs[0] - b0 * cs[1]; t2[2 * q] = a0 * cs[1] + b0 * cs[0];
                        t1[2 * q + 1] = a1 * cs[2] - b1 * cs[3]; t2[2 * q + 1] = a1 * cs[3] + b1 * cs[2]; }
                }
                u32x4 w; w.x = pg8::cvt_pk_bf16(t1[0] * sc, t1[1] * sc); w.y = pg8::cvt_pk_bf16(t1[2] * sc, t1[3] * sc); w.z = pg8::cvt_pk_bf16(t1[4] * sc, t1[5] * sc); w.w = pg8::cvt_pk_bf16(t1[6] * sc, t1[7] * sc);
                *(u32x4*)(rowp) = w;
                w.x = pg8::cvt_pk_bf16(t2[0] * sc, t2[1] * sc); w.y = pg8::cvt_pk_bf16(t2[2] * sc, t2[3] * sc); w.z = pg8::cvt_pk_bf16(t2[4] * sc, t2[5] * sc); w.w = pg8::cvt_pk_bf16(t2[6] * sc, t2[7] * sc);
                *(u32x4*)(rowp + 128) = w; }
    }
};

#define XB_TMO      128
#define XB_XCNT(j)  (256  + 64 * (j))
#define XB_XSUB(j)  (1280 + 64 * (j))
#define XB_XGEN(j)  (2304 + 64 * (j))
#define XB_TOP      3328
#define XB_TOPGEN   3392
#define XCD_BAR_WORDS 3456
#define XB_SPIN_CAP (1u << 22)
__device__ __forceinline__ unsigned xb_ld(unsigned* p)              { return __hip_atomic_load(p, __ATOMIC_RELAXED, __HIP_MEMORY_SCOPE_AGENT); }
__device__ __forceinline__ unsigned xb_add(unsigned* p, unsigned v) { return __hip_atomic_fetch_add(p, v, __ATOMIC_RELAXED, __HIP_MEMORY_SCOPE_AGENT); }
__device__ __forceinline__ unsigned xb_xcc_id() { return (unsigned)__builtin_amdgcn_s_getreg((3 << 11) | 20) & 0xFu; }
#define XB_SPIN(cond, bar) do { unsigned _sp = 0; while (cond) { __builtin_amdgcn_s_sleep(1); \
    if ((++_sp & 255u) == 0u) { if (xb_ld(&(bar)[XB_TMO])) break; if (_sp > XB_SPIN_CAP) { atomicAdd(&(bar)[XB_TMO], 1u); break; } } } } while (0)
struct XcdBarrier { unsigned* bar; unsigned x; volatile LAS unsigned* st; };
__device__ __forceinline__ XcdBarrier xcd_barrier_post(unsigned* bar, volatile LAS unsigned* st) {
    XcdBarrier b; b.bar = bar; b.x = xb_xcc_id(); b.st = st;
    if (threadIdx.x == 0) (void)xb_add(&bar[XB_XCNT(b.x)], 1u);
    return b;
}
__device__ __forceinline__ void xcd_barrier_complete(unsigned* bar, unsigned x, unsigned& nloc, unsigned& nx) {
    const unsigned G = gridDim.x * gridDim.y * gridDim.z;
    unsigned sum, cnt, mine, sp = 0u;
    for (;;) {
        sum = 0u; cnt = 0u; mine = 0u;
#pragma unroll
        for (unsigned j = 0; j < 16; ++j) { const unsigned c = xb_ld(&bar[XB_XCNT(j)]); sum += c; cnt += (c > 0u) ? 1u : 0u; mine = (j == x) ? c : mine; }
        if (sum == G) break;
        __builtin_amdgcn_s_sleep(1);
        if ((++sp & 255u) == 0u) { if (xb_ld(&bar[XB_TMO])) break; if (sp > XB_SPIN_CAP) { atomicAdd(&bar[XB_TMO], 1u); break; } }
    }
    nloc = mine > 0u ? mine : 1u; nx = cnt > 0u ? cnt : 1u;
}
__device__ __forceinline__ void xcd_barrier(const XcdBarrier& b) {
    asm volatile("s_waitcnt vmcnt(0)" ::: "memory");
    __syncthreads();
    if (threadIdx.x == 0) {
        unsigned* bar = b.bar;
        __builtin_amdgcn_s_waitcnt(0);
        unsigned nloc = b.st[0], nx = b.st[1];
        if (nloc == 0u) { xcd_barrier_complete(bar, b.x, nloc, nx); b.st[0] = nloc; b.st[1] = nx; }
        const unsigned old = xb_add(&bar[XB_XSUB(b.x)], 1u);
        const unsigned gen = old / nloc;
        if (old + 1u == (gen + 1u) * nloc) {
            __builtin_amdgcn_fence(__ATOMIC_RELEASE, "agent");
            asm volatile("s_waitcnt vmcnt(0)" ::: "memory");
            const unsigned og = xb_add(&bar[XB_TOP], 1u);
            const unsigned tg = og / nx;
            if (og + 1u == (tg + 1u) * nx) xb_add(&bar[XB_TOPGEN], 1u);
            else XB_SPIN(xb_ld(&bar[XB_TOPGEN]) == tg, bar);
            __builtin_amdgcn_fence(__ATOMIC_ACQUIRE, "agent");
            xb_add(&bar[XB_XGEN(b.x)], 1u);
            asm volatile("s_waitcnt vmcnt(0)" ::: "memory");
        } else {
            XB_SPIN(xb_ld(&bar[XB_XGEN(b.x)]) == gen, bar);
            __builtin_amdgcn_fence(__ATOMIC_ACQUIRE, "agent");
            asm volatile("s_waitcnt vmcnt(0)" ::: "memory");
        }
    }
    __syncthreads();
}

struct Args { const float* in[38]; float* out; unsigned char* ws; int ph_lo, ph_hi; };
enum { I_X = 0, I_C, I_CTX, I_CCTX, I_MODW, I_MODB, I_N1G, I_N2G, I_W1, I_W3, I_W2, I_FING, I_EWIN, I_EWOUT, I_LRE, I_LIM, I_LSTEP, I_BRE, I_BIM, I_CRE, I_CIM,
       I_S5D, I_GLUW, I_GLUB, I_DNCW, I_DNALOG, I_DNDT, I_DNNG, I_OWIN, I_OWOUT, I_LCW, I_LCB, I_LWA, I_LBA, I_LWX, I_LBX, I_LLAM, I_RTH };

constexpr int LDS_RING = 131072, LDS_CTL_OFF = 131072, LDS_BYTES = 147456;
constexpr int NW = 8;

DI void transpose_item(const float* W, int ldw, int k0, int n_src0, bf16* WT, int ldk, int dst_row0, LAS float* scr, int lane) {
#pragma unroll 8
    for (int i = 0; i < 32; ++i) { const int kk = 2 * i + (lane >> 5); scr[kk * 33 + (lane & 31)] = W[(size_t)(k0 + kk) * ldw + n_src0 + (lane & 31)]; }
    LDS_WAIT();
    const int c = lane & 7;
#pragma unroll
    for (int j = 0; j < 4; ++j) { const int n = (lane >> 3) + 8 * j; const LAS float* s = scr + (8 * c) * 33 + n;
        u32x4 o; o.x = pk2(s[0 * 33], s[1 * 33]); o.y = pk2(s[2 * 33], s[3 * 33]); o.z = pk2(s[4 * 33], s[5 * 33]); o.w = pk2(s[6 * 33], s[7 * 33]);
        *(u32x4*)(WT + (size_t)(dst_row0 + n) * ldk + k0 + 8 * c) = o; }
    LDS_WAIT();
}
DI void transpose_job(int it, const float* W, int K, int N, bf16* WT, int mode, int add, LAS float* scr, int lane) {
    const int nblk = N / 32, kb = it / nblk, nb = it % nblk, n0 = nb * 32;
    const int dr = mode ? ((n0 >> 7) * 256 + (n0 & 127) + add) : n0;
    transpose_item(W, N, kb * 64, n0, WT, K, dr, scr, lane);
}


#define BGW_ITEMS 67584
#define BGW_DECODE(it, LAYER) \
    const int job_ = (it) / 22528, idx_ = (it) - job_ * 22528; \
    const int KK_ = job_ < 2 ? 2048 : 5632, NN_ = job_ < 2 ? 5632 : 2048, kbs_ = KK_ >> 3; \
    const int nblk_ = idx_ / kbs_, kblk_ = idx_ - nblk_ * kbs_, n_ = nblk_ * 64 + lane; \
    const float* src_ = args.in[job_ == 0 ? I_W1 : (job_ == 1 ? I_W3 : I_W2)] + (size_t)(LAYER) * 2048 * 5632 + (size_t)(kblk_ * 8) * NN_ + n_; \
    const int row_ = job_ < 2 ? ((n_ >> 7) * 256 + (n_ & 127) + (job_ == 1 ? 128 : 0)) : n_; \
    bf16* dst_ = (bf16*)(WB + (job_ < 2 ? W_UP : W_DN)) + (size_t)row_ * KK_ + kblk_ * 8;
#define BGW_ISSUE(it, LAYER) do { if ((it) < BGW_ITEMS) { BGW_DECODE(it, LAYER) (void)dst_; \
        _Pragma("unroll") for (int e_ = 0; e_ < 8; ++e_) bgv[e_] = src_[(size_t)e_ * NN_]; bg_cur = (it); } else bg_cur = -1; } while (0)
#define BGW_STORE(LAYER) do { if (bg_cur >= 0) { BGW_DECODE(bg_cur, LAYER) (void)src_; \
        u32x4 w_; w_.x = pk2(bgv[0], bgv[1]); w_.y = pk2(bgv[2], bgv[3]); w_.z = pk2(bgv[4], bgv[5]); w_.w = pk2(bgv[6], bgv[7]); *(u32x4*)dst_ = w_; bg_cur = -1; } } while (0)

__global__ void __launch_bounds__(512, 2) fwd_kernel(Args args) {
    extern __shared__ __attribute__((aligned(16))) unsigned char lds_raw[];
    LAS unsigned char* lds = (LAS unsigned char*)lds_raw;
    const int tid0 = threadIdx.x;
    const int G = gridDim.x, bid = blockIdx.x;
    const int NGW = G * NW;
    unsigned char* ws = args.ws;
    float* MOD = (float*)(ws + WS_MOD);
    float* XC = (float*)(ws + WS_XC);
    bf16* XLb = (bf16*)(ws + WS_BIG + 340 * MiB);
    bf16* Hb = (bf16*)(ws + WS_H);
    bf16* MIX = (bf16*)(ws + WS_MIX);
    unsigned char* BIG = ws + WS_BIG;
    unsigned char* WB = ws + WS_W;
    float* SLAB = (float*)(BIG + 200 * MiB);
    float* T_ABAR = (float*)(ws + WS_TAB); float* T_APOW = (float*)(ws + WS_TAB + 65536); f32x2* T_ROPE = (f32x2*)(ws + WS_TAB + 131072);
    float* T_SPL = (float*)(ws + WS_TAB + 163840);
    float* T_BBR = (float*)(ws + WS_XC); float* T_BBI = (float*)(ws + WS_XC + MiB / 2);
    bf16* T_BBF = (bf16*)(ws + WS_TAB + MiB);
    bf16* T_CF = (bf16*)(ws + WS_TAB + MiB + MiB / 2);

    volatile LAS unsigned* CTLW = (volatile LAS unsigned*)(lds + LDS_CTL_OFF);
    for (int u = tid0; u < (LDS_BYTES - LDS_CTL_OFF) / 4; u += 512) CTLW[u] = 0u;
    __syncthreads();
#if MK_ONE_LAUNCH
    XcdBarrier bar = xcd_barrier_post((unsigned*)(ws + WS_CTL) + 4096, CTLW + 8);
#define SEAM() xcd_barrier(bar)
#else
#define SEAM() do {} while (0)
#endif
    const int lo = args.ph_lo, hi = args.ph_hi;
    int ph = 0;
#define PHASE_BEGIN if (ph >= lo && ph < hi) { int tid = tid0; asm volatile("" : "+v"(tid)); const int lane = tid & 63, wave = __builtin_amdgcn_readfirstlane(tid >> 6), gw = bid * NW + wave; (void)lane; (void)gw;
#define PHASE_END   if (ph + 1 < hi) SEAM(); } ++ph;

    PHASE_BEGIN
    {
        LAS float* sc = (LAS float*)lds;
        LAS float* red = (LAS float*)(lds + 40960);
        if (bid < 96) {
            for (int i = tid; i < 5 * 2048; i += 512) { const int r = i >> 11, k = i & 2047; const float v = r < 4 ? args.in[I_C][r * 2048 + k] : args.in[I_CCTX][k]; sc[i] = siluf_(v); }
            __syncthreads();
            for (int cb = bid; cb < 96; cb += G) {
                const int n0 = cb * 256, layer = n0 / 12288, nn = n0 % 12288;
                const float* W = args.in[I_MODW] + (size_t)layer * 2048 * 12288 + nn + lane * 4;
                float a[5][4];
#pragma unroll
                for (int r = 0; r < 5; ++r)
#pragma unroll
                    for (int j = 0; j < 4; ++j) a[r][j] = 0.f;
                const int kb = wave * 256;
#pragma unroll 8
                for (int k = kb; k < kb + 256; ++k) { const f32x4 w = *(const f32x4*)(W + (size_t)k * 12288);
#pragma unroll
                    for (int r = 0; r < 5; ++r) { const float s = sc[r * 2048 + k];
#pragma unroll
                        for (int j = 0; j < 4; ++j) a[r][j] += s * w[j]; } }
#pragma unroll
                for (int r = 0; r < 5; ++r)
#pragma unroll
                    for (int j = 0; j < 4; ++j) red[(wave * 5 + r) * 256 + lane * 4 + j] = a[r][j];
                __syncthreads();
                for (int i = tid; i < 5 * 256; i += 512) { const int r = i >> 8, cc = i & 255; float s = args.in[I_MODB][layer * 12288 + nn + cc];
#pragma unroll
                    for (int w = 0; w < 8; ++w) s += red[(w * 5 + r) * 256 + cc];
                    MOD[(size_t)(layer * 5 + r) * 12288 + nn + cc] = s; }
                __syncthreads();
            }
        }
        for (int i = bid * 512 + tid; i < 2 * 64 * 64 * 16; i += G * 512) {
            const int s = i & 15, p = (i >> 4) & 63, g = (i >> 10) & 63, d = i >> 16;
            const int ip = (d * 64 + g) * 64 + p;
            const float lre = fminf(args.in[I_LRE][ip], -1e-4f), lim = args.in[I_LIM][ip];
            const float dt = expf(args.in[I_LSTEP][d * 64 + g]);
            const float mag = expf(lre * dt); const float ar = mag * cosf(lim * dt), ai = mag * sinf(lim * dt);
            const float nr = ar - 1.f, ni = ai, den = lre * lre + lim * lim;
            const float cre = (nr * lre + ni * lim) / den, cim = (ni * lre - nr * lim) / den;
            const float br = args.in[I_BRE][(size_t)ip * 16 + s], bi = args.in[I_BIM][(size_t)ip * 16 + s];
            T_BBR[(size_t)ip * 16 + s] = cre * br - cim * bi; T_BBI[(size_t)ip * 16 + s] = cre * bi + cim * br;
            T_BBF[((size_t)(d * 64 + g) * 128 + p) * 16 + s] = (bf16)f2bf(cre * br - cim * bi); T_BBF[((size_t)(d * 64 + g) * 128 + 64 + p) * 16 + s] = (bf16)f2bf(cre * bi + cim * br);
            T_CF[((size_t)(d * 64 + g) * 16 + s) * 128 + p] = (bf16)f2bf(args.in[I_CRE][((size_t)(d * 64 + g) * 16 + s) * 64 + p]); T_CF[((size_t)(d * 64 + g) * 16 + s) * 128 + 64 + p] = (bf16)f2bf(-args.in[I_CIM][((size_t)(d * 64 + g) * 16 + s) * 64 + p]);
            if (s == 0) { T_ABAR[ip * 2] = ar; T_ABAR[ip * 2 + 1] = ai; float pr = ar, pi = ai;
#pragma unroll
                for (int q = 0; q < 6; ++q) { const float tr = pr * pr - pi * pi, ti = 2.f * pr * pi; pr = tr; pi = ti; }
                T_APOW[ip * 2] = pr; T_APOW[ip * 2 + 1] = pi; }
        }
        for (int i = bid * 512 + tid; i < 4096; i += G * 512) { const int p = i >> 6, f = i & 63; const float inv = powf(10000.f, -(float)f / 64.f); const float ang = (float)p * inv;
            f32x2 v; v.x = cosf(ang); v.y = sinf(ang); T_ROPE[i] = v; }
        for (int i = bid * 512 + tid; i < 2048; i += G * 512) T_SPL[i] = -8.f * softplusf_(-args.in[I_LLAM][i]);
        __syncthreads();
        LAS float* scr = (LAS float*)(lds + wave * 16384);
        constexpr int J0 = 32 * 161, J1 = 32 * 64, J2 = 16 * 32, J3 = 32 * 176, J4 = J3, J5 = 88 * 64;
        (void)J3; (void)J4; (void)J5;
        for (int it = gw; it < J0 + J1 + J2; it += NGW) {
            int r = it;
            if (r < J0) { transpose_job(r, args.in[I_EWIN], 2048, 5152, (bf16*)(WB + W_IN), 0, 0, scr, lane); continue; } r -= J0;
            if (r < J1) { transpose_job(r, args.in[I_EWOUT], 2048, 2048, (bf16*)(WB + W_OUT), 0, 0, scr, lane); continue; } r -= J1;
            transpose_job(r, args.in[I_GLUW], 1024, 1024, (bf16*)(WB + W_GLU), 0, 0, scr, lane);
        }
    }
    PHASE_END

#define ADALN(LAYER, WHICH, SRCBF, SRC_L, SRC_C, LATONLY, SLABP, SGATE) \
    for (int R = gw; R < MROWS; R += NGW) { const int b = R / SROW, s = R % SROW; const bool cx = s < CTX; if ((LATONLY) && cx) continue; \
        const float* md = MOD + (size_t)((LAYER) * 5 + (cx ? 4 : b)) * 12288 + (WHICH) * 3 * 2048; \
        const float* gn = args.in[(WHICH) ? I_N2G : I_N1G] + (LAYER) * 2048; \
        f32x4 v[8]; float ss = 0.f; \
        if ((SRCBF) && !cx) { const bf16* srcb = (const bf16*)(SRC_L) + ((size_t)b * SEQ + (s - CTX)) * DM; \
            _Pragma("unroll") for (int j = 0; j < 8; ++j) { const u32x2 w = *(const u32x2*)(srcb + lane * 4 + j * 256); v[j] = (f32x4){lo16(w.x), hi16(w.x), lo16(w.y), hi16(w.y)}; } } \
        else { const float* src = cx ? (SRC_C) + ((size_t)b * CTX + s) * DM : (const float*)(SRC_L) + ((size_t)b * SEQ + (s - CTX)) * DM; \
            _Pragma("unroll") for (int j = 0; j < 8; ++j) v[j] = *(const f32x4*)(src + lane * 4 + j * 256); } \
        if ((SLABP) != nullptr && cx) { const size_t crow = (size_t)b * CTX + s; \
            _Pragma("unroll") for (int j = 0; j < 8; ++j) { const int c = lane * 4 + j * 256; f32x4 a = (f32x4){0.f, 0.f, 0.f, 0.f}; \
                _Pragma("unroll") for (int sp = 0; sp < 8; ++sp) a += *(const f32x4*)((SLABP) + ((size_t)sp * 1024 + crow) * DM + c); \
                v[j] = v[j] + *(const f32x4*)((SGATE) + c) * a; *(f32x4*)(XC + crow * DM + c) = v[j]; } } \
        _Pragma("unroll") for (int j = 0; j < 8; ++j) ss += (v[j][0] * v[j][0] + v[j][1] * v[j][1]) + (v[j][2] * v[j][2] + v[j][3] * v[j][3]); \
        const float rstd = __builtin_amdgcn_rsqf(wave_sum(ss) * (1.f / DM) + EPS); \
        _Pragma("unroll") for (int j = 0; j < 8; ++j) { const int c = lane * 4 + j * 256; const f32x4 gg = *(const f32x4*)(gn + c), sh = *(const f32x4*)(md + c), sl = *(const f32x4*)(md + 2048 + c); \
            const f32x4 o = v[j] * rstd * gg * (sl + 1.f) + sh; u32x2 w; w.x = pk2(o[0], o[1]); w.y = pk2(o[2], o[3]); *(u32x2*)(Hb + (size_t)R * DM + c) = w; } }

    PHASE_BEGIN
    ADALN(0, 0, false, args.in[I_X], args.in[I_CTX], false, (const float*)nullptr, (const float*)nullptr)
    PHASE_END

    PHASE_BEGIN
    { pg8::Gemm g{Hb, (const bf16*)(WB + W_IN), DM, DM, DM}; pg8::StaticOrder S; S.init(68, 21, G, bid, 0);
      EpiIn0 E{(bf16*)(BIG + B_IN0), (float*)(BIG + B_AB)};
      pg8::gemm_phase<EpiIn0>(lds, g, S, E); }
    PHASE_END

#define S5_PASS(READOUT) { \
        const bf16* IN0 = (const bf16*)(BIG + B_IN0); \
        LAS float* BU = (LAS float*)(lds + wave * 12800); LAS unsigned char* HB = lds + wave * 12800 + 8448; \
        const int r = lane & 15, q = lane >> 4; \
        const int NU = (READOUT) ? NB * 64 * NCH : NB * 64 * 2 * NCH; \
        for (int unit = gw; unit < NU; unit += NGW) { \
            const int c = unit % NCH; int rest = unit / NCH; const int g = rest & 63; rest >>= 6; \
            int dsel = 0, b; if (READOUT) b = rest; else { dsel = rest & 1; b = rest >> 1; } \
            const int R0 = b * SROW + c * 64; \
            bf16x8 Uf[4]; \
            _Pragma("unroll") for (int tt = 0; tt < 4; ++tt) { Uf[tt] = (bf16x8){0, 0, 0, 0, 0, 0, 0, 0}; if (q < 2) Uf[tt] = *(const bf16x8*)(IN0 + (size_t)(R0 + 16 * tt + r) * IN0_LD + g * 16 + 8 * q); } \
            f32x4 Y[4]; \
            _Pragma("unroll") for (int tt = 0; tt < 4; ++tt) Y[tt] = (f32x4){0.f, 0.f, 0.f, 0.f}; \
            for (int dd = 0; dd < ((READOUT) ? 2 : 1); ++dd) { \
                const int dir = (READOUT) ? dd : dsel; \
                bf16x8 Bf[8], Cf[4]; \
                _Pragma("unroll") for (int pt = 0; pt < 8; ++pt) { Bf[pt] = (bf16x8){0, 0, 0, 0, 0, 0, 0, 0}; if (q < 2) Bf[pt] = *(const bf16x8*)(T_BBF + ((size_t)(dir * 64 + g) * 128 + 16 * pt + r) * 16 + 8 * q); } \
                if (READOUT) { _Pragma("unroll") for (int ks = 0; ks < 4; ++ks) Cf[ks] = *(const bf16x8*)(T_CF + ((size_t)(dir * 64 + g) * 16 + r) * 128 + 32 * ks + 8 * q); } \
                const int ip = (dir * 64 + g) * 64 + lane; \
                const float ar = T_ABAR[ip * 2], ai = T_ABAR[ip * 2 + 1]; \
                float hr = 0.f, hi = 0.f; \
                if (READOUT) { const float* st = (const float*)(BIG + B_S5S) + ((((size_t)(b * 64 + g) * 2 + dir) * NCH + c) * 64 + lane) * 2; hr = st[0]; hi = st[1]; } \
                for (int ti = 0; ti < 4; ++ti) { const int tt = dir ? 3 - ti : ti; \
                    _Pragma("unroll") for (int pt = 0; pt < 8; ++pt) { const f32x4 cc = MFMA16(Uf[tt], Bf[pt], ((f32x4){0.f, 0.f, 0.f, 0.f})); \
                        _Pragma("unroll") for (int jj = 0; jj < 4; ++jj) BU[(4 * q + jj) * 132 + 16 * pt + r] = cc[jj]; } \
                    LDS_WAIT(); \
                    _Pragma("unroll") for (int i = 0; i < 16; ++i) { const int tl = dir ? 15 - i : i; \
                        const float bur = BU[tl * 132 + lane], bui = BU[tl * 132 + 64 + lane]; \
                        const float nr = ar * hr - ai * hi + bur, ni = ar * hi + ai * hr + bui; hr = nr; hi = ni; \
                        if (READOUT) { *(LAS bf16*)(HB + tl * 272 + lane * 2) = (bf16)f2bf(hr); *(LAS bf16*)(HB + tl * 272 + 128 + lane * 2) = (bf16)f2bf(hi); } } \
                    if (READOUT) { LDS_WAIT(); \
                        _Pragma("unroll") for (int ks = 0; ks < 4; ++ks) Y[tt] = MFMA16(frag_rows(HB, 272, 0, 32 * ks, r, q), Cf[ks], Y[tt]); } \
                    LDS_WAIT(); \
                } \
                if (!(READOUT)) { float* e = (float*)(BIG + B_S5E) + ((((size_t)(b * 64 + g) * 2 + dir) * NCH + c) * 64 + lane) * 2; e[0] = hr; e[1] = hi; } \
            } \
            if (READOUT) { const float dsk = args.in[I_S5D][g * 16 + r]; \
                _Pragma("unroll") for (int tt = 0; tt < 4; ++tt) \
                    _Pragma("unroll") for (int jj = 0; jj < 4; ++jj) { const size_t R = (size_t)(R0 + 16 * tt + 4 * q + jj); const float uu = bf2f(IN0[R * IN0_LD + g * 16 + r]); \
                        ((bf16*)(BIG + B_S5Y))[R * 1024 + g * 16 + r] = (bf16)f2bf(gelu_tanh(Y[tt][jj] + dsk * uu)); } } \
        } }

#define S5_ENDSTATE() { \
        const bf16* IN0 = (const bf16*)(BIG + B_IN0); \
        LAS float* ubuf = (LAS float*)(lds + wave * 4096); \
        for (int unit = gw; unit < NB * 64 * 2 * NCH; unit += NGW) { \
            const int c = unit % NCH; int rest = unit / NCH; const int g = rest & 63; rest >>= 6; const int dir = rest & 1, b = rest >> 1; \
            const int R0 = b * SROW + c * 64; \
            { const u32x4* up = (const u32x4*)(IN0 + (size_t)(R0 + lane) * IN0_LD + g * 16); const u32x4 w0 = up[0], w1 = up[1]; \
              *(LAS f32x4*)(ubuf + lane * 16) = (f32x4){lo16(w0.x), hi16(w0.x), lo16(w0.y), hi16(w0.y)}; *(LAS f32x4*)(ubuf + lane * 16 + 4) = (f32x4){lo16(w0.z), hi16(w0.z), lo16(w0.w), hi16(w0.w)}; \
              *(LAS f32x4*)(ubuf + lane * 16 + 8) = (f32x4){lo16(w1.x), hi16(w1.x), lo16(w1.y), hi16(w1.y)}; *(LAS f32x4*)(ubuf + lane * 16 + 12) = (f32x4){lo16(w1.z), hi16(w1.z), lo16(w1.w), hi16(w1.w)}; } \
            const int ip = (dir * 64 + g) * 64 + lane; \
            f32x2 cB[16]; \
            _Pragma("unroll") for (int q = 0; q < 4; ++q) { const f32x4 x = *(const f32x4*)(T_BBR + (size_t)ip * 16 + 4 * q), y = *(const f32x4*)(T_BBI + (size_t)ip * 16 + 4 * q); \
                _Pragma("unroll") for (int j = 0; j < 4; ++j) cB[4 * q + j] = (f32x2){x[j], y[j]}; } \
            const float ar = T_ABAR[ip * 2], ai = T_ABAR[ip * 2 + 1]; \
            float hr = 0.f, hi = 0.f; \
            LDS_WAIT(); \
            _Pragma("unroll 4") for (int ti = 0; ti < 64; ++ti) { const int t = dir ? 63 - ti : ti; \
                f32x2 bu0 = (f32x2){0.f, 0.f}, bu1 = (f32x2){0.f, 0.f}; \
                _Pragma("unroll") for (int q = 0; q < 4; ++q) { const f32x4 uu = *(const LAS f32x4*)(ubuf + t * 16 + 4 * q); \
                    bu0 = __builtin_elementwise_fma(cB[4 * q], (f32x2){uu[0], uu[0]}, bu0); bu1 = __builtin_elementwise_fma(cB[4 * q + 1], (f32x2){uu[1], uu[1]}, bu1); \
                    bu0 = __builtin_elementwise_fma(cB[4 * q + 2], (f32x2){uu[2], uu[2]}, bu0); bu1 = __builtin_elementwise_fma(cB[4 * q + 3], (f32x2){uu[3], uu[3]}, bu1); } \
                const f32x2 bu = bu0 + bu1; \
                const float nr = ar * hr - ai * hi + bu[0], ni = ar * hi + ai * hr + bu[1]; hr = nr; hi = ni; } \
            { float* e = (float*)(BIG + B_S5E) + ((((size_t)(b * 64 + g) * 2 + dir) * NCH + c) * 64 + lane) * 2; e[0] = hr; e[1] = hi; } \
            LDS_WAIT(); \
        } }

    PHASE_BEGIN
    for (int stg_ = 0; stg_ < 2; ++stg_) {
    if ((stg_ == 0) == (wave < 4)) {
    S5_ENDSTATE()
    } else {
        const bf16* IN0 = (const bf16*)(BIG + B_IN0); const float* AB = (const float*)(BIG + B_AB);
        bf16* DQ = (bf16*)(BIG + B_DNQ); bf16* DK = (bf16*)(BIG + B_DNK); bf16* DV = (bf16*)(BIG + B_DNV);
        float* DG = (float*)(BIG + B_DNG); float* DBt = (float*)(BIG + B_DNB);
        const float* cw = args.in[I_DNCW];
        int cur_combo = -1; f32x4 wv[8];
        for (int item = gw; item < MROWS * 6; item += NGW) {
            const int combo = item / MROWS, R = item - combo * MROWS, part = combo >> 1, hq = combo & 1;
            const int b = R / SROW, sx = R - b * SROW;
            const int seg_lo = sx < CTX ? 0 : CTX, seg_hi = sx < CTX ? CTX : SROW;
            const int cidx = part * 1024 + hq * 512 + lane * 8;
            if (combo != cur_combo) { cur_combo = combo;
#pragma unroll
                for (int e = 0; e < 8; ++e) wv[e] = *(const f32x4*)(cw + (size_t)(cidx + e) * 4); }
            float acc[8];
#pragma unroll
            for (int e = 0; e < 8; ++e) acc[e] = 0.f;
#pragma unroll
            for (int j = 0; j < 4; ++j) { const int sj = sx + j - 2;
                if (sj >= seg_lo && sj < seg_hi) { const u32x4 w = *(const u32x4*)(IN0 + (size_t)(b * SROW + sj) * IN0_LD + 1024 + cidx);
                    acc[0] += wv[0][j] * lo16(w.x); acc[1] += wv[1][j] * hi16(w.x); acc[2] += wv[2][j] * lo16(w.y); acc[3] += wv[3][j] * hi16(w.y);
                    acc[4] += wv[4][j] * lo16(w.z); acc[5] += wv[5][j] * hi16(w.z); acc[6] += wv[6][j] * lo16(w.w); acc[7] += wv[7][j] * hi16(w.w); } }
            float ss = 0.f;
#pragma unroll
            for (int e = 0; e < 8; ++e) { acc[e] = acc[e] * __builtin_amdgcn_rcpf(1.f + __expf(-acc[e])); ss += acc[e] * acc[e]; }
            ss += __shfl_xor(ss, 1); ss += __shfl_xor(ss, 2); ss += __shfl_xor(ss, 4); ss += __shfl_xor(ss, 8);
            const float sc = part == 0 ? 0.08838834764831845f * __builtin_amdgcn_rsqf(ss + EPS) : (part == 1 ? __builtin_amdgcn_rsqf(ss + EPS) : 1.f);
            u32x4 o; o.x = pk2(acc[0] * sc, acc[1] * sc); o.y = pk2(acc[2] * sc, acc[3] * sc); o.z = pk2(acc[4] * sc, acc[5] * sc); o.w = pk2(acc[6] * sc, acc[7] * sc);
            bf16* dst = part == 0 ? DQ : (part == 1 ? DK : DV);
            *(u32x4*)(dst + (size_t)R * 1024 + hq * 512 + lane * 8) = o;
        }
        for (int i = bid * 512 + tid; i < MROWS * 16; i += G * 512) { const int R = i >> 4, l16 = i & 15;
            const float araw = AB[(size_t)R * 32 + l16], braw = AB[(size_t)R * 32 + 16 + l16];
            DG[i] = -expf(args.in[I_DNALOG][l16]) * softplusf_(araw + args.in[I_DNDT][l16]);
            DBt[i] = sigmoidf_(braw); }
    }
    }
    PHASE_END

    PHASE_BEGIN
    {
        for (int i = bid * 512 + tid; i < NB * 64 * 2 * 64; i += G * 512) {
            const int p = i & 63, dir = (i >> 6) & 1, bg = i >> 7, g = bg & 63;
            const int ip = (dir * 64 + g) * 64 + p; const float pr = T_APOW[ip * 2], pi = T_APOW[ip * 2 + 1];
            const float* E = (const float*)(BIG + B_S5E) + ((size_t)(bg * 2 + dir) * NCH) * 128 + p * 2;
            float* St = (float*)(BIG + B_S5S) + ((size_t)(bg * 2 + dir) * NCH) * 128 + p * 2;
            float sr = 0.f, si = 0.f;
            for (int k = 0; k < NCH; ++k) { const int c = dir == 0 ? k : (k < 4 ? 3 - k : 71 - k);
                St[c * 128] = sr; St[c * 128 + 1] = si; const float er = E[c * 128], ei = E[c * 128 + 1];
                const float nr = pr * sr - pi * si + er, ni = pr * si + pi * sr + ei; sr = nr; si = ni; }
        }
        {
            const bf16* DK = (const bf16*)(BIG + B_DNK); const float* DG = (const float*)(BIG + B_DNG); const float* DBt = (const float*)(BIG + B_DNB);
            bf16* TINV = (bf16*)((unsigned char*)MIX + MIX_TINV); bf16* WT = Hb; float* GCUM = (float*)(BIG + B_GCUM);
            constexpr int KC = 0, KB = 17408, KG = 34816, PA = 52224, PB = 61440, TA = 70656, TB = 79872, LO = 36864, WSo = 0  , GCo = 125952, BTo = 126208, RS = 272, PS = 144;
            const int r = lane & 15, q = lane >> 4, qq = r >> 2, pp = r & 3, it = wave >> 1, nh = wave & 1;
            LAS float* GC = (LAS float*)(lds + GCo); LAS float* BT = (LAS float*)(lds + BTo);
#define DN_ROW(n, row) ((size_t)b * SROW + (dir == 0 ? ((n) * 64 + (row)) : (((n) * 64 + (row)) < CTX ? CTX - 1 - ((n) * 64 + (row)) : SROW + CTX - 1 - ((n) * 64 + (row)))))
            for (int i = tid; i < 36864 / 4; i += 512) { ((LAS unsigned*)(lds + PA))[i] = 0u; ((LAS unsigned*)(lds + PA + LO))[i] = 0u; }
            __syncthreads();
            for (int unit = bid; unit < NB * 8 * 2 * NCH; unit += G) {
                const int n = unit % NCH; int rest = unit / NCH; const int dir = rest & 1; rest >>= 1; const int h = rest & 7, b = rest >> 3;
                u32x4 kreg[2];
#pragma unroll
                for (int k = 0; k < 2; ++k) { const int id = tid + 512 * k, row = id >> 4, cp = id & 15; kreg[k] = *(const u32x4*)(DK + DN_ROW(n, row) * 1024 + h * 128 + cp * 8); }
                if (wave == 0) { const size_t R = DN_ROW(n, lane); float g = DG[R * 16 + dir * 8 + h]; const float bt = DBt[R * 16 + dir * 8 + h];
#pragma unroll
                    for (int o = 1; o < 64; o <<= 1) { const float t = __shfl_up(g, o); if (lane >= o) g += t; }
                    GC[lane] = g; BT[lane] = bt; GCUM[(size_t)unit * 64 + lane] = g; }
                __syncthreads();
#pragma unroll
                for (int k = 0; k < 2; ++k) { const int id = tid + 512 * k, row = id >> 4, cp = id & 15; const float bt = BT[row], bg = bt * __expf(GC[row]);
                    const u32x4 w = kreg[k];
                    *(LAS u32x4*)(lds + KC + row * RS + cp * 16) = w;
                    u32x4 x; x.x = pk2(lo16(w.x) * bt, hi16(w.x) * bt); x.y = pk2(lo16(w.y) * bt, hi16(w.y) * bt); x.z = pk2(lo16(w.z) * bt, hi16(w.z) * bt); x.w = pk2(lo16(w.w) * bt, hi16(w.w) * bt);
                    *(LAS u32x4*)(lds + KB + row * RS + cp * 16) = x;
                    x.x = pk2(lo16(w.x) * bg, hi16(w.x) * bg); x.y = pk2(lo16(w.y) * bg, hi16(w.y) * bg); x.z = pk2(lo16(w.z) * bg, hi16(w.z) * bg); x.w = pk2(lo16(w.w) * bg, hi16(w.w) * bg);
                    *(LAS u32x4*)(lds + KG + row * RS + cp * 16) = x; }
                __syncthreads();
#pragma unroll
                for (int e = 0; e < 2; ++e) { const int jt = 2 * nh + e; f32x4 c = (f32x4){0.f, 0.f, 0.f, 0.f};
                    if (jt <= it) {
#pragma unroll
                        for (int ks = 0; ks < 4; ++ks) c = MFMA16(frag_rows(lds + KC, RS, 16 * jt, 32 * ks, r, q), frag_rows(lds + KB, RS, 16 * it, 32 * ks, r, q), c);
                        const float gi = GC[16 * it + r]; const f32x4 gj = *(const LAS f32x4*)(GC + 16 * jt + 4 * q);
#pragma unroll
                        for (int jj = 0; jj < 4; ++jj) c[jj] = (16 * jt + 4 * q + jj < 16 * it + r) ? -c[jj] * __expf(gi - gj[jj]) : 0.f; }
                    st_hl(lds + PA + (16 * it + r) * PS + (16 * jt + 4 * q) * 2, LO, c);
                    if (jt == it) {
#pragma unroll
                        for (int jj = 0; jj < 4; ++jj) if (4 * q + jj == r) c[jj] = 1.f; }
                    st_hl(lds + TA + (16 * it + r) * PS + (16 * jt + 4 * q) * 2, LO, c); }
                __syncthreads();
#pragma unroll
                for (int st = 1; st <= 6; ++st) {
                    LAS unsigned char* Pc = lds + ((st & 1) ? PA : PB); LAS unsigned char* Pn = lds + ((st & 1) ? PB : PA);
                    LAS unsigned char* Tc = lds + ((st & 1) ? TB : TA); LAS unsigned char* Tn = lds + ((st & 1) ? TA : TB);
                    if (st == 1) { Tc = lds + TA; }
                    f32x4 cP[2], cT[2];
#pragma unroll
                    for (int e = 0; e < 2; ++e) { const int nt = 2 * nh + e; cP[e] = (f32x4){0.f, 0.f, 0.f, 0.f}; cT[e] = (f32x4){0.f, 0.f, 0.f, 0.f};
                        if (st >= 2) { const u32x2 t0 = *(const LAS u32x2*)(Tc + (16 * it + r) * PS + (16 * nt + 4 * q) * 2), t1 = *(const LAS u32x2*)(Tc + LO + (16 * it + r) * PS + (16 * nt + 4 * q) * 2);
                            cT[e] = (f32x4){lo16(t0.x) + lo16(t1.x), hi16(t0.x) + hi16(t1.x), lo16(t0.y) + lo16(t1.y), hi16(t0.y) + hi16(t1.y)}; } }
                    {
#pragma unroll
                        for (int kb = 0; kb < 2; ++kb) {
                            bf16x8 rPh, rPl, rTh, rTl;
                            if (st <= 5) { rPh = frag_rows(Pc, PS, 16 * it, 32 * kb, r, q); rPl = frag_rows(Pc + LO, PS, 16 * it, 32 * kb, r, q); }
                            if (st >= 2) { rTh = frag_rows(Tc, PS, 16 * it, 32 * kb, r, q); rTl = frag_rows(Tc + LO, PS, 16 * it, 32 * kb, r, q); }
#pragma unroll
                            for (int e = 0; e < 2; ++e) { const int nt = 2 * nh + e;
                                { const bf16x8 th = frag_tr(Pc, PS, 32 * kb, 16 * nt, q, qq, pp), tl = frag_tr(Pc + LO, PS, 32 * kb, 16 * nt, q, qq, pp);
                                    if (st <= 5) cP[e] = mm3(cP[e], th, tl, rPh, rPl);
                                    if (st >= 2) cT[e] = mm3(cT[e], th, tl, rTh, rTl); } }
                        }
#pragma unroll
                        for (int e = 0; e < 2; ++e) { const int nt = 2 * nh + e;
                            { if (st <= 5) st_hl(Pn + (16 * it + r) * PS + (16 * nt + 4 * q) * 2, LO, cP[e]);
                                if (st >= 2) st_hl(Tn + (16 * it + r) * PS + (16 * nt + 4 * q) * 2, LO, cT[e]); } }
                    }
                    __syncthreads();
                }
#pragma unroll
                for (int e = 0; e < 4; ++e) { const int nt = 4 * nh + e; f32x4 c = (f32x4){0.f, 0.f, 0.f, 0.f};
#pragma unroll
                    for (int kb = 0; kb < 2; ++kb) c = MFMA16(frag_tr(lds + KG, RS, 32 * kb, 16 * nt, q, qq, pp), frag_rows(lds + TB, PS, 16 * it, 32 * kb, r, q), c);
                    u32x2 w; w.x = pk2(-c[0], -c[1]); w.y = pk2(-c[2], -c[3]); *(LAS u32x2*)(lds + WSo + (16 * it + r) * RS + (16 * nt + 4 * q) * 2) = w; }
                __syncthreads();
#pragma unroll
                for (int k = 0; k < 2; ++k) { const int id = tid + 512 * k, row = id >> 4, cp = id & 15; *(u32x4*)(WT + ((size_t)unit * 64 + row) * 128 + cp * 8) = *(const LAS u32x4*)(lds + WSo + row * RS + cp * 16); }
                { const int row = tid >> 3, cp = tid & 7; *(u32x4*)(TINV + ((size_t)unit * 64 + row) * 64 + cp * 8) = *(const LAS u32x4*)(lds + TB + row * PS + cp * 16); }
            }
        }
    }
    PHASE_END

    PHASE_BEGIN
    {
        const bf16* DQ = (const bf16*)(BIG + B_DNQ); const bf16* DK = (const bf16*)(BIG + B_DNK); const bf16* DV = (const bf16*)(BIG + B_DNV);
        const float* DBt = (const float*)(BIG + B_DNB); const bf16* TINV = (const bf16*)((unsigned char*)MIX + MIX_TINV); const bf16* WT = Hb; const float* GCUM = (const float*)(BIG + B_GCUM);
        constexpr int QC0 = 0, KC0 = 17408, QC1 = 34816, KC1 = 52224, WC = 69632, TI = 87040, VB = 96256, VN = 101376, VD = 105984, ST0 = 110592, ST1 = 119296, GS0 = 128000, GS1 = 128768, RS = 272, PS = 144, VBS = 80;
        const int r = lane & 15, q = lane >> 4, qq = r >> 2, pp = r & 3, it = wave >> 1, ct = wave & 1;
        for (int unit0 = bid; unit0 < NB * 8 * 2 * 4; unit0 += G) {
            const int unit = (unit0 & 7) * 32 + (unit0 >> 3);
            const int sl = unit & 3, dir = (unit >> 2) & 1, h = (unit >> 3) & 7, b = unit >> 6;
            const size_t ubase = (size_t)((b * 8 + h) * 2 + dir) * NCH;
            bf16* DO = (bf16*)(BIG + (dir ? B_DNO1 : B_DNO0));
            f32x4 Sacc[2] = {(f32x4){0.f, 0.f, 0.f, 0.f}, (f32x4){0.f, 0.f, 0.f, 0.f}};
            u32x4 rq[2], rk[2], rw[2], rt, rv; float rbeta = 0.f, rgc = 0.f;
#define DNB_LOAD(n) do { _Pragma("unroll") for (int k = 0; k < 2; ++k) { const int id = tid + 512 * k, row = id >> 4, cp = id & 15; const size_t R = DN_ROW(n, row); \
                    rq[k] = *(const u32x4*)(DQ + R * 1024 + h * 128 + cp * 8); rk[k] = *(const u32x4*)(DK + R * 1024 + h * 128 + cp * 8); \
                    rw[k] = *(const u32x4*)(WT + ((ubase + (n)) * 64 + row) * 128 + cp * 8); } \
                { const int row = tid >> 3, cp = tid & 7; rt = *(const u32x4*)(TINV + ((ubase + (n)) * 64 + row) * 64 + cp * 8); } \
                if (tid < 256) { const int row = tid >> 2, cp = tid & 3; const size_t R = DN_ROW(n, row); rv = *(const u32x4*)(DV + R * 1024 + h * 128 + sl * 32 + cp * 8); rbeta = DBt[R * 16 + dir * 8 + h]; } \
                if (tid < 64) rgc = GCUM[(ubase + (n)) * 64 + tid]; } while (0)
#define DNB_STAGE(QCo, KCo, GSo) do { _Pragma("unroll") for (int k = 0; k < 2; ++k) { const int id = tid + 512 * k, row = id >> 4, cp = id & 15; \
                    *(LAS u32x4*)(lds + (QCo) + row * RS + cp * 16) = rq[k]; *(LAS u32x4*)(lds + (KCo) + row * RS + cp * 16) = rk[k]; *(LAS u32x4*)(lds + WC + row * RS + cp * 16) = rw[k]; } \
                { const int row = tid >> 3, cp = tid & 7; *(LAS u32x4*)(lds + TI + row * PS + cp * 16) = rt; } \
                if (tid < 256) { const int row = tid >> 2, cp = tid & 3; u32x4 x; x.x = pk2(lo16(rv.x) * rbeta, hi16(rv.x) * rbeta); x.y = pk2(lo16(rv.y) * rbeta, hi16(rv.y) * rbeta); \
                    x.z = pk2(lo16(rv.z) * rbeta, hi16(rv.z) * rbeta); x.w = pk2(lo16(rv.w) * rbeta, hi16(rv.w) * rbeta); *(LAS u32x4*)(lds + VB + row * VBS + cp * 16) = x; } \
                if (tid < 64) { const float gl = __shfl(rgc, 63); LAS float* gs = (LAS float*)(lds + (GSo)); gs[tid] = rgc; gs[64 + tid] = __expf(rgc); gs[128 + tid] = __expf(gl - rgc); } } while (0)
            for (int i = tid; i < 8704 / 4; i += 512) ((LAS unsigned*)(lds + ST0))[i] = 0u;
            DNB_LOAD(0);
            DNB_STAGE(QC0, KC0, GS0);
            if (NCH > 1) DNB_LOAD(1);
            __syncthreads();
            float bgv[8]; int bg_cur = -1; int bg_it = gw;
            for (int n = 0; n < NCH; ++n) {
                BGW_STORE(0); BGW_ISSUE(bg_it, 0); bg_it += NGW;
                LAS unsigned char* QC = lds + ((n & 1) ? QC1 : QC0); LAS unsigned char* KC = lds + ((n & 1) ? KC1 : KC0);
                LAS float* GS = (LAS float*)(lds + ((n & 1) ? GS1 : GS0));
                LAS unsigned char* STc = lds + ((n & 1) ? ST1 : ST0); LAS unsigned char* STn = lds + ((n & 1) ? ST0 : ST1);
                { f32x4 c = (f32x4){0.f, 0.f, 0.f, 0.f};
#pragma unroll
                  for (int kb = 0; kb < 2; ++kb) c = MFMA16(frag_rows(lds + TI, PS, 16 * it, 32 * kb, r, q), frag_tr(lds + VB, VBS, 32 * kb, 16 * ct, q, qq, pp), c);
#pragma unroll
                  for (int ks = 0; ks < 4; ++ks) c = MFMA16(frag_rows(lds + WC, RS, 16 * it, 32 * ks, r, q), frag_rows(STc, RS, 16 * ct, 32 * ks, r, q), c);
                  const f32x4 ed = *(const LAS f32x4*)(GS + 128 + 16 * it + 4 * q);
                  u32x2 w; w.x = pk2(c[0], c[1]); w.y = pk2(c[2], c[3]); *(LAS u32x2*)(lds + VN + (16 * ct + r) * PS + (16 * it + 4 * q) * 2) = w;
                  w.x = pk2(c[0] * ed[0], c[1] * ed[1]); w.y = pk2(c[2] * ed[2], c[3] * ed[3]); *(LAS u32x2*)(lds + VD + (16 * ct + r) * PS + (16 * it + 4 * q) * 2) = w; }
                __syncthreads();
                if (n + 1 < NCH) { if (n & 1) DNB_STAGE(QC0, KC0, GS0); else DNB_STAGE(QC1, KC1, GS1); }
                if (n + 2 < NCH) DNB_LOAD(n + 2);
                { const float egl = GS[64 + 63];
#pragma unroll
                  for (int e = 0; e < 2; ++e) { f32x4 c = Sacc[e] * egl;
#pragma unroll
                      for (int kb = 0; kb < 2; ++kb) c = MFMA16(frag_tr(KC, RS, 32 * kb, 16 * wave, q, qq, pp), frag_rows(lds + VD, PS, 16 * e, 32 * kb, r, q), c);
                      Sacc[e] = c;
                      u32x2 w; w.x = pk2(c[0], c[1]); w.y = pk2(c[2], c[3]); *(LAS u32x2*)(STn + (16 * e + r) * RS + (16 * wave + 4 * q) * 2) = w; } }
                { f32x4 o = (f32x4){0.f, 0.f, 0.f, 0.f};
                  bf16x8 Qf[4];
#pragma unroll
                  for (int ks = 0; ks < 4; ++ks) Qf[ks] = frag_rows(QC, RS, 16 * it, 32 * ks, r, q);
#pragma unroll
                  for (int ks = 0; ks < 4; ++ks) o = MFMA16(Qf[ks], frag_rows(STc, RS, 16 * ct, 32 * ks, r, q), o);
                  { const f32x4 eg = *(const LAS f32x4*)(GS + 64 + 16 * it + 4 * q); o = o * eg; }
                  const float gi = GS[16 * it + r];
#pragma unroll
                  for (int kp = 0; kp < 2; ++kp) {
                      if (2 * kp <= it) { f32x4 pt[2];
#pragma unroll
                          for (int e = 0; e < 2; ++e) { const int jt = 2 * kp + e; f32x4 c = (f32x4){0.f, 0.f, 0.f, 0.f};
                              if (jt <= it) {
#pragma unroll
                                  for (int ks = 0; ks < 4; ++ks) c = MFMA16(frag_rows(KC, RS, 16 * jt, 32 * ks, r, q), Qf[ks], c);
                                  const f32x4 gj = *(const LAS f32x4*)(GS + 16 * jt + 4 * q);
#pragma unroll
                                  for (int jj = 0; jj < 4; ++jj) c[jj] = (16 * jt + 4 * q + jj <= 16 * it + r) ? c[jj] * __expf(gi - gj[jj]) : 0.f; }
                              pt[e] = c; }
                          o = MFMA16(pack_pair(pt[0], pt[1]), frag_rows_perm(lds + VN, PS, 16 * ct, 32 * kp, r, q), o); }
                  }
#pragma unroll
                  for (int jj = 0; jj < 4; ++jj) { const size_t R = DN_ROW(n, 16 * it + 4 * q + jj); DO[R * 1024 + h * 128 + sl * 32 + 16 * ct + r] = (bf16)f2bf(o[jj]); } }
                __syncthreads();
            }
            BGW_STORE(0);
            for (; bg_it < BGW_ITEMS; bg_it += NGW) { BGW_ISSUE(bg_it, 0); BGW_STORE(0); }
        }
#undef DNB_LOAD
#undef DNB_STAGE
    }
    S5_PASS(true)
    PHASE_END

    PHASE_BEGIN
    {
        const bf16* O0 = (const bf16*)(BIG + B_DNO0); const bf16* O1 = (const bf16*)(BIG + B_DNO1); const bf16* IN0 = (const bf16*)(BIG + B_IN0);
        for (int item = gw; item < MROWS * 8; item += NGW) {
            const int R = item >> 3, h = item & 7; const size_t o = (size_t)R * 1024 + h * 128 + 2 * lane;
            const unsigned a = *(const unsigned*)(O0 + o), c = *(const unsigned*)(O1 + o);
            const float v0 = lo16(a) + lo16(c), v1 = hi16(a) + hi16(c);
            const float ms = wave_sum(v0 * v0 + v1 * v1) * (1.f / 128.f); const float rs = __builtin_amdgcn_rsqf(ms + EPS);
            const unsigned gt = *(const unsigned*)(IN0 + (size_t)R * IN0_LD + 4096 + h * 128 + 2 * lane);
            const float g0 = args.in[I_DNNG][2 * lane], g1 = args.in[I_DNNG][2 * lane + 1];
            *(unsigned*)(MIX + (size_t)R * 2048 + 1024 + h * 128 + 2 * lane) = pk2(v0 * rs * g0 * siluf_(lo16(gt)), v1 * rs * g1 * siluf_(hi16(gt)));
        }
    }
    { pg8::Gemm g{(const bf16*)(BIG + B_S5Y), (const bf16*)(WB + W_GLU), 1024, 1024, 1024}; pg8::StaticOrder S; S.init(68, 4, G, bid, 0);
      EpiGlu E{(const bf16*)(BIG + B_S5Y), MIX, args.in[I_GLUB]};
      pg8::gemm_phase<EpiGlu>(lds, g, S, E); }
    PHASE_END

    PHASE_BEGIN
    { pg8::Gemm g{MIX, (const bf16*)(WB + W_OUT), 2048, 2048, 2048}; pg8::TailOrder<32> S; S.init(G, bid);
      EpiRes<true> E{args.in[I_X], XLb, MOD + 2 * 2048, SLAB};
      pg8::gemm_phase<EpiRes<true>, pg8::TailOrder<32>>(lds, g, S, E); }
    PHASE_END

    PHASE_BEGIN
    ADALN(0, 1, true, XLb, args.in[I_CTX], false, SLAB, MOD + 4 * 12288 + 2 * 2048)
    PHASE_END

    PHASE_BEGIN
    { pg8::Gemm g{Hb, (const bf16*)(WB + W_UP), DM, DM, DM}; pg8::StaticOrder S; S.init(68, 44, G, bid, 0);
      EpiSwiglu E{(bf16*)(BIG + B_G)};
      pg8::gemm_phase<EpiSwiglu>(lds, g, S, E); }
    PHASE_END

    PHASE_BEGIN
    { pg8::Gemm g{(const bf16*)(BIG + B_G), (const bf16*)(WB + W_DN), DFF, DFF, DFF}; pg8::TailOrder<88> S; S.init(G, bid);
      EpiRes<false> E{XLb, XLb, MOD + 5 * 2048, SLAB};
      pg8::gemm_phase<EpiRes<false>, pg8::TailOrder<88>>(lds, g, S, E); }
    PHASE_END

    PHASE_BEGIN
    ADALN(1, 0, true, XLb, XC, false, SLAB, MOD + 4 * 12288 + 5 * 2048)
    {
        LAS float* scr = (LAS float*)(lds + wave * 16384);
        constexpr int J0 = 32 * 256, J1 = 48 * 64, J3 = 32 * 176, J4 = J3, J5 = 88 * 64;
        (void)J3; (void)J4; (void)J5;
        for (int it = gw; it < J0 + J1; it += NGW) {
            int r = it;
            if (r < J0) { transpose_job(r, args.in[I_OWIN], 2048, 8192, (bf16*)(WB + W_IN), 0, 0, scr, lane); continue; } r -= J0;
            transpose_job(r, args.in[I_OWOUT], 3072, 2048, (bf16*)(WB + W_OUT), 0, 0, scr, lane);
        }
        bf16* WG = (bf16*)(WB + W_GLU);
        for (int i = bid * 512 + tid; i < 4096 * 256 / 2; i += G * 512) {
            const int kk = (i & 127) * 2, np = i >> 7; const int e = np & 127, half = (np >> 7) & 1, q = np >> 8, blk = q & 7, dir = q >> 3;
            unsigned w = 0u;
            if ((kk >> 7) == (blk & 1)) { const float* src = args.in[half ? I_LWX : I_LWA] + ((size_t)(dir * 8 + blk) * 128 + (kk & 127)) * 128 + e; w = pk2(src[0], src[128]); }
            *(unsigned*)(WG + (size_t)np * 256 + kk) = w;
        }
    }
    PHASE_END

    PHASE_BEGIN
    { pg8::Gemm g{Hb, (const bf16*)(WB + W_IN), DM, DM, DM}; pg8::StaticOrder S; S.init(68, 8, G, bid, 0);
      EpiPlain E{(bf16*)(BIG + B_INA), 2048};
      pg8::gemm_phase<EpiPlain>(lds, g, S, E); }
    PHASE_END

    PHASE_BEGIN
    {
        const bf16* INA = (const bf16*)(BIG + B_INA); bf16* XCV = (bf16*)(BIG + B_XCV);
        for (size_t i = (size_t)bid * 512 + tid; i < (size_t)MROWS * 512; i += (size_t)G * 512) {
            const int R = (int)(i >> 9), ch = (int)(i & 511) * 2, b = R / SROW, s = R % SROW;
            const int seg_lo = s < CTX ? 0 : CTX, seg_hi = s < CTX ? CTX : SROW;
            const f32x4 w0 = *(const f32x4*)(args.in[I_LCW] + ch * 4), w1 = *(const f32x4*)(args.in[I_LCW] + ch * 4 + 4);
            float a0 = args.in[I_LCB][ch], a1 = args.in[I_LCB][ch + 1];
#pragma unroll
            for (int j = 0; j < 4; ++j) { const int sx = s + j - 2;
                if (sx >= seg_lo && sx < seg_hi) { const unsigned pr = *(const unsigned*)(INA + (size_t)(b * SROW + sx) * 2048 + ch); a0 += w0[j] * lo16(pr); a1 += w1[j] * hi16(pr); } }
            *(unsigned*)(XCV + (size_t)R * 1024 + ch) = pk2(a0, a1);
        }
    }
    PHASE_END

    PHASE_BEGIN
    { pg8::Gemm g{(const bf16*)(BIG + B_XCV), (const bf16*)(WB + W_GLU), 1024, 256, 256}; pg8::StaticOrder S; S.init(68, 16, G, bid, 0);
      EpiGate E{(const bf16*)(BIG + B_XCV), (bf16*)(BIG + B_LA), (bf16*)(BIG + B_BB), args.in[I_LBA], args.in[I_LBX], T_SPL};
      pg8::gemm_phase<EpiGate, pg8::StaticOrder, true>(lds, g, S, E); }
    PHASE_END

    PHASE_BEGIN
    {
        const bf16* LA = (const bf16*)(BIG + B_LA); const bf16* BBp = (const bf16*)(BIG + B_BB); float* EP = (float*)(BIG + B_LEP);
        for (int i = bid * 512 + tid; i < NB * 2 * NCH * 1024; i += G * 512) {
            const int ch = i & 1023; int rest = i >> 10; const int c = rest % NCH; rest /= NCH; const int dir = rest & 1, b = rest >> 1;
            float P = 1.f, h = 0.f;
            for (int ti = 0; ti < 64; ++ti) { const int t = dir ? 63 - ti : ti; const size_t o = ((size_t)(b * SROW + c * 64 + t) * 2 + dir) * 1024 + ch;
                const float a = __expf(bf2f(LA[o])), bb = bf2f(BBp[o]); P *= a; h = a * h + bb; }
            EP[(size_t)i * 2] = P; EP[(size_t)i * 2 + 1] = h;
        }
    }
    PHASE_END

    PHASE_BEGIN
    {
        const float* EP = (const float*)(BIG + B_LEP); float* ST = (float*)(BIG + B_LST);
        for (int i = bid * 512 + tid; i < NB * 2 * 1024; i += G * 512) {
            const int ch = i & 1023, dir = (i >> 10) & 1, b = i >> 11; float s = 0.f;
            for (int k = 0; k < NCH; ++k) { const int c = dir == 0 ? k : (k < 4 ? 3 - k : 71 - k); const size_t o = ((size_t)(b * 2 + dir) * NCH + c) * 1024 + ch;
                ST[o] = s; s = EP[o * 2] * s + EP[o * 2 + 1]; }
        }
    }
    PHASE_END

    PHASE_BEGIN
    {
        const bf16* LA = (const bf16*)(BIG + B_LA); const bf16* BBp = (const bf16*)(BIG + B_BB); const float* ST = (const float*)(BIG + B_LST); const bf16* INA = (const bf16*)(BIG + B_INA);
        LAS float* hb = (LAS float*)lds;
        for (int u = bid; u < NB * 64 * 2; u += G) {
            const int half = u & 1, c = 4 + ((u >> 1) & 63), b = u >> 7, ch = half * 512 + tid;
            float h = ST[((size_t)(b * 2 + 0) * NCH + c) * 1024 + ch];
            for (int t = 0; t < 64; ++t) { const size_t o = ((size_t)(b * SROW + c * 64 + t) * 2 + 0) * 1024 + ch; h = __expf(bf2f(LA[o])) * h + bf2f(BBp[o]); hb[t * 512 + tid] = h; }
            h = ST[((size_t)(b * 2 + 1) * NCH + c) * 1024 + ch];
            for (int t = 63; t >= 0; --t) { const size_t R = (size_t)(b * SROW + c * 64 + t); const size_t o = (R * 2 + 1) * 1024 + ch; h = __expf(bf2f(LA[o])) * h + bf2f(BBp[o]);
                const float y = hb[t * 512 + tid] + h; const float gt = bf2f(INA[R * 2048 + 1024 + ch]);
                MIX[R * 3072 + ch] = (bf16)f2bf(y * gelu_tanh(gt)); }
        }
    }
    PHASE_END

    PHASE_BEGIN
    { pg8::Gemm g{Hb, (const bf16*)(WB + W_IN) + (size_t)2048 * 2048, DM, DM, DM}; pg8::StaticOrder S; S.init(68, 24, G, bid, 0);
      EpiRope E{(bf16*)(BIG + B_INB), T_ROPE};
      pg8::gemm_phase<EpiRope>(lds, g, S, E); }
    PHASE_END

    PHASE_BEGIN
    {
        const bf16* INB = (const bf16*)(BIG + B_INB);
        constexpr int QS = 0, KS = 33792, VS = 67584, TS = 76800, RS = 528, VRS = 144;
        const int r = lane & 15, q = lane >> 4, qq = r >> 2, pp = r & 3;
        const int it = wave >> 1, dvp = wave & 1;
        for (int unit0 = bid; unit0 < NB * 4 * 2 * 8; unit0 += G) {
            const int unit = (unit0 & 7) * 32 + (unit0 >> 3);
            const int sl = unit & 7, dir = (unit >> 3) & 1, h = (unit >> 4) & 3, b = unit >> 6;
            bf16* RO = (bf16*)(BIG + (dir ? B_RO1 : B_RO0));
            const float lgam = -expf(args.in[I_RTH][dir * 4 + h]);
            const float gC = expf(64.f * lgam);
            f32x4 Tacc[2][4];
#pragma unroll
            for (int a = 0; a < 2; ++a)
#pragma unroll
                for (int d = 0; d < 4; ++d) Tacc[a][d] = (f32x4){0.f, 0.f, 0.f, 0.f};
            const int vrow = tid >> 3, vcp = tid & 7;
            const float vsc = expf(-(float)vrow * lgam);
            u32x4 pq[4], pk[4], pv;
#define RT_ROW(n, row) ((size_t)b * SROW + (dir == 0 ? ((n) * 64 + (row)) : (((n) * 64 + (row)) < CTX ? CTX - 1 - ((n) * 64 + (row)) : SROW + CTX - 1 - ((n) * 64 + (row)))))
#define RT_LOAD(n) do { _Pragma("unroll") for (int k = 0; k < 4; ++k) { const int id = tid + 512 * k, row = id >> 5, cp = id & 31; const bf16* src = INB + RT_ROW(n, row) * INB_LD + h * 256 + cp * 8; \
                pq[k] = *(const u32x4*)src; pk[k] = *(const u32x4*)(src + 1024); } \
                pv = *(const u32x4*)(INB + RT_ROW(n, vrow) * INB_LD + 2048 + h * 512 + sl * 64 + vcp * 8); } while (0)
            RT_LOAD(0);
            float bgv[8]; int bg_cur = -1; int bg_it = gw;
            for (int n = 0; n < NCH; ++n) {
                BGW_STORE(1); BGW_ISSUE(bg_it, 1); bg_it += NGW;
#pragma unroll
                for (int k = 0; k < 4; ++k) { const int id = tid + 512 * k, row = id >> 5, cp = id & 31;
                    *(LAS u32x4*)(lds + QS + row * RS + cp * 16) = pq[k]; *(LAS u32x4*)(lds + KS + row * RS + cp * 16) = pk[k]; }
                { u32x4 w; w.x = pk2(lo16(pv.x) * vsc, hi16(pv.x) * vsc); w.y = pk2(lo16(pv.y) * vsc, hi16(pv.y) * vsc); w.z = pk2(lo16(pv.z) * vsc, hi16(pv.z) * vsc); w.w = pk2(lo16(pv.w) * vsc, hi16(pv.w) * vsc);
                  *(LAS u32x4*)(lds + VS + vrow * VRS + vcp * 16) = w; }
                const bool outp = n >= 4;
                if (outp) {
#pragma unroll
                    for (int a = 0; a < 2; ++a)
#pragma unroll
                        for (int d = 0; d < 4; ++d) { u32x2 w; w.x = pk2(Tacc[a][d][0], Tacc[a][d][1]); w.y = pk2(Tacc[a][d][2], Tacc[a][d][3]);
                            *(LAS u32x2*)(lds + TS + (16 * d + r) * RS + (16 * (2 * wave + a) + 4 * q) * 2) = w; }
                }
                __syncthreads();
                if (n + 1 < NCH) RT_LOAD(n + 1);
                if (outp) {
                    bf16x8 Qf[8];
#pragma unroll
                    for (int ks = 0; ks < 8; ++ks) Qf[ks] = *(const LAS bf16x8*)(lds + QS + (16 * it + r) * RS + (32 * ks + 8 * q) * 2);
                    f32x4 oacc[2];
#pragma unroll
                    for (int dd = 0; dd < 2; ++dd) { f32x4 c = (f32x4){0.f, 0.f, 0.f, 0.f};
#pragma unroll
                        for (int ks = 0; ks < 8; ++ks) { const bf16x8 tf = *(const LAS bf16x8*)(lds + TS + (16 * (2 * dvp + dd) + r) * RS + (32 * ks + 8 * q) * 2);
                            c = __builtin_amdgcn_mfma_f32_16x16x32_bf16(Qf[ks], tf, c, 0, 0, 0); }
                        oacc[dd] = c * gC; }
#pragma unroll
                    for (int kp = 0; kp < 2; ++kp) {
                        if (2 * kp <= it) {
                            f32x4 pt[2];
#pragma unroll
                            for (int e = 0; e < 2; ++e) { const int jt = 2 * kp + e; f32x4 c = (f32x4){0.f, 0.f, 0.f, 0.f};
                                if (jt <= it) {
#pragma unroll
                                    for (int ks = 0; ks < 8; ++ks) { const bf16x8 kf = *(const LAS bf16x8*)(lds + KS + (16 * jt + r) * RS + (32 * ks + 8 * q) * 2);
                                        c = __builtin_amdgcn_mfma_f32_16x16x32_bf16(kf, Qf[ks], c, 0, 0, 0); }
                                    if (jt == it) {
#pragma unroll
                                        for (int jj = 0; jj < 4; ++jj) if (4 * q + jj > r) c[jj] = 0.f; }
                                }
                                pt[e] = c; }
                            u32x4 pw; pw.x = pk2(pt[0][0], pt[0][1]); pw.y = pk2(pt[0][2], pt[0][3]); pw.z = pk2(pt[1][0], pt[1][1]); pw.w = pk2(pt[1][2], pt[1][3]);
                            const bf16x8 pf = __builtin_bit_cast(bf16x8, pw);
#pragma unroll
                            for (int dd = 0; dd < 2; ++dd) { const int dvt = 2 * dvp + dd;
                                const s16x4 v0 = __builtin_amdgcn_ds_read_tr16_b64_v4i16((LAS s16x4*)(lds + VS + (32 * kp + 4 * q + qq) * VRS + (16 * dvt + 4 * pp) * 2));
                                const s16x4 v1 = __builtin_amdgcn_ds_read_tr16_b64_v4i16((LAS s16x4*)(lds + VS + (32 * kp + 16 + 4 * q + qq) * VRS + (16 * dvt + 4 * pp) * 2));
                                const bf16x8 vf = {v0[0], v0[1], v0[2], v0[3], v1[0], v1[1], v1[2], v1[3]};
                                oacc[dd] = __builtin_amdgcn_mfma_f32_16x16x32_bf16(pf, vf, oacc[dd], 0, 0, 0); }
                        }
                    }
#pragma unroll
                    for (int jj = 0; jj < 4; ++jj) { const int i = 16 * it + 4 * q + jj; const float gi = __expf((float)i * lgam);
                        const size_t R = RT_ROW(n, i); const size_t Rl = (size_t)b * SEQ + (R - (size_t)b * SROW - CTX);
#pragma unroll
                        for (int dd = 0; dd < 2; ++dd) RO[Rl * 2048 + h * 512 + sl * 64 + 16 * (2 * dvp + dd) + r] = (bf16)f2bf(oacc[dd][jj] * gi); }
                }
#pragma unroll
                for (int a = 0; a < 2; ++a)
#pragma unroll
                    for (int d = 0; d < 4; ++d) Tacc[a][d] = Tacc[a][d] * gC;
#pragma unroll
                for (int ks = 0; ks < 2; ++ks) {
                    bf16x8 kt[2], vf[4];
#pragma unroll
                    for (int a = 0; a < 2; ++a) { const int dkt = 2 * wave + a;
                        const s16x4 k0 = __builtin_amdgcn_ds_read_tr16_b64_v4i16((LAS s16x4*)(lds + KS + (32 * ks + 8 * q + qq) * RS + (16 * dkt + 4 * pp) * 2));
                        const s16x4 k1 = __builtin_amdgcn_ds_read_tr16_b64_v4i16((LAS s16x4*)(lds + KS + (32 * ks + 8 * q + 4 + qq) * RS + (16 * dkt + 4 * pp) * 2));
                        kt[a] = (bf16x8){k0[0], k0[1], k0[2], k0[3], k1[0], k1[1], k1[2], k1[3]}; }
#pragma unroll
                    for (int d = 0; d < 4; ++d) {
                        const s16x4 v0 = __builtin_amdgcn_ds_read_tr16_b64_v4i16((LAS s16x4*)(lds + VS + (32 * ks + 8 * q + qq) * VRS + (16 * d + 4 * pp) * 2));
                        const s16x4 v1 = __builtin_amdgcn_ds_read_tr16_b64_v4i16((LAS s16x4*)(lds + VS + (32 * ks + 8 * q + 4 + qq) * VRS + (16 * d + 4 * pp) * 2));
                        vf[d] = (bf16x8){v0[0], v0[1], v0[2], v0[3], v1[0], v1[1], v1[2], v1[3]}; }
#pragma unroll
                    for (int a = 0; a < 2; ++a)
#pragma unroll
                        for (int d = 0; d < 4; ++d) Tacc[a][d] = __builtin_amdgcn_mfma_f32_16x16x32_bf16(kt[a], vf[d], Tacc[a][d], 0, 0, 0);
                }
                __syncthreads();
            }
            BGW_STORE(1);
            for (; bg_it < BGW_ITEMS; bg_it += NGW) { BGW_ISSUE(bg_it, 1); BGW_STORE(1); }
        }
#undef RT_ROW
#undef RT_LOAD
    }
    PHASE_END

    PHASE_BEGIN
    {
        const bf16* O0 = (const bf16*)(BIG + B_RO0); const bf16* O1 = (const bf16*)(BIG + B_RO1); const bf16* INB = (const bf16*)(BIG + B_INB);
        for (int item = gw; item < NB * SEQ * 4; item += NGW) {
            const int Rl = item >> 2, h = item & 3, b = Rl / SEQ, n = Rl % SEQ; const size_t R = (size_t)b * SROW + CTX + n;
            const size_t o = (size_t)Rl * 2048 + h * 512 + lane * 8;
            const u32x4 a = *(const u32x4*)(O0 + o), c = *(const u32x4*)(O1 + o);
            float v[8] = {lo16(a.x) + lo16(c.x), hi16(a.x) + hi16(c.x), lo16(a.y) + lo16(c.y), hi16(a.y) + hi16(c.y), lo16(a.z) + lo16(c.z), hi16(a.z) + hi16(c.z), lo16(a.w) + lo16(c.w), hi16(a.w) + hi16(c.w)};
            float ss = 0.f;
#pragma unroll
            for (int e = 0; e < 8; ++e) ss += v[e] * v[e];
            const float rs = __builtin_amdgcn_rsqf(wave_sum(ss) * (1.f / 512.f) + EPS);
            const u32x4 gw4 = *(const u32x4*)(INB + R * INB_LD + 4096 + h * 512 + lane * 8);
            const float gt[8] = {lo16(gw4.x), hi16(gw4.x), lo16(gw4.y), hi16(gw4.y), lo16(gw4.z), hi16(gw4.z), lo16(gw4.w), hi16(gw4.w)};
            u32x4 w; w.x = pk2(v[0] * rs * siluf_(gt[0]), v[1] * rs * siluf_(gt[1])); w.y = pk2(v[2] * rs * siluf_(gt[2]), v[3] * rs * siluf_(gt[3]));
            w.z = pk2(v[4] * rs * siluf_(gt[4]), v[5] * rs * siluf_(gt[5])); w.w = pk2(v[6] * rs * siluf_(gt[6]), v[7] * rs * siluf_(gt[7]));
            *(u32x4*)(MIX + R * 3072 + 1024 + h * 512 + lane * 8) = w;
        }
    }
    PHASE_END

    PHASE_BEGIN
    { pg8::Gemm g{MIX, (const bf16*)(WB + W_OUT), 3072, 3072, 3072}; pg8::StaticOrder S; S.init(64, 8, G, bid, 1);
      EpiRes<false> E{XLb, XLb, MOD + 5 * 12288 + 2 * 2048, SLAB};
      pg8::gemm_phase<EpiRes<false>>(lds, g, S, E); }
    PHASE_END

    PHASE_BEGIN
    ADALN(1, 1, true, XLb, XC, true, (const float*)nullptr, (const float*)nullptr)
    PHASE_END

    PHASE_BEGIN
    { pg8::Gemm g{Hb, (const bf16*)(WB + W_UP), DM, DM, DM}; pg8::StaticOrder S; S.init(64, 44, G, bid, 1);
      EpiSwiglu E{(bf16*)(BIG + B_G)};
      pg8::gemm_phase<EpiSwiglu>(lds, g, S, E); }
    PHASE_END

    PHASE_BEGIN
    { pg8::Gemm g{(const bf16*)(BIG + B_G), (const bf16*)(WB + W_DN), DFF, DFF, DFF}; pg8::StaticOrder S; S.init(64, 8, G, bid, 1);
      EpiRes<false> E{XLb, XLb, MOD + 5 * 12288 + 5 * 2048, SLAB};
      pg8::gemm_phase<EpiRes<false>>(lds, g, S, E); }
    PHASE_END

    PHASE_BEGIN
    {
        const float* fg = args.in[I_FING];
        for (int R = gw; R < NB * SEQ; R += NGW) { const bf16* xr = XLb + (size_t)R * DM; float* orow = args.out + (size_t)R * DM;
            f32x4 v[8]; float ss = 0.f;
#pragma unroll
            for (int j = 0; j < 8; ++j) { const u32x2 w = *(const u32x2*)(xr + lane * 4 + j * 256); v[j] = (f32x4){lo16(w.x), hi16(w.x), lo16(w.y), hi16(w.y)};
                ss += (v[j][0] * v[j][0] + v[j][1] * v[j][1]) + (v[j][2] * v[j][2] + v[j][3] * v[j][3]); }
            const float rstd = __builtin_amdgcn_rsqf(wave_sum(ss) * (1.f / DM) + EPS);
#pragma unroll
            for (int j = 0; j < 8; ++j) { const f32x4 gg = *(const f32x4*)(fg + lane * 4 + j * 256); *(f32x4*)(orow + lane * 4 + j * 256) = v[j] * rstd * gg; }
        }
    }
    PHASE_END
}
constexpr int N_PHASES = 26;

extern "C" void kernel_launch(void* const* d_in, const int* in_sizes, int n_in, void* d_out, int out_size, void* d_ws, size_t ws_size, hipStream_t stream) {
    static int grid = 0;
    if (grid == 0) {
        if (n_in != 38 || out_size != NB * SEQ * DM || ws_size < WS_END) { fprintf(stderr, "kernel_launch: unexpected problem (n_in %d out %d ws %zu, need %zu)\n", n_in, out_size, ws_size, (size_t)WS_END); grid = -1; return; }
        int dev = 0, cus = 0;
        if (hipGetDevice(&dev) != hipSuccess || hipDeviceGetAttribute(&cus, hipDeviceAttributeMultiprocessorCount, dev) != hipSuccess) { grid = -1; return; }
        if (hipFuncSetAttribute((const void*)fwd_kernel, hipFuncAttributeMaxDynamicSharedMemorySize, LDS_BYTES) != hipSuccess) { fprintf(stderr, "kernel_launch: hipFuncSetAttribute failed\n"); grid = -1; return; }
        int per_cu = 0;
        if (hipOccupancyMaxActiveBlocksPerMultiprocessor(&per_cu, (const void*)fwd_kernel, 512, LDS_BYTES) != hipSuccess || per_cu < 1) { fprintf(stderr, "kernel_launch: occupancy query says %d\n", per_cu); }
        (void)hipGetLastError();
        if (per_cu < 1) { grid = -1; return; }
        grid = cus;
    }
    if (grid < 0) return;
    (void)hipMemsetAsync((char*)d_ws + WS_CTL, 0, CTL_BYTES, stream);
    Args a{};
    for (int i = 0; i < 38; ++i) a.in[i] = (const float*)d_in[i];
    a.out = (float*)d_out; a.ws = (unsigned char*)d_ws;
#if MK_ONE_LAUNCH
    a.ph_lo = 0; a.ph_hi = N_PHASES;
    hipLaunchKernelGGL(fwd_kernel, dim3(grid), dim3(512), LDS_BYTES, stream, a);
#else
    for (int p = 0; p < N_PHASES; ++p) { a.ph_lo = p; a.ph_hi = p + 1; hipLaunchKernelGGL(fwd_kernel, dim3(grid), dim3(512), LDS_BYTES, stream, a); }
#endif
}
```

```cpp
#include <hip/hip_runtime.h>
#include <cstdio>
#include <cstdint>

#ifndef MK_ONE_LAUNCH
#define MK_ONE_LAUNCH 1
#endif

#define DI __device__ __forceinline__
#define LAS __attribute__((address_space(3)))
typedef unsigned short bf16;
typedef short bf16x8 __attribute__((ext_vector_type(8)));
typedef float f32x4 __attribute__((ext_vector_type(4)));
typedef float f32x2 __attribute__((ext_vector_type(2)));
typedef unsigned u32x4 __attribute__((ext_vector_type(4)));
typedef unsigned u32x2 __attribute__((ext_vector_type(2)));
typedef short s16x4 __attribute__((ext_vector_type(4)));

constexpr int DM = 2048, NB = 4, SEQ = 4096, CTX = 256, DFF = 5632;
constexpr int SROW = CTX + SEQ;
constexpr int MROWS = NB * SROW;
constexpr int NCH = SROW / 64;
constexpr float EPS = 1e-6f;
constexpr int IN0_LD = 5120;
constexpr int INB_LD = 6144;

constexpr size_t MiB = 1u << 20;
constexpr size_t WS_CTL = 0, CTL_BYTES = 1 * MiB;
constexpr size_t WS_MOD = 1 * MiB;
constexpr size_t WS_TAB = 2 * MiB;
constexpr size_t WS_XC = 4 * MiB;
constexpr size_t WS_W = 12 * MiB;
constexpr size_t W_IN = 0, W_OUT = 32 * MiB, W_GLU = 44 * MiB, W_UP = 46 * MiB, W_DN = 90 * MiB;
constexpr size_t WS_H = 124 * MiB;
constexpr size_t WS_MIX = 192 * MiB;
constexpr size_t WS_BIG = 294 * MiB;
constexpr size_t B_IN0 = 0, B_AB = 170 * MiB, B_DNQ = 173 * MiB, B_DNK = 207 * MiB, B_DNV = 241 * MiB, B_DNG = 275 * MiB, B_DNB = 277 * MiB,
                 B_DNO0 = 279 * MiB, B_DNO1 = 313 * MiB, B_S5Y = 347 * MiB, B_S5E = 381 * MiB, B_S5S = 398 * MiB, B_GCUM = 415 * MiB, B_END0 = 417 * MiB;
constexpr size_t MIX_TINV = 68 * MiB;
constexpr size_t B_INA = 0, B_XCV = 68 * MiB, B_LA = 102 * MiB, B_BB = 170 * MiB, B_LEP = 238 * MiB, B_LST = 243 * MiB;
constexpr size_t B_INB = 0, B_RO0 = 204 * MiB, B_RO1 = 268 * MiB;
constexpr size_t B_G = 0;
constexpr size_t WS_END = WS_BIG + B_END0;

DI float bf2f(unsigned v) { return __uint_as_float(v << 16); }
typedef __bf16 bf16x2_t __attribute__((ext_vector_type(2)));
DI unsigned pk2(float lo, float hi) { const bf16x2_t v = __builtin_convertvector((f32x2){lo, hi}, bf16x2_t); return __builtin_bit_cast(unsigned, v); }
DI unsigned f2bf(float f) { return pk2(f, 0.f) & 0xffffu; }
DI float lo16(unsigned w) { return __uint_as_float(w << 16); }
DI float hi16(unsigned w) { return __uint_as_float(w & 0xffff0000u); }
DI float sigmoidf_(float x) { return __builtin_amdgcn_rcpf(1.f + __expf(-x)); }
DI float siluf_(float x) { return x * __builtin_amdgcn_rcpf(1.f + __expf(-x)); }
DI float softplusf_(float x) { return fmaxf(x, 0.f) + log1pf(expf(-fabsf(x))); }
DI float gelu_tanh(float x) { const float u = 0.7978845608028654f * (x + 0.044715f * x * x * x); return x * __builtin_amdgcn_rcpf(1.f + __expf(-2.f * u)); }
DI float wave_sum(float v) {
#pragma unroll
    for (int o = 1; o < 64; o <<= 1) v += __shfl_xor(v, o);
    return v;
}

DI bf16x8 frag_rows(LAS unsigned char* base, int RSB, int row0, int k0, int r, int q) { return *(const LAS bf16x8*)(base + (row0 + r) * RSB + (k0 + 8 * q) * 2); }
DI bf16x8 frag_tr(LAS unsigned char* base, int RSB, int k0, int n0, int q, int qq, int pp) {
    const s16x4 a = __builtin_amdgcn_ds_read_tr16_b64_v4i16((LAS s16x4*)(base + (k0 + 8 * q + qq) * RSB + (n0 + 4 * pp) * 2));
    const s16x4 b = __builtin_amdgcn_ds_read_tr16_b64_v4i16((LAS s16x4*)(base + (k0 + 8 * q + 4 + qq) * RSB + (n0 + 4 * pp) * 2));
    return (bf16x8){a[0], a[1], a[2], a[3], b[0], b[1], b[2], b[3]}; }
DI bf16x8 frag_rows_perm(LAS unsigned char* base, int RSB, int row0, int k0, int r, int q) {
    const u32x2 a = *(const LAS u32x2*)(base + (row0 + r) * RSB + (k0 + 4 * q) * 2), b = *(const LAS u32x2*)(base + (row0 + r) * RSB + (k0 + 16 + 4 * q) * 2);
    u32x4 w; w.x = a.x; w.y = a.y; w.z = b.x; w.w = b.y; return __builtin_bit_cast(bf16x8, w); }
DI bf16x8 pack_pair(const f32x4& x, const f32x4& y) { u32x4 w; w.x = pk2(x[0], x[1]); w.y = pk2(x[2], x[3]); w.z = pk2(y[0], y[1]); w.w = pk2(y[2], y[3]); return __builtin_bit_cast(bf16x8, w); }
#define MFMA16(a, b, c) __builtin_amdgcn_mfma_f32_16x16x32_bf16((a), (b), (c), 0, 0, 0)
DI void st_hl(LAS unsigned char* p, int lo_off, const f32x4& c) {
    u32x2 h; h.x = pk2(c[0], c[1]); h.y = pk2(c[2], c[3]);
    u32x2 l; l.x = pk2(c[0] - lo16(h.x), c[1] - hi16(h.x)); l.y = pk2(c[2] - lo16(h.y), c[3] - hi16(h.y));
    *(LAS u32x2*)p = h; *(LAS u32x2*)(p + lo_off) = l; }
DI f32x4 mm3(f32x4 c, const bf16x8& ah, const bf16x8& al, const bf16x8& bh, const bf16x8& bl) { c = MFMA16(ah, bh, c); c = MFMA16(ah, bl, c); c = MFMA16(al, bh, c); return c; }
#define LDS_WAIT() asm volatile("s_waitcnt lgkmcnt(0)" ::: "memory")
#define VM_WAIT() asm volatile("s_waitcnt vmcnt(0)" ::: "memory")

namespace pg8 {
constexpr int BM = 256, BK = 64, HALF = 128, HTB = HALF * BK * 2, STAGE_BYTES = 8 * HTB, NXCD = 8, WGM = 8;
DI int lds_byte(int r, int c) { const int st = (r >> 4) * 2 + (c >> 5), rr = r & 15, cc = c & 31, ob = rr * 64 + cc * 2; return st * 1024 + (ob ^ (((ob >> 9) & 1) << 5)); }
DI void stage_rc(int b, int& R, int& C) { const int st = b / 1024, sb = b % 1024, swz = sb ^ (((sb >> 9) & 1) << 5); R = (st >> 1) * 16 + swz / 64; C = (st & 1) * 32 + (swz % 64) / 2; }
DI int perm32(int rho) { const int n = rho >> 4, i = rho & 15; return 8 * (i >> 2) + 4 * n + (i & 3); }
struct Unit { int pm, pn, koff, nt; };
struct Gemm { const bf16* A; const bf16* Bt; int lda, ldb, K; };
struct StaticOrder {
    int nM, nN, nwg, G, c, lat;
    DI void init(int nM_, int nN_, int G_, int c_, int lat_) { nM = nM_; nN = nN_; nwg = nM * nN; G = G_; c = c_; lat = lat_; }
    DI bool next(int i, int& upm, int& upn, int& ukoff, int& unt) const {
        const long L = (long)i * G + c; if (L >= nwg) return false;
        int wgid = (int)L; { const int q = nwg / NXCD, r = nwg % NXCD, xcd = wgid % NXCD, off = wgid / NXCD; wgid = (xcd < r ? xcd * (q + 1) : r * (q + 1) + (xcd - r) * q) + off; }
        const int nig = WGM * nN, gid = wgid / nig, fm = gid * WGM, gsz = (nM - fm) < WGM ? (nM - fm) : WGM;
        int pm = fm + ((wgid % nig) % gsz); upn = (wgid % nig) / gsz;
        if (lat) pm = (pm >> 4) * 17 + 1 + (pm & 15);
        upm = pm; ukoff = 0; unt = 0; return true;
    }
};
template <int NTOT> struct TailOrder {
    int G, c;
    static constexpr int NWG = 512, LO = (NTOT / 8) & ~1, EX2 = (NTOT - LO * 8) >> 1;
    DI void init(int G_, int c_) { G = G_; c = c_; }
    DI bool next(int i, int& upm, int& upn, int& ukoff, int& unt) const {
        const int L = i * G + c; if (L >= NWG + 256) return false;
        const bool mainu = L < NWG; const int T = L - NWG;
        const int wgid = (L & 7) * (NWG / 8) + (L >> 3);
        const int w = wgid & 63, pml = (wgid >> 6) * 8 + (w & 7); const int ctn = T >> 3, sp = T & 7;
        upm = mainu ? (pml >> 4) * 17 + 1 + (pml & 15) : (ctn >> 3) * 17; upn = mainu ? (w >> 3) : (ctn & 7);
        unt = mainu ? 0 : ((LO + (sp < EX2 ? 2 : 0)) | (sp << 8)); ukoff = mainu ? 0 : (LO * sp + 2 * (sp < EX2 ? sp : EX2)) * 128; return true;
    }
};
DI unsigned cvt_pk_bf16(float lo, float hi) { unsigned r; asm volatile("v_cvt_pk_bf16_f32 %0, %1, %2" : "=v"(r) : "v"(lo), "v"(hi)); return r; }

template <class Epi, class Sched = StaticOrder, bool BLKDIAG = false>
DI void gemm_phase(LAS unsigned char* lds, const Gemm g, const Sched& S, const Epi& E) {
    int tid_ = threadIdx.x; asm volatile("" : "+v"(tid_));
    const int tid = tid_, wid = __builtin_amdgcn_readfirstlane(tid >> 6), lane = tid & 63, wr = wid >> 2, wc = wid & 3, fr = lane & 15, fq = lane >> 4;
    int K_ = g.K; asm volatile("" : "+s"(K_));
    const int K = K_, nt = K / BK;
    unsigned voffA[2], voffB[2];
#pragma unroll
    for (int i = 0; i < 2; ++i) { int R, C; stage_rc(tid * 16 + i * 8192, R, C); const int Rb = Epi::PERM ? ((R & ~31) + perm32(R & 31)) : R;
        voffA[i] = (unsigned)(R * g.lda + C) * 2u; voffB[i] = (unsigned)(Rb * g.ldb + C) * 2u; }
    const size_t kstep = (size_t)(BK * 2);
    const size_t hstepA = (size_t)HALF * g.lda * 2, hstepB = (size_t)HALF * g.ldb * 2;
    const size_t tstepA = 2 * hstepA, tstepB = 2 * hstepB;
    const unsigned ldsw = (unsigned)wid * 1024u;
    const int aoff = lds_byte(wr * 64 + fr, fq * 8), boff = lds_byte(wc * 32 + fr, fq * 8);
#define PG8_SA(b, h) (((b) * 2 + (h)) * HTB)
#define PG8_SB(b, h) ((4 + (b) * 2 + (h)) * HTB)
#define PG8_STAGE(bufoff, gbase, voff) do { _Pragma("unroll") for (int _i = 0; _i < 2; ++_i) \
        __builtin_amdgcn_global_load_lds((const unsigned*)((const char*)(gbase) + (voff)[_i]), (LAS unsigned*)(lds + (bufoff) + ldsw + _i * 8192), 16, 0, 0); } while (0)
#define PG8_LDA(dst, b, h) do { _Pragma("unroll") for (int m = 0; m < 4; ++m) _Pragma("unroll") for (int k = 0; k < 2; ++k) dst[m][k] = *(const LAS bf16x8*)(lds + PG8_SA(b, h) + aoff + m * 2048 + k * 1024); } while (0)
#define PG8_LDB(dst, b, h) do { _Pragma("unroll") for (int n = 0; n < 2; ++n) _Pragma("unroll") for (int k = 0; k < 2; ++k) dst[n][k] = *(const LAS bf16x8*)(lds + PG8_SB(b, h) + boff + n * 2048 + k * 1024); } while (0)
#define PG8_MMA(ai, bj, At, Bt) do { __builtin_amdgcn_s_setprio(1); _Pragma("unroll") for (int m = 0; m < 4; ++m) _Pragma("unroll") for (int n = 0; n < 2; ++n) _Pragma("unroll") for (int k = 0; k < 2; ++k) \
        acc[ai][bj][m][n] = __builtin_amdgcn_mfma_f32_16x16x32_bf16(Bt[n][k], At[m][k], acc[ai][bj][m][n], 0, 0, 0); __builtin_amdgcn_s_setprio(0); } while (0)
#define PG8_WAIT_V(n) asm volatile("s_waitcnt vmcnt(" #n ")" ::: "memory")
#define PG8_WAIT_L(n) asm volatile("s_waitcnt lgkmcnt(" #n ")" ::: "memory")
#define PG8_BAR __builtin_amdgcn_s_barrier()
#define PG8_SCHED __builtin_amdgcn_sched_barrier(0)
#define PG8_KOFF(pn_, koff_) ((BLKDIAG ? (size_t)(((pn_) & 7) >> 1) * 512 : (size_t)0) + (size_t)(koff_))
    int cpm, cpn, ckoff, cnt_, npm = 0, npn = 0, nkoff = 0, nnt = 0; int ui = 0;
    if (!S.next(0, cpm, cpn, ckoff, cnt_)) return;
    f32x4 acc[2][2][4][2];
#pragma unroll
    for (int a = 0; a < 2; ++a)
#pragma unroll
        for (int b = 0; b < 2; ++b)
#pragma unroll
            for (int m = 0; m < 4; ++m)
#pragma unroll
                for (int n = 0; n < 2; ++n) acc[a][b][m][n] = (f32x4){0.f, 0.f, 0.f, 0.f};
    bf16x8 At[4][2], B0[2][2], B1[2][2];
    const char* cA = (const char*)g.A + (size_t)cpm * tstepA + PG8_KOFF(cpn, ckoff); const char* cB = (const char*)g.Bt + (size_t)cpn * tstepB + (size_t)ckoff;
    PG8_STAGE(PG8_SB(0, 0), cB, voffB); PG8_STAGE(PG8_SB(0, 1), cB + hstepB, voffB); PG8_STAGE(PG8_SA(0, 0), cA, voffA); PG8_STAGE(PG8_SA(0, 1), cA + hstepA, voffA);
    if (wr == 1) PG8_BAR;
    PG8_WAIT_V(2); PG8_BAR;
    PG8_STAGE(PG8_SB(1, 0), cB + kstep, voffB); PG8_STAGE(PG8_SA(1, 0), cA + kstep, voffA); PG8_STAGE(PG8_SB(1, 1), cB + hstepB + kstep, voffB);
    PG8_WAIT_V(6); PG8_BAR;
    for (;;) {
        const bool has_next = S.next(ui + 1, npm, npn, nkoff, nnt);
        const char* nA = has_next ? (const char*)g.A + (size_t)npm * tstepA + PG8_KOFF(npn, nkoff) : cA; const char* nB = has_next ? (const char*)g.Bt + (size_t)npn * tstepB + (size_t)nkoff : cB;
        const int cnt = cnt_ ? (cnt_ & 255) : nt;
        for (int t = 0; t < cnt; t += 2) {
            const bool last = (t == cnt - 2);
            const char* a1 = cA + (size_t)(t + 1) * kstep;
            const char* a2 = last ? nA : cA + (size_t)(t + 2) * kstep; const char* b2 = last ? nB : cB + (size_t)(t + 2) * kstep;
            const char* a3 = a2 + kstep; const char* b3 = b2 + kstep;
            PG8_LDB(B0, 0, 0); PG8_LDB(B1, 0, 1); PG8_SCHED; PG8_LDA(At, 0, 0); PG8_STAGE(PG8_SA(1, 1), a1 + hstepA, voffA);
            PG8_WAIT_V(8); PG8_WAIT_L(0); PG8_BAR; PG8_MMA(0, 0, At, B0); PG8_MMA(0, 1, At, B1); PG8_BAR; PG8_SCHED;
            PG8_LDA(At, 0, 1); PG8_STAGE(PG8_SB(0, 0), b2, voffB); PG8_STAGE(PG8_SB(0, 1), b2 + hstepB, voffB); PG8_STAGE(PG8_SA(0, 0), a2, voffA);
            PG8_WAIT_V(8); PG8_WAIT_L(0); PG8_BAR; PG8_MMA(1, 0, At, B0); PG8_MMA(1, 1, At, B1); PG8_BAR; PG8_SCHED;
            PG8_LDB(B0, 1, 0); PG8_LDB(B1, 1, 1); PG8_SCHED; PG8_LDA(At, 1, 0); PG8_STAGE(PG8_SA(0, 1), a2 + hstepA, voffA);
            PG8_WAIT_V(8); PG8_WAIT_L(0); PG8_BAR; PG8_MMA(0, 0, At, B0); PG8_MMA(0, 1, At, B1); PG8_BAR; PG8_SCHED;
            PG8_LDA(At, 1, 1); PG8_STAGE(PG8_SB(1, 0), b3, voffB); PG8_STAGE(PG8_SB(1, 1), b3 + hstepB, voffB); PG8_STAGE(PG8_SA(1, 0), a3, voffA);
            PG8_WAIT_V(8); PG8_WAIT_L(0); PG8_BAR; PG8_MMA(1, 0, At, B0); PG8_MMA(1, 1, At, B1); PG8_BAR; PG8_SCHED;
        }
        if (wr == 0) PG8_BAR;
        { Unit cu; cu.pm = cpm; cu.pn = cpn; cu.koff = ckoff; cu.nt = cnt_; E(acc, cu, wr, wc, fr, fq); }
        if (!has_next) break;
#pragma unroll
        for (int a = 0; a < 2; ++a)
#pragma unroll
            for (int b = 0; b < 2; ++b)
#pragma unroll
                for (int m = 0; m < 4; ++m)
#pragma unroll
                    for (int n = 0; n < 2; ++n) acc[a][b][m][n] = (f32x4){0.f, 0.f, 0.f, 0.f};
        cpm = npm; cpn = npn; ckoff = nkoff; cnt_ = nnt; cA = nA; cB = nB; ++ui;
        if (wr == 1) PG8_BAR;
    }
    PG8_WAIT_V(0);
    PG8_BAR;
#undef PG8_SA
#undef PG8_SB
#undef PG8_STAGE
#undef PG8_LDA
#undef PG8_LDB
#undef PG8_MMA
#undef PG8_WAIT_V
#undef PG8_WAIT_L
#undef PG8_BAR
#undef PG8_SCHED
#undef PG8_KOFF
}
}
using pg8::Unit;
typedef f32x4 AccT[2][2][4][2];

struct EpiPlain {
    static constexpr bool PERM = true;
    bf16* O; int ldc;
    DI void operator()(const AccT& acc, const Unit& u, int wr, int wc, int fr, int fq) const {
        const int row0 = u.pm * 256 + wr * 64 + fr, col0 = u.pn * 256 + wc * 32 + 8 * fq;
#pragma unroll
        for (int ai = 0; ai < 2; ++ai)
#pragma unroll
            for (int m = 0; m < 4; ++m) { bf16* rowp = O + (size_t)(row0 + ai * 128 + m * 16) * ldc + col0;
#pragma unroll
                for (int bj = 0; bj < 2; ++bj) { const f32x4 v0 = acc[ai][bj][m][0], v1 = acc[ai][bj][m][1];
                    u32x4 w; w.x = pg8::cvt_pk_bf16(v0[0], v0[1]); w.y = pg8::cvt_pk_bf16(v0[2], v0[3]); w.z = pg8::cvt_pk_bf16(v1[0], v1[1]); w.w = pg8::cvt_pk_bf16(v1[2], v1[3]);
                    *(u32x4*)(rowp + bj * 128) = w; } }
    }
};
struct EpiIn0 {
    static constexpr bool PERM = true;
    bf16* O; float* AB;
    DI void operator()(const AccT& acc, const Unit& u, int wr, int wc, int fr, int fq) const {
        const int row0 = u.pm * 256 + wr * 64 + fr;
        if (u.pn < 20) {
            const int col0 = u.pn * 256 + wc * 32 + 8 * fq;
#pragma unroll
            for (int ai = 0; ai < 2; ++ai)
#pragma unroll
                for (int m = 0; m < 4; ++m) { bf16* rowp = O + (size_t)(row0 + ai * 128 + m * 16) * IN0_LD + col0;
#pragma unroll
                    for (int bj = 0; bj < 2; ++bj) { const f32x4 v0 = acc[ai][bj][m][0], v1 = acc[ai][bj][m][1];
                        u32x4 w; w.x = pg8::cvt_pk_bf16(v0[0], v0[1]); w.y = pg8::cvt_pk_bf16(v0[2], v0[3]); w.z = pg8::cvt_pk_bf16(v1[0], v1[1]); w.w = pg8::cvt_pk_bf16(v1[2], v1[3]);
                        *(u32x4*)(rowp + bj * 128) = w; } }
        } else if (wc == 0) {
#pragma unroll
            for (int ai = 0; ai < 2; ++ai)
#pragma unroll
                for (int m = 0; m < 4; ++m) { float* rowp = AB + (size_t)(row0 + ai * 128 + m * 16) * 32 + 8 * fq;
                    *(f32x4*)(rowp) = acc[ai][0][m][0]; *(f32x4*)(rowp + 4) = acc[ai][0][m][1]; }
        }
    }
};
template <bool XIN_F32> struct EpiRes {
    static constexpr bool PERM = true;
    const void* xin_l; bf16* xout_l; const float* mod; float* slab;
    DI void operator()(const AccT& acc, const Unit& u, int wr, int wc, int fr, int fq) const {
        const int b = u.pm / 17, j = u.pm % 17;
        const int r0 = wr * 64 + fr, col0 = u.pn * 256 + wc * 32 + 8 * fq;
        if (j == 0) {
            float* sp = slab + ((size_t)(u.nt >> 8) * 1024 + (size_t)b * 256) * DM;
#pragma unroll
            for (int ai = 0; ai < 2; ++ai)
#pragma unroll
                for (int m = 0; m < 4; ++m) { const size_t ro = (size_t)(r0 + ai * 128 + m * 16) * DM + col0;
#pragma unroll
                    for (int bj = 0; bj < 2; ++bj) { *(f32x4*)(sp + ro + bj * 128) = acc[ai][bj][m][0]; *(f32x4*)(sp + ro + bj * 128 + 4) = acc[ai][bj][m][1]; } }
            return;
        }
        const size_t off = ((size_t)b * SEQ + (size_t)(j - 1) * 256) * DM; const float* gt = mod + b * 12288;
        f32x4 gv[2][2];
#pragma unroll
        for (int bj = 0; bj < 2; ++bj)
#pragma unroll
            for (int n = 0; n < 2; ++n) gv[bj][n] = *(const f32x4*)(gt + col0 + bj * 128 + 4 * n);
#pragma unroll
        for (int ai = 0; ai < 2; ++ai)
#pragma unroll
            for (int m = 0; m < 4; ++m) { const size_t ro = off + (size_t)(r0 + ai * 128 + m * 16) * DM + col0;
#pragma unroll
                for (int bj = 0; bj < 2; ++bj) { f32x4 x0, x1;
                    if (XIN_F32) { x0 = *(const f32x4*)((const float*)xin_l + ro + bj * 128); x1 = *(const f32x4*)((const float*)xin_l + ro + bj * 128 + 4); }
                    else { const u32x4 w = *(const u32x4*)((const bf16*)xin_l + ro + bj * 128); x0 = (f32x4){lo16(w.x), hi16(w.x), lo16(w.y), hi16(w.y)}; x1 = (f32x4){lo16(w.z), hi16(w.z), lo16(w.w), hi16(w.w)}; }
                    const f32x4 o0 = x0 + gv[bj][0] * acc[ai][bj][m][0], o1 = x1 + gv[bj][1] * acc[ai][bj][m][1];
                    u32x4 w; w.x = pg8::cvt_pk_bf16(o0[0], o0[1]); w.y = pg8::cvt_pk_bf16(o0[2], o0[3]); w.z = pg8::cvt_pk_bf16(o1[0], o1[1]); w.w = pg8::cvt_pk_bf16(o1[2], o1[3]);
                    *(u32x4*)(xout_l + ro + bj * 128) = w; } }
    }
};
struct EpiSwiglu {
    static constexpr bool PERM = true;
    bf16* O;
    DI void operator()(const AccT& acc, const Unit& u, int wr, int wc, int fr, int fq) const {
        const int row0 = u.pm * 256 + wr * 64 + fr, col0 = u.pn * 128 + wc * 32 + 8 * fq;
#pragma unroll
        for (int ai = 0; ai < 2; ++ai)
#pragma unroll
            for (int m = 0; m < 4; ++m) { bf16* rowp = O + (size_t)(row0 + ai * 128 + m * 16) * DFF + col0;
                float v[8];
#pragma unroll
                for (int n = 0; n < 2; ++n)
#pragma unroll
                    for (int j = 0; j < 4; ++j) { const float a = acc[ai][0][m][n][j], b = acc[ai][1][m][n][j]; v[n * 4 + j] = a * __builtin_amdgcn_rcpf(1.f + __expf(-a)) * b; }
                u32x4 w; w.x = pg8::cvt_pk_bf16(v[0], v[1]); w.y = pg8::cvt_pk_bf16(v[2], v[3]); w.z = pg8::cvt_pk_bf16(v[4], v[5]); w.w = pg8::cvt_pk_bf16(v[6], v[7]);
                *(u32x4*)rowp = w; }
    }
};
struct EpiGlu {
    static constexpr bool PERM = true;
    const bf16* Y; bf16* O; const float* gb;
    DI void operator()(const AccT& acc, const Unit& u, int wr, int wc, int fr, int fq) const {
        const int row0 = u.pm * 256 + wr * 64 + fr, col0 = u.pn * 256 + wc * 32 + 8 * fq;
#pragma unroll
        for (int bj = 0; bj < 2; ++bj) {
            const f32x4 b0 = *(const f32x4*)(gb + col0 + bj * 128), b1 = *(const f32x4*)(gb + col0 + bj * 128 + 4);
#pragma unroll
            for (int ai = 0; ai < 2; ++ai)
#pragma unroll
                for (int m = 0; m < 4; ++m) { const size_t r = (size_t)(row0 + ai * 128 + m * 16);
                    const u32x4 yw = *(const u32x4*)(Y + r * 1024 + col0 + bj * 128);
                    const f32x4 v0 = acc[ai][bj][m][0] + b0, v1 = acc[ai][bj][m][1] + b1;
                    float o[8];
#define FSIG(x) __builtin_amdgcn_rcpf(1.f + __expf(-(x)))
                    o[0] = lo16(yw.x) * FSIG(v0[0]); o[1] = hi16(yw.x) * FSIG(v0[1]); o[2] = lo16(yw.y) * FSIG(v0[2]); o[3] = hi16(yw.y) * FSIG(v0[3]);
                    o[4] = lo16(yw.z) * FSIG(v1[0]); o[5] = hi16(yw.z) * FSIG(v1[1]); o[6] = lo16(yw.w) * FSIG(v1[2]); o[7] = hi16(yw.w) * FSIG(v1[3]);
#undef FSIG
                    u32x4 w; w.x = pg8::cvt_pk_bf16(o[0], o[1]); w.y = pg8::cvt_pk_bf16(o[2], o[3]); w.z = pg8::cvt_pk_bf16(o[4], o[5]); w.w = pg8::cvt_pk_bf16(o[6], o[7]);
                    *(u32x4*)(O + r * 2048 + col0 + bj * 128) = w; }
        }
    }
};
struct EpiGate {
    static constexpr bool PERM = true;
    const bf16* X; bf16* LA; bf16* BB; const float* ba; const float* bx; const float* spl;
    DI void operator()(const AccT& acc, const Unit& u, int wr, int wc, int fr, int fq) const {
        const int dir = u.pn >> 3, blk = u.pn & 7;
        const int row0 = u.pm * 256 + wr * 64 + fr, ch0 = blk * 128 + wc * 32 + 8 * fq;
        const f32x4 ba0 = *(const f32x4*)(ba + dir * 1024 + ch0), ba1 = *(const f32x4*)(ba + dir * 1024 + ch0 + 4);
        const f32x4 bx0 = *(const f32x4*)(bx + dir * 1024 + ch0), bx1 = *(const f32x4*)(bx + dir * 1024 + ch0 + 4);
        const f32x4 sp0 = *(const f32x4*)(spl + dir * 1024 + ch0), sp1 = *(const f32x4*)(spl + dir * 1024 + ch0 + 4);
#pragma unroll
        for (int ai = 0; ai < 2; ++ai)
#pragma unroll
            for (int m = 0; m < 4; ++m) { const size_t r = (size_t)(row0 + ai * 128 + m * 16);
                const u32x4 xw = *(const u32x4*)(X + r * 1024 + ch0);
                const float xv[8] = {lo16(xw.x), hi16(xw.x), lo16(xw.y), hi16(xw.y), lo16(xw.z), hi16(xw.z), lo16(xw.w), hi16(xw.w)};
                float la[8], bb[8];
#pragma unroll
                for (int n = 0; n < 2; ++n)
#pragma unroll
                    for (int j = 0; j < 4; ++j) { const int q = n * 4 + j;
                        const float pa = acc[ai][0][m][n][j] + (n ? ba1[j] : ba0[j]), px = acc[ai][1][m][n][j] + (n ? bx1[j] : bx0[j]);
                        const float rg = __builtin_amdgcn_rcpf(1.f + __expf(-pa)), ig = __builtin_amdgcn_rcpf(1.f + __expf(-px));
                        const float l = rg * (n ? sp1[j] : sp0[j]); la[q] = l;
                        const float x2 = 2.f * l;
                        const float ser = -x2 * (1.f + x2 * 0.5f * (1.f + x2 * (1.f / 3.f) * (1.f + x2 * 0.25f * (1.f + x2 * 0.2f))));
                        const float om = x2 > -0.25f ? ser : 1.f - __expf(x2);
                        bb[q] = __builtin_sqrtf(fmaxf(om, 0.f)) * (ig * xv[q]); }
                u32x4 w; w.x = pg8::cvt_pk_bf16(la[0], la[1]); w.y = pg8::cvt_pk_bf16(la[2], la[3]); w.z = pg8::cvt_pk_bf16(la[4], la[5]); w.w = pg8::cvt_pk_bf16(la[6], la[7]);
                *(u32x4*)(LA + (r * 2 + dir) * 1024 + ch0) = w;
                w.x = pg8::cvt_pk_bf16(bb[0], bb[1]); w.y = pg8::cvt_pk_bf16(bb[2], bb[3]); w.z = pg8::cvt_pk_bf16(bb[4], bb[5]); w.w = pg8::cvt_pk_bf16(bb[6], bb[7]);
                *(u32x4*)(BB + (r * 2 + dir) * 1024 + ch0) = w; }
    }
};
struct EpiRope {
    static constexpr bool PERM = true;
    bf16* O; const f32x2* rope;
    DI void operator()(const AccT& acc, const Unit& u, int wr, int wc, int fr, int fq) const {
        const int row0 = u.pm * 256 + wr * 64 + fr, col0 = u.pn * 256 + wc * 32 + 8 * fq;
        const int jt = u.pm % 17;
        const bool isqk = u.pn < 8, lat = jt != 0;
        const float sc = (u.pn >= 4 && u.pn < 8) ? 0.0625f : 1.f;
#pragma unroll
        for (int ai = 0; ai < 2; ++ai)
#pragma unroll
            for (int m = 0; m < 4; ++m) { const int rl = wr * 64 + fr + ai * 128 + m * 16;
                bf16* rowp = O + (size_t)(u.pm * 256 + rl) * INB_LD + col0;
                float t1[8], t2[8];
#pragma unroll
                for (int n = 0; n < 2; ++n)
#pragma unroll
                    for (int j = 0; j < 4; ++j) { t1[n * 4 + j] = acc[ai][0][m][n][j]; t2[n * 4 + j] = acc[ai][1][m][n][j]; }
                if (isqk && lat) {
                    const int pos = (jt - 1) * 256 + rl;
                    const int p = (wc < 2) ? (pos >> 6) : (pos & 63);
                    const int f0 = (wc & 1) * 32 + 8 * fq;
                    const f32x4* rp = (const f32x4*)(rope + p * 64 + f0);
#pragma unroll
                    for (int q = 0; q < 4; ++q) { const f32x4 cs = rp[q];
                        const float a0 = t1[2 * q], b0 = t2[2 * q], a1 = t1[2 * q + 1], b1 = t2[2 * q + 1];
                        t1[2 * q] = a0 * cs[0] - b0 * cs[1]; t2[2 * q] = a0 * cs[1] + b0 * cs[0];
                        t1[2 * q + 1] = a1 * cs[2] - b1 * cs[3]; t2[2 * q + 1] = a1 * cs[3] + b1 * cs[2]; }
                }
                u32x4 w; w.x = pg8::cvt_pk_bf16(t1[0] * sc, t1[1] * sc); w.y = pg8::cvt_pk_bf16(t1[2] * sc, t1[3] * sc); w.z = pg8::cvt_pk_bf16(t1[4] * sc, t1[5] * sc); w.w = pg8::cvt_pk_bf16(t1[6] * sc, t1[7] * sc);
                *(u32x4*)(rowp) = w;
                w.x = pg8::cvt_pk_bf16(t2[0] * sc, t2[1] * sc); w.y = pg8::cvt_pk_bf16(t2[2] * sc, t2[3] * sc); w.z = pg8::cvt_pk_bf16(t2[4] * sc, t2[5] * sc); w.w = pg8::cvt_pk_bf16(t2[6] * sc, t2[7] * sc);
                *(u32x4*)(rowp + 128) = w; }
    }
};

#define XB_TMO      128
#define XB_XCNT(j)  (256  + 64 * (j))
#define XB_XSUB(j)  (1280 + 64 * (j))
#define XB_XGEN(j)  (2304 + 64 * (j))
#define XB_TOP      3328
#define XB_TOPGEN   3392
#define XCD_BAR_WORDS 3456
#define XB_SPIN_CAP (1u << 22)
__device__ __forceinline__ unsigned xb_ld(unsigned* p)              { return __hip_atomic_load(p, __ATOMIC_RELAXED, __HIP_MEMORY_SCOPE_AGENT); }
__device__ __forceinline__ unsigned xb_add(unsigned* p, unsigned v) { return __hip_atomic_fetch_add(p, v, __ATOMIC_RELAXED, __HIP_MEMORY_SCOPE_AGENT); }
__device__ __forceinline__ unsigned xb_xcc_id() { return (unsigned)__builtin_amdgcn_s_getreg((3 << 11) | 20) & 0xFu; }
#define XB_SPIN(cond, bar) do { unsigned _sp = 0; while (cond) { __builtin_amdgcn_s_sleep(1); \
    if ((++_sp & 255u) == 0u) { if (xb_ld(&(bar)[XB_TMO])) break; if (_sp > XB_SPIN_CAP) { atomicAdd(&(bar)[XB_TMO], 1u); break; } } } } while (0)
struct XcdBarrier { unsigned* bar; unsigned x; volatile LAS unsigned* st; };
__device__ __forceinline__ XcdBarrier xcd_barrier_post(unsigned* bar, volatile LAS unsigned* st) {
    XcdBarrier b; b.bar = bar; b.x = xb_xcc_id(); b.st = st;
    if (threadIdx.x == 0) (void)xb_add(&bar[XB_XCNT(b.x)], 1u);
    return b;
}
__device__ __forceinline__ void xcd_barrier_complete(unsigned* bar, unsigned x, unsigned& nloc, unsigned& nx) {
    const unsigned G = gridDim.x * gridDim.y * gridDim.z;
    unsigned sum, cnt, mine, sp = 0u;
    for (;;) {
        sum = 0u; cnt = 0u; mine = 0u;
#pragma unroll
        for (unsigned j = 0; j < 16; ++j) { const unsigned c = xb_ld(&bar[XB_XCNT(j)]); sum += c; cnt += (c > 0u) ? 1u : 0u; mine = (j == x) ? c : mine; }
        if (sum == G) break;
        __builtin_amdgcn_s_sleep(1);
        if ((++sp & 255u) == 0u) { if (xb_ld(&bar[XB_TMO])) break; if (sp > XB_SPIN_CAP) { atomicAdd(&bar[XB_TMO], 1u); break; } }
    }
    nloc = mine > 0u ? mine : 1u; nx = cnt > 0u ? cnt : 1u;
}
__device__ __forceinline__ void xcd_barrier(const XcdBarrier& b) {
    asm volatile("s_waitcnt vmcnt(0)" ::: "memory");
    __syncthreads();
    if (threadIdx.x == 0) {
        unsigned* bar = b.bar;
        __builtin_amdgcn_s_waitcnt(0);
        unsigned nloc = b.st[0], nx = b.st[1];
        if (nloc == 0u) { xcd_barrier_complete(bar, b.x, nloc, nx); b.st[0] = nloc; b.st[1] = nx; }
        const unsigned old = xb_add(&bar[XB_XSUB(b.x)], 1u);
        const unsigned gen = old / nloc;
        if (old + 1u == (gen + 1u) * nloc) {
            __builtin_amdgcn_fence(__ATOMIC_RELEASE, "agent");
            asm volatile("s_waitcnt vmcnt(0)" ::: "memory");
            const unsigned og = xb_add(&bar[XB_TOP], 1u);
            const unsigned tg = og / nx;
            if (og + 1u == (tg + 1u) * nx) xb_add(&bar[XB_TOPGEN], 1u);
            else XB_SPIN(xb_ld(&bar[XB_TOPGEN]) == tg, bar);
            __builtin_amdgcn_fence(__ATOMIC_ACQUIRE, "agent");
            xb_add(&bar[XB_XGEN(b.x)], 1u);
            asm volatile("s_waitcnt vmcnt(0)" ::: "memory");
        } else {
            XB_SPIN(xb_ld(&bar[XB_XGEN(b.x)]) == gen, bar);
            __builtin_amdgcn_fence(__ATOMIC_ACQUIRE, "agent");
            asm volatile("s_waitcnt vmcnt(0)" ::: "memory");
        }
    }
    __syncthreads();
}

struct Args { const float* in[38]; float* out; unsigned char* ws; int ph_lo, ph_hi; };
enum { I_X = 0, I_C, I_CTX, I_CCTX, I_MODW, I_MODB, I_N1G, I_N2G, I_W1, I_W3, I_W2, I_FING, I_EWIN, I_EWOUT, I_LRE, I_LIM, I_LSTEP, I_BRE, I_BIM, I_CRE, I_CIM,
       I_S5D, I_GLUW, I_GLUB, I_DNCW, I_DNALOG, I_DNDT, I_DNNG, I_OWIN, I_OWOUT, I_LCW, I_LCB, I_LWA, I_LBA, I_LWX, I_LBX, I_LLAM, I_RTH };

constexpr int LDS_RING = 131072, LDS_CTL_OFF = 131072, LDS_BYTES = 147456;
constexpr int NW = 8;

DI void transpose_item(const float* W, int ldw, int k0, int n_src0, bf16* WT, int ldk, int dst_row0, LAS float* scr, int lane) {
#pragma unroll 8
    for (int i = 0; i < 32; ++i) { const int kk = 2 * i + (lane >> 5); scr[kk * 33 + (lane & 31)] = W[(size_t)(k0 + kk) * ldw + n_src0 + (lane & 31)]; }
    LDS_WAIT();
    const int c = lane & 7;
#pragma unroll
    for (int j = 0; j < 4; ++j) { const int n = (lane >> 3) + 8 * j; const LAS float* s = scr + (8 * c) * 33 + n;
        u32x4 o; o.x = pk2(s[0 * 33], s[1 * 33]); o.y = pk2(s[2 * 33], s[3 * 33]); o.z = pk2(s[4 * 33], s[5 * 33]); o.w = pk2(s[6 * 33], s[7 * 33]);
        *(u32x4*)(WT + (size_t)(dst_row0 + n) * ldk + k0 + 8 * c) = o; }
    LDS_WAIT();
}
DI void transpose_job(int it, const float* W, int K, int N, bf16* WT, int mode, int add, LAS float* scr, int lane) {
    const int nblk = N / 32, kb = it / nblk, nb = it % nblk, n0 = nb * 32;
    const int dr = mode ? ((n0 >> 7) * 256 + (n0 & 127) + add) : n0;
    transpose_item(W, N, kb * 64, n0, WT, K, dr, scr, lane);
}


#define BGW_ITEMS 67584
#define BGW_DECODE(it, LAYER) \
    const int job_ = (it) / 22528, idx_ = (it) - job_ * 22528; \
    const int KK_ = job_ < 2 ? 2048 : 5632, NN_ = job_ < 2 ? 5632 : 2048, kbs_ = KK_ >> 3; \
    const int nblk_ = idx_ / kbs_, kblk_ = idx_ - nblk_ * kbs_, n_ = nblk_ * 64 + lane; \
    const float* src_ = args.in[job_ == 0 ? I_W1 : (job_ == 1 ? I_W3 : I_W2)] + (size_t)(LAYER) * 2048 * 5632 + (size_t)(kblk_ * 8) * NN_ + n_; \
    const int row_ = job_ < 2 ? ((n_ >> 7) * 256 + (n_ & 127) + (job_ == 1 ? 128 : 0)) : n_; \
    bf16* dst_ = (bf16*)(WB + (job_ < 2 ? W_UP : W_DN)) + (size_t)row_ * KK_ + kblk_ * 8;
#define BGW_ISSUE(it, LAYER) do { if ((it) < BGW_ITEMS) { BGW_DECODE(it, LAYER) (void)dst_; \
        _Pragma("unroll") for (int e_ = 0; e_ < 8; ++e_) bgv[e_] = src_[(size_t)e_ * NN_]; bg_cur = (it); } else bg_cur = -1; } while (0)
#define BGW_STORE(LAYER) do { if (bg_cur >= 0) { BGW_DECODE(bg_cur, LAYER) (void)src_; \
        u32x4 w_; w_.x = pk2(bgv[0], bgv[1]); w_.y = pk2(bgv[2], bgv[3]); w_.z = pk2(bgv[4], bgv[5]); w_.w = pk2(bgv[6], bgv[7]); *(u32x4*)dst_ = w_; bg_cur = -1; } } while (0)

__global__ void __launch_bounds__(512, 2) fwd_kernel(Args args) {
    extern __shared__ __attribute__((aligned(16))) unsigned char lds_raw[];
    LAS unsigned char* lds = (LAS unsigned char*)lds_raw;
    const int tid0 = threadIdx.x;
    const int G = gridDim.x, bid = blockIdx.x;
    const int NGW = G * NW;
    unsigned char* ws = args.ws;
    float* MOD = (float*)(ws + WS_MOD);
    float* XC = (float*)(ws + WS_XC);
    bf16* XLb = (bf16*)(ws + WS_BIG + 340 * MiB);
    bf16* Hb = (bf16*)(ws + WS_H);
    bf16* MIX = (bf16*)(ws + WS_MIX);
    unsigned char* BIG = ws + WS_BIG;
    unsigned char* WB = ws + WS_W;
    float* SLAB = (float*)(BIG + 200 * MiB);
    float* T_ABAR = (float*)(ws + WS_TAB); float* T_APOW = (float*)(ws + WS_TAB + 65536); f32x2* T_ROPE = (f32x2*)(ws + WS_TAB + 131072);
    float* T_SPL = (float*)(ws + WS_TAB + 163840);
    float* T_BBR = (float*)(ws + WS_XC); float* T_BBI = (float*)(ws + WS_XC + MiB / 2);
    bf16* T_BBF = (bf16*)(ws + WS_TAB + MiB);
    bf16* T_CF = (bf16*)(ws + WS_TAB + MiB + MiB / 2);

    volatile LAS unsigned* CTLW = (volatile LAS unsigned*)(lds + LDS_CTL_OFF);
    for (int u = tid0; u < (LDS_BYTES - LDS_CTL_OFF) / 4; u += 512) CTLW[u] = 0u;
    __syncthreads();
#if MK_ONE_LAUNCH
    XcdBarrier bar = xcd_barrier_post((unsigned*)(ws + WS_CTL) + 4096, CTLW + 8);
#define SEAM() xcd_barrier(bar)
#else
#define SEAM() do {} while (0)
#endif
    const int lo = args.ph_lo, hi = args.ph_hi;
    int ph = 0;
#define PHASE_BEGIN if (ph >= lo && ph < hi) { int tid = tid0; asm volatile("" : "+v"(tid)); const int lane = tid & 63, wave = __builtin_amdgcn_readfirstlane(tid >> 6), gw = bid * NW + wave; (void)lane; (void)gw;
#define PHASE_END   if (ph + 1 < hi) SEAM(); } ++ph;

    PHASE_BEGIN
    {
        LAS float* sc = (LAS float*)lds;
        LAS float* red = (LAS float*)(lds + 40960);
        if (bid < 96) {
            for (int i = tid; i < 5 * 2048; i += 512) { const int r = i >> 11, k = i & 2047; const float v = r < 4 ? args.in[I_C][r * 2048 + k] : args.in[I_CCTX][k]; sc[i] = siluf_(v); }
            __syncthreads();
            for (int cb = bid; cb < 96; cb += G) {
                const int n0 = cb * 256, layer = n0 / 12288, nn = n0 % 12288;
                const float* W = args.in[I_MODW] + (size_t)layer * 2048 * 12288 + nn + lane * 4;
                float a[5][4];
#pragma unroll
                for (int r = 0; r < 5; ++r)
#pragma unroll
                    for (int j = 0; j < 4; ++j) a[r][j] = 0.f;
                const int kb = wave * 256;
#pragma unroll 8
                for (int k = kb; k < kb + 256; ++k) { const f32x4 w = *(const f32x4*)(W + (size_t)k * 12288);
#pragma unroll
                    for (int r = 0; r < 5; ++r) { const float s = sc[r * 2048 + k];
#pragma unroll
                        for (int j = 0; j < 4; ++j) a[r][j] += s * w[j]; } }
#pragma unroll
                for (int r = 0; r < 5; ++r)
#pragma unroll
                    for (int j = 0; j < 4; ++j) red[(wave * 5 + r) * 256 + lane * 4 + j] = a[r][j];
                __syncthreads();
                for (int i = tid; i < 5 * 256; i += 512) { const int r = i >> 8, cc = i & 255; float s = args.in[I_MODB][layer * 12288 + nn + cc];
#pragma unroll
                    for (int w = 0; w < 8; ++w) s += red[(w * 5 + r) * 256 + cc];
                    MOD[(size_t)(layer * 5 + r) * 12288 + nn + cc] = s; }
                __syncthreads();
            }
        }
        for (int i = bid * 512 + tid; i < 2 * 64 * 64 * 16; i += G * 512) {
            const int s = i & 15, p = (i >> 4) & 63, g = (i >> 10) & 63, d = i >> 16;
            const int ip = (d * 64 + g) * 64 + p;
            const float lre = fminf(args.in[I_LRE][ip], -1e-4f), lim = args.in[I_LIM][ip];
            const float dt = expf(args.in[I_LSTEP][d * 64 + g]);
            const float mag = expf(lre * dt); const float ar = mag * cosf(lim * dt), ai = mag * sinf(lim * dt);
            const float nr = ar - 1.f, ni = ai, den = lre * lre + lim * lim;
            const float cre = (nr * lre + ni * lim) / den, cim = (ni * lre - nr * lim) / den;
            const float br = args.in[I_BRE][(size_t)ip * 16 + s], bi = args.in[I_BIM][(size_t)ip * 16 + s];
            T_BBR[(size_t)ip * 16 + s] = cre * br - cim * bi; T_BBI[(size_t)ip * 16 + s] = cre * bi + cim * br;
            T_BBF[((size_t)(d * 64 + g) * 128 + p) * 16 + s] = (bf16)f2bf(cre * br - cim * bi); T_BBF[((size_t)(d * 64 + g) * 128 + 64 + p) * 16 + s] = (bf16)f2bf(cre * bi + cim * br);
            T_CF[((size_t)(d * 64 + g) * 16 + s) * 128 + p] = (bf16)f2bf(args.in[I_CRE][((size_t)(d * 64 + g) * 16 + s) * 64 + p]); T_CF[((size_t)(d * 64 + g) * 16 + s) * 128 + 64 + p] = (bf16)f2bf(-args.in[I_CIM][((size_t)(d * 64 + g) * 16 + s) * 64 + p]);
            if (s == 0) { T_ABAR[ip * 2] = ar; T_ABAR[ip * 2 + 1] = ai; float pr = ar, pi = ai;
#pragma unroll
                for (int q = 0; q < 6; ++q) { const float tr = pr * pr - pi * pi, ti = 2.f * pr * pi; pr = tr; pi = ti; }
                T_APOW[ip * 2] = pr; T_APOW[ip * 2 + 1] = pi; }
        }
        for (int i = bid * 512 + tid; i < 4096; i += G * 512) { const int p = i >> 6, f = i & 63; const float inv = powf(10000.f, -(float)f / 64.f); const float ang = (float)p * inv;
            f32x2 v; v.x = cosf(ang); v.y = sinf(ang); T_ROPE[i] = v; }
        for (int i = bid * 512 + tid; i < 2048; i += G * 512) T_SPL[i] = -8.f * softplusf_(-args.in[I_LLAM][i]);
        __syncthreads();
        LAS float* scr = (LAS float*)(lds + wave * 16384);
        constexpr int J0 = 32 * 161, J1 = 32 * 64, J2 = 16 * 32, J3 = 32 * 176, J4 = J3, J5 = 88 * 64;
        (void)J3; (void)J4; (void)J5;
        for (int it = gw; it < J0 + J1 + J2; it += NGW) {
            int r = it;
            if (r < J0) { transpose_job(r, args.in[I_EWIN], 2048, 5152, (bf16*)(WB + W_IN), 0, 0, scr, lane); continue; } r -= J0;
            if (r < J1) { transpose_job(r, args.in[I_EWOUT], 2048, 2048, (bf16*)(WB + W_OUT), 0, 0, scr, lane); continue; } r -= J1;
            transpose_job(r, args.in[I_GLUW], 1024, 1024, (bf16*)(WB + W_GLU), 0, 0, scr, lane);
        }
    }
    PHASE_END

#define ADALN(LAYER, WHICH, SRCBF, SRC_L, SRC_C, LATONLY, SLABP, SGATE) \
    for (int R = gw; R < MROWS; R += NGW) { const int b = R / SROW, s = R % SROW; const bool cx = s < CTX; if ((LATONLY) && cx) continue; \
        const float* md = MOD + (size_t)((LAYER) * 5 + (cx ? 4 : b)) * 12288 + (WHICH) * 3 * 2048; \
        const float* gn = args.in[(WHICH) ? I_N2G : I_N1G] + (LAYER) * 2048; \
        f32x4 v[8]; float ss = 0.f; \
        if ((SRCBF) && !cx) { const bf16* srcb = (const bf16*)(SRC_L) + ((size_t)b * SEQ + (s - CTX)) * DM; \
            _Pragma("unroll") for (int j = 0; j < 8; ++j) { const u32x2 w = *(const u32x2*)(srcb + lane * 4 + j * 256); v[j] = (f32x4){lo16(w.x), hi16(w.x), lo16(w.y), hi16(w.y)}; } } \
        else { const float* src = cx ? (SRC_C) + ((size_t)b * CTX + s) * DM : (const float*)(SRC_L) + ((size_t)b * SEQ + (s - CTX)) * DM; \
            _Pragma("unroll") for (int j = 0; j < 8; ++j) v[j] = *(const f32x4*)(src + lane * 4 + j * 256); } \
        if ((SLABP) != nullptr && cx) { const size_t crow = (size_t)b * CTX + s; \
            _Pragma("unroll") for (int j = 0; j < 8; ++j) { const int c = lane * 4 + j * 256; f32x4 a = (f32x4){0.f, 0.f, 0.f, 0.f}; \
                _Pragma("unroll") for (int sp = 0; sp < 8; ++sp) a += *(const f32x4*)((SLABP) + ((size_t)sp * 1024 + crow) * DM + c); \
                v[j] = v[j] + *(const f32x4*)((SGATE) + c) * a; *(f32x4*)(XC + crow * DM + c) = v[j]; } } \
        _Pragma("unroll") for (int j = 0; j < 8; ++j) ss += (v[j][0] * v[j][0] + v[j][1] * v[j][1]) + (v[j][2] * v[j][2] + v[j][3] * v[j][3]); \
        const float rstd = __builtin_amdgcn_rsqf(wave_sum(ss) * (1.f / DM) + EPS); \
        _Pragma("unroll") for (int j = 0; j < 8; ++j) { const int c = lane * 4 + j * 256; const f32x4 gg = *(const f32x4*)(gn + c), sh = *(const f32x4*)(md + c), sl = *(const f32x4*)(md + 2048 + c); \
            const f32x4 o = v[j] * rstd * gg * (sl + 1.f) + sh; u32x2 w; w.x = pk2(o[0], o[1]); w.y = pk2(o[2], o[3]); *(u32x2*)(Hb + (size_t)R * DM + c) = w; } }

    PHASE_BEGIN
    ADALN(0, 0, false, args.in[I_X], args.in[I_CTX], false, (const float*)nullptr, (const float*)nullptr)
    PHASE_END

    PHASE_BEGIN
    { pg8::Gemm g{Hb, (const bf16*)(WB + W_IN), DM, DM, DM}; pg8::StaticOrder S; S.init(68, 21, G, bid, 0);
      EpiIn0 E{(bf16*)(BIG + B_IN0), (float*)(BIG + B_AB)};
      pg8::gemm_phase<EpiIn0>(lds, g, S, E); }
    PHASE_END

#define S5_PASS(READOUT) { \
        const bf16* IN0 = (const bf16*)(BIG + B_IN0); \
        LAS float* BU = (LAS float*)(lds + wave * 12800); LAS unsigned char* HB = lds + wave * 12800 + 8448; \
        const int r = lane & 15, q = lane >> 4; \
        const int NU = (READOUT) ? NB * 64 * NCH : NB * 64 * 2 * NCH; \
        for (int unit = gw; unit < NU; unit += NGW) { \
            const int g = unit & 63; int rest = unit >> 6; int dsel = 0; if (!(READOUT)) { dsel = rest & 1; rest >>= 1; } const int c = rest % NCH, b = rest / NCH;     \
            const int R0 = b * SROW + c * 64; \
            bf16x8 Uf[4]; \
            _Pragma("unroll") for (int tt = 0; tt < 4; ++tt) { Uf[tt] = (bf16x8){0, 0, 0, 0, 0, 0, 0, 0}; if (q < 2) Uf[tt] = *(const bf16x8*)(IN0 + (size_t)(R0 + 16 * tt + r) * IN0_LD + g * 16 + 8 * q); } \
            f32x4 Y[4]; \
            _Pragma("unroll") for (int tt = 0; tt < 4; ++tt) Y[tt] = (f32x4){0.f, 0.f, 0.f, 0.f}; \
            for (int dd = 0; dd < ((READOUT) ? 2 : 1); ++dd) { \
                const int dir = (READOUT) ? dd : dsel; \
                bf16x8 Bf[8], Cf[4]; \
                _Pragma("unroll") for (int pt = 0; pt < 8; ++pt) { Bf[pt] = (bf16x8){0, 0, 0, 0, 0, 0, 0, 0}; if (q < 2) Bf[pt] = *(const bf16x8*)(T_BBF + ((size_t)(dir * 64 + g) * 128 + 16 * pt + r) * 16 + 8 * q); } \
                if (READOUT) { _Pragma("unroll") for (int ks = 0; ks < 4; ++ks) Cf[ks] = *(const bf16x8*)(T_CF + ((size_t)(dir * 64 + g) * 16 + r) * 128 + 32 * ks + 8 * q); } \
                const int ip = (dir * 64 + g) * 64 + lane; \
                const float ar = T_ABAR[ip * 2], ai = T_ABAR[ip * 2 + 1]; \
                float hr = 0.f, hi = 0.f; \
                if (READOUT) { const float* st = (const float*)(BIG + B_S5S) + ((((size_t)(b * 64 + g) * 2 + dir) * NCH + c) * 64 + lane) * 2; hr = st[0]; hi = st[1]; } \
                for (int ti = 0; ti < 4; ++ti) { const int tt = dir ? 3 - ti : ti; \
                    _Pragma("unroll") for (int pt = 0; pt < 8; ++pt) { const f32x4 cc = MFMA16(Uf[tt], Bf[pt], ((f32x4){0.f, 0.f, 0.f, 0.f})); \
                        _Pragma("unroll") for (int jj = 0; jj < 4; ++jj) BU[(4 * q + jj) * 132 + 16 * pt + r] = cc[jj]; } \
                    LDS_WAIT(); \
                    _Pragma("unroll") for (int i = 0; i < 16; ++i) { const int tl = dir ? 15 - i : i; \
                        const float bur = BU[tl * 132 + lane], bui = BU[tl * 132 + 64 + lane]; \
                        const float nr = ar * hr - ai * hi + bur, ni = ar * hi + ai * hr + bui; hr = nr; hi = ni; \
                        if (READOUT) { *(LAS bf16*)(HB + tl * 272 + lane * 2) = (bf16)f2bf(hr); *(LAS bf16*)(HB + tl * 272 + 128 + lane * 2) = (bf16)f2bf(hi); } } \
                    if (READOUT) { LDS_WAIT(); \
                        _Pragma("unroll") for (int ks = 0; ks < 4; ++ks) Y[tt] = MFMA16(frag_rows(HB, 272, 0, 32 * ks, r, q), Cf[ks], Y[tt]); } \
                    LDS_WAIT(); \
                } \
                if (!(READOUT)) { float* e = (float*)(BIG + B_S5E) + ((((size_t)(b * 64 + g) * 2 + dir) * NCH + c) * 64 + lane) * 2; e[0] = hr; e[1] = hi; } \
            } \
            if (READOUT) { const float dsk = args.in[I_S5D][g * 16 + r]; \
                _Pragma("unroll") for (int tt = 0; tt < 4; ++tt) \
                    _Pragma("unroll") for (int jj = 0; jj < 4; ++jj) { const size_t R = (size_t)(R0 + 16 * tt + 4 * q + jj); const float uu = bf2f(IN0[R * IN0_LD + g * 16 + r]); \
                        ((bf16*)(BIG + B_S5Y))[R * 1024 + g * 16 + r] = (bf16)f2bf(gelu_tanh(Y[tt][jj] + dsk * uu)); } } \
        } }

#define S5_ENDSTATE() { \
        const bf16* IN0 = (const bf16*)(BIG + B_IN0); \
        LAS float* ubuf = (LAS float*)(lds + wave * 4096); \
        for (int unit = gw; unit < NB * 64 * 2 * NCH; unit += NGW) { \
            const int g = unit & 63; int rest = unit >> 6; const int dir = rest & 1; rest >>= 1; const int c = rest % NCH, b = rest / NCH; \
            const int R0 = b * SROW + c * 64; \
            { const u32x4* up = (const u32x4*)(IN0 + (size_t)(R0 + lane) * IN0_LD + g * 16); const u32x4 w0 = up[0], w1 = up[1]; \
              *(LAS f32x4*)(ubuf + lane * 16) = (f32x4){lo16(w0.x), hi16(w0.x), lo16(w0.y), hi16(w0.y)}; *(LAS f32x4*)(ubuf + lane * 16 + 4) = (f32x4){lo16(w0.z), hi16(w0.z), lo16(w0.w), hi16(w0.w)}; \
              *(LAS f32x4*)(ubuf + lane * 16 + 8) = (f32x4){lo16(w1.x), hi16(w1.x), lo16(w1.y), hi16(w1.y)}; *(LAS f32x4*)(ubuf + lane * 16 + 12) = (f32x4){lo16(w1.z), hi16(w1.z), lo16(w1.w), hi16(w1.w)}; } \
            const int ip = (dir * 64 + g) * 64 + lane; \
            f32x2 cB[16]; \
            _Pragma("unroll") for (int q = 0; q < 4; ++q) { const f32x4 x = *(const f32x4*)(T_BBR + (size_t)ip * 16 + 4 * q), y = *(const f32x4*)(T_BBI + (size_t)ip * 16 + 4 * q); \
                _Pragma("unroll") for (int j = 0; j < 4; ++j) cB[4 * q + j] = (f32x2){x[j], y[j]}; } \
            const float ar = T_ABAR[ip * 2], ai = T_ABAR[ip * 2 + 1]; \
            float hr = 0.f, hi = 0.f; \
            LDS_WAIT(); \
            _Pragma("unroll 4") for (int ti = 0; ti < 64; ++ti) { const int t = dir ? 63 - ti : ti; \
                f32x2 bu0 = (f32x2){0.f, 0.f}, bu1 = (f32x2){0.f, 0.f}; \
                _Pragma("unroll") for (int q = 0; q < 4; ++q) { const f32x4 uu = *(const LAS f32x4*)(ubuf + t * 16 + 4 * q); \
                    bu0 = __builtin_elementwise_fma(cB[4 * q], (f32x2){uu[0], uu[0]}, bu0); bu1 = __builtin_elementwise_fma(cB[4 * q + 1], (f32x2){uu[1], uu[1]}, bu1); \
                    bu0 = __builtin_elementwise_fma(cB[4 * q + 2], (f32x2){uu[2], uu[2]}, bu0); bu1 = __builtin_elementwise_fma(cB[4 * q + 3], (f32x2){uu[3], uu[3]}, bu1); } \
                const f32x2 bu = bu0 + bu1; \
                const float nr = ar * hr - ai * hi + bu[0], ni = ar * hi + ai * hr + bu[1]; hr = nr; hi = ni; } \
            { float* e = (float*)(BIG + B_S5E) + ((((size_t)(b * 64 + g) * 2 + dir) * NCH + c) * 64 + lane) * 2; e[0] = hr; e[1] = hi; } \
            LDS_WAIT(); \
        } }

    PHASE_BEGIN
    for (int stg_ = 0; stg_ < 2; ++stg_) {
    if ((stg_ == 0) == (wave < 4)) {
    S5_ENDSTATE()
    } else {
        const bf16* IN0 = (const bf16*)(BIG + B_IN0); const float* AB = (const float*)(BIG + B_AB);
        bf16* DQ = (bf16*)(BIG + B_DNQ); bf16* DK = (bf16*)(BIG + B_DNK); bf16* DV = (bf16*)(BIG + B_DNV);
        float* DG = (float*)(BIG + B_DNG); float* DBt = (float*)(BIG + B_DNB);
        const float* cw = args.in[I_DNCW];
        int cur_combo = -1; f32x4 wv[8];
        for (int item = gw; item < MROWS * 6; item += NGW) {
            const int combo = item / MROWS, R = item - combo * MROWS, part = combo >> 1, hq = combo & 1;
            const int b = R / SROW, sx = R - b * SROW;
            const int seg_lo = sx < CTX ? 0 : CTX, seg_hi = sx < CTX ? CTX : SROW;
            const int cidx = part * 1024 + hq * 512 + lane * 8;
            if (combo != cur_combo) { cur_combo = combo;
#pragma unroll
                for (int e = 0; e < 8; ++e) wv[e] = *(const f32x4*)(cw + (size_t)(cidx + e) * 4); }
            float acc[8];
#pragma unroll
            for (int e = 0; e < 8; ++e) acc[e] = 0.f;
#pragma unroll
            for (int j = 0; j < 4; ++j) { const int sj = sx + j - 2;
                if (sj >= seg_lo && sj < seg_hi) { const u32x4 w = *(const u32x4*)(IN0 + (size_t)(b * SROW + sj) * IN0_LD + 1024 + cidx);
                    acc[0] += wv[0][j] * lo16(w.x); acc[1] += wv[1][j] * hi16(w.x); acc[2] += wv[2][j] * lo16(w.y); acc[3] += wv[3][j] * hi16(w.y);
                    acc[4] += wv[4][j] * lo16(w.z); acc[5] += wv[5][j] * hi16(w.z); acc[6] += wv[6][j] * lo16(w.w); acc[7] += wv[7][j] * hi16(w.w); } }
            float ss = 0.f;
#pragma unroll
            for (int e = 0; e < 8; ++e) { acc[e] = acc[e] * __builtin_amdgcn_rcpf(1.f + __expf(-acc[e])); ss += acc[e] * acc[e]; }
            ss += __shfl_xor(ss, 1); ss += __shfl_xor(ss, 2); ss += __shfl_xor(ss, 4); ss += __shfl_xor(ss, 8);
            const float sc = part == 0 ? 0.08838834764831845f * __builtin_amdgcn_rsqf(ss + EPS) : (part == 1 ? __builtin_amdgcn_rsqf(ss + EPS) : 1.f);
            u32x4 o; o.x = pk2(acc[0] * sc, acc[1] * sc); o.y = pk2(acc[2] * sc, acc[3] * sc); o.z = pk2(acc[4] * sc, acc[5] * sc); o.w = pk2(acc[6] * sc, acc[7] * sc);
            bf16* dst = part == 0 ? DQ : (part == 1 ? DK : DV);
            *(u32x4*)(dst + (size_t)R * 1024 + hq * 512 + lane * 8) = o;
        }
        for (int i = bid * 512 + tid; i < MROWS * 16; i += G * 512) { const int R = i >> 4, l16 = i & 15;
            const float araw = AB[(size_t)R * 32 + l16], braw = AB[(size_t)R * 32 + 16 + l16];
            DG[i] = -expf(args.in[I_DNALOG][l16]) * softplusf_(araw + args.in[I_DNDT][l16]);
            DBt[i] = sigmoidf_(braw); }
    }
    }
    PHASE_END

    PHASE_BEGIN
    {
        for (int i = bid * 512 + tid; i < NB * 64 * 2 * 64; i += G * 512) {
            const int p = i & 63, dir = (i >> 6) & 1, bg = i >> 7, g = bg & 63;
            const int ip = (dir * 64 + g) * 64 + p; const float pr = T_APOW[ip * 2], pi = T_APOW[ip * 2 + 1];
            const float* E = (const float*)(BIG + B_S5E) + ((size_t)(bg * 2 + dir) * NCH) * 128 + p * 2;
            float* St = (float*)(BIG + B_S5S) + ((size_t)(bg * 2 + dir) * NCH) * 128 + p * 2;
            float sr = 0.f, si = 0.f;
            for (int k = 0; k < NCH; ++k) { const int c = dir == 0 ? k : (k < 4 ? 3 - k : 71 - k);
                St[c * 128] = sr; St[c * 128 + 1] = si; const float er = E[c * 128], ei = E[c * 128 + 1];
                const float nr = pr * sr - pi * si + er, ni = pr * si + pi * sr + ei; sr = nr; si = ni; }
        }
        {
            const bf16* DK = (const bf16*)(BIG + B_DNK); const float* DG = (const float*)(BIG + B_DNG); const float* DBt = (const float*)(BIG + B_DNB);
            bf16* TINV = (bf16*)((unsigned char*)MIX + MIX_TINV); bf16* WT = Hb; float* GCUM = (float*)(BIG + B_GCUM);
            constexpr int KC = 0, KB = 17408, KG = 34816, PA = 52224, PB = 61440, TA = 70656, TB = 79872, LO = 36864, WSo = 0  , GCo = 125952, BTo = 126208, RS = 272, PS = 144;
            const int r = lane & 15, q = lane >> 4, qq = r >> 2, pp = r & 3, it = wave >> 1, nh = wave & 1;
            LAS float* GC = (LAS float*)(lds + GCo); LAS float* BT = (LAS float*)(lds + BTo);
#define DN_ROW(n, row) ((size_t)b * SROW + (dir == 0 ? ((n) * 64 + (row)) : (((n) * 64 + (row)) < CTX ? CTX - 1 - ((n) * 64 + (row)) : SROW + CTX - 1 - ((n) * 64 + (row)))))
            for (int i = tid; i < 36864 / 4; i += 512) { ((LAS unsigned*)(lds + PA))[i] = 0u; ((LAS unsigned*)(lds + PA + LO))[i] = 0u; }
            __syncthreads();
            for (int unit = bid; unit < NB * 8 * 2 * NCH; unit += G) {
                const int n = unit % NCH; int rest = unit / NCH; const int dir = rest & 1; rest >>= 1; const int h = rest & 7, b = rest >> 3;
                u32x4 kreg[2];
#pragma unroll
                for (int k = 0; k < 2; ++k) { const int id = tid + 512 * k, row = id >> 4, cp = id & 15; kreg[k] = *(const u32x4*)(DK + DN_ROW(n, row) * 1024 + h * 128 + cp * 8); }
                if (wave == 0) { const size_t R = DN_ROW(n, lane); float g = DG[R * 16 + dir * 8 + h]; const float bt = DBt[R * 16 + dir * 8 + h];
#pragma unroll
                    for (int o = 1; o < 64; o <<= 1) { const float t = __shfl_up(g, o); if (lane >= o) g += t; }
                    GC[lane] = g; BT[lane] = bt; GCUM[(size_t)unit * 64 + lane] = g; }
                __syncthreads();
#pragma unroll
                for (int k = 0; k < 2; ++k) { const int id = tid + 512 * k, row = id >> 4, cp = id & 15; const float bt = BT[row], bg = bt * __expf(GC[row]);
                    const u32x4 w = kreg[k];
                    *(LAS u32x4*)(lds + KC + row * RS + cp * 16) = w;
                    u32x4 x; x.x = pk2(lo16(w.x) * bt, hi16(w.x) * bt); x.y = pk2(lo16(w.y) * bt, hi16(w.y) * bt); x.z = pk2(lo16(w.z) * bt, hi16(w.z) * bt); x.w = pk2(lo16(w.w) * bt, hi16(w.w) * bt);
                    *(LAS u32x4*)(lds + KB + row * RS + cp * 16) = x;
                    x.x = pk2(lo16(w.x) * bg, hi16(w.x) * bg); x.y = pk2(lo16(w.y) * bg, hi16(w.y) * bg); x.z = pk2(lo16(w.z) * bg, hi16(w.z) * bg); x.w = pk2(lo16(w.w) * bg, hi16(w.w) * bg);
                    *(LAS u32x4*)(lds + KG + row * RS + cp * 16) = x; }
                __syncthreads();
#pragma unroll
                for (int e = 0; e < 2; ++e) { const int jt = 2 * nh + e; f32x4 c = (f32x4){0.f, 0.f, 0.f, 0.f};
                    if (jt <= it) {
#pragma unroll
                        for (int ks = 0; ks < 4; ++ks) c = MFMA16(frag_rows(lds + KC, RS, 16 * jt, 32 * ks, r, q), frag_rows(lds + KB, RS, 16 * it, 32 * ks, r, q), c);
                        const float gi = GC[16 * it + r]; const f32x4 gj = *(const LAS f32x4*)(GC + 16 * jt + 4 * q);
#pragma unroll
                        for (int jj = 0; jj < 4; ++jj) c[jj] = (16 * jt + 4 * q + jj < 16 * it + r) ? -c[jj] * __expf(gi - gj[jj]) : 0.f; }
                    st_hl(lds + PA + (16 * it + r) * PS + (16 * jt + 4 * q) * 2, LO, c);
                    if (jt == it) {
#pragma unroll
                        for (int jj = 0; jj < 4; ++jj) if (4 * q + jj == r) c[jj] = 1.f; }
                    st_hl(lds + TA + (16 * it + r) * PS + (16 * jt + 4 * q) * 2, LO, c); }
                __syncthreads();
#pragma unroll
                for (int st = 1; st <= 6; ++st) {
                    LAS unsigned char* Pc = lds + ((st & 1) ? PA : PB); LAS unsigned char* Pn = lds + ((st & 1) ? PB : PA);
                    LAS unsigned char* Tc = lds + ((st & 1) ? TB : TA); LAS unsigned char* Tn = lds + ((st & 1) ? TA : TB);
                    if (st == 1) { Tc = lds + TA; }
                    f32x4 cP[2], cT[2];
#pragma unroll
                    for (int e = 0; e < 2; ++e) { const int nt = 2 * nh + e; cP[e] = (f32x4){0.f, 0.f, 0.f, 0.f}; cT[e] = (f32x4){0.f, 0.f, 0.f, 0.f};
                        if (st >= 2) { const u32x2 t0 = *(const LAS u32x2*)(Tc + (16 * it + r) * PS + (16 * nt + 4 * q) * 2), t1 = *(const LAS u32x2*)(Tc + LO + (16 * it + r) * PS + (16 * nt + 4 * q) * 2);
                            cT[e] = (f32x4){lo16(t0.x) + lo16(t1.x), hi16(t0.x) + hi16(t1.x), lo16(t0.y) + lo16(t1.y), hi16(t0.y) + hi16(t1.y)}; } }
                    {
#pragma unroll
                        for (int kb = 0; kb < 2; ++kb) {
                            bf16x8 rPh, rPl, rTh, rTl;
                            if (st <= 5) { rPh = frag_rows(Pc, PS, 16 * it, 32 * kb, r, q); rPl = frag_rows(Pc + LO, PS, 16 * it, 32 * kb, r, q); }
                            if (st >= 2) { rTh = frag_rows(Tc, PS, 16 * it, 32 * kb, r, q); rTl = frag_rows(Tc + LO, PS, 16 * it, 32 * kb, r, q); }
#pragma unroll
                            for (int e = 0; e < 2; ++e) { const int nt = 2 * nh + e;
                                { const bf16x8 th = frag_tr(Pc, PS, 32 * kb, 16 * nt, q, qq, pp), tl = frag_tr(Pc + LO, PS, 32 * kb, 16 * nt, q, qq, pp);
                                    if (st <= 5) cP[e] = mm3(cP[e], th, tl, rPh, rPl);
                                    if (st >= 2) cT[e] = mm3(cT[e], th, tl, rTh, rTl); } }
                        }
#pragma unroll
                        for (int e = 0; e < 2; ++e) { const int nt = 2 * nh + e;
                            { if (st <= 5) st_hl(Pn + (16 * it + r) * PS + (16 * nt + 4 * q) * 2, LO, cP[e]);
                                if (st >= 2) st_hl(Tn + (16 * it + r) * PS + (16 * nt + 4 * q) * 2, LO, cT[e]); } }
                    }
                    __syncthreads();
                }
#pragma unroll
                for (int e = 0; e < 4; ++e) { const int nt = 4 * nh + e; f32x4 c = (f32x4){0.f, 0.f, 0.f, 0.f};
#pragma unroll
                    for (int kb = 0; kb < 2; ++kb) c = MFMA16(frag_tr(lds + KG, RS, 32 * kb, 16 * nt, q, qq, pp), frag_rows(lds + TB, PS, 16 * it, 32 * kb, r, q), c);
                    u32x2 w; w.x = pk2(-c[0], -c[1]); w.y = pk2(-c[2], -c[3]); *(LAS u32x2*)(lds + WSo + (16 * it + r) * RS + (16 * nt + 4 * q) * 2) = w; }
                __syncthreads();
#pragma unroll
                for (int k = 0; k < 2; ++k) { const int id = tid + 512 * k, row = id >> 4, cp = id & 15; *(u32x4*)(WT + ((size_t)unit * 64 + row) * 128 + cp * 8) = *(const LAS u32x4*)(lds + WSo + row * RS + cp * 16); }
                { const int row = tid >> 3, cp = tid & 7; *(u32x4*)(TINV + ((size_t)unit * 64 + row) * 64 + cp * 8) = *(const LAS u32x4*)(lds + TB + row * PS + cp * 16); }
            }
        }
    }
    PHASE_END

    PHASE_BEGIN
    {
        const bf16* DQ = (const bf16*)(BIG + B_DNQ); const bf16* DK = (const bf16*)(BIG + B_DNK); const bf16* DV = (const bf16*)(BIG + B_DNV);
        const float* DBt = (const float*)(BIG + B_DNB); const bf16* TINV = (const bf16*)((unsigned char*)MIX + MIX_TINV); const bf16* WT = Hb; const float* GCUM = (const float*)(BIG + B_GCUM);
        constexpr int QC0 = 0, KC0 = 17408, QC1 = 34816, KC1 = 52224, WC = 69632, TI = 87040, VB = 96256, VN = 101376, VD = 105984, ST0 = 110592, ST1 = 119296, GS0 = 128000, GS1 = 128768, RS = 272, PS = 144, VBS = 80;
        const int r = lane & 15, q = lane >> 4, qq = r >> 2, pp = r & 3, it = wave >> 1, ct = wave & 1;
        for (int unit0 = bid; unit0 < NB * 8 * 2 * 4; unit0 += G) {
            const int unit = (unit0 & 7) * 32 + (unit0 >> 3);
            const int sl = unit & 3, dir = (unit >> 2) & 1, h = (unit >> 3) & 7, b = unit >> 6;
            const size_t ubase = (size_t)((b * 8 + h) * 2 + dir) * NCH;
            bf16* DO = (bf16*)(BIG + (dir ? B_DNO1 : B_DNO0));
            f32x4 Sacc[2] = {(f32x4){0.f, 0.f, 0.f, 0.f}, (f32x4){0.f, 0.f, 0.f, 0.f}};
            u32x4 rq[2], rk[2], rw[2], rt, rv; float rbeta = 0.f, rgc = 0.f;
#define DNB_LOAD(n) do { _Pragma("unroll") for (int k = 0; k < 2; ++k) { const int id = tid + 512 * k, row = id >> 4, cp = id & 15; const size_t R = DN_ROW(n, row); \
                    rq[k] = *(const u32x4*)(DQ + R * 1024 + h * 128 + cp * 8); rk[k] = *(const u32x4*)(DK + R * 1024 + h * 128 + cp * 8); \
                    rw[k] = *(const u32x4*)(WT + ((ubase + (n)) * 64 + row) * 128 + cp * 8); } \
                { const int row = tid >> 3, cp = tid & 7; rt = *(const u32x4*)(TINV + ((ubase + (n)) * 64 + row) * 64 + cp * 8); } \
                if (tid < 256) { const int row = tid >> 2, cp = tid & 3; const size_t R = DN_ROW(n, row); rv = *(const u32x4*)(DV + R * 1024 + h * 128 + sl * 32 + cp * 8); rbeta = DBt[R * 16 + dir * 8 + h]; } \
                if (tid < 64) rgc = GCUM[(ubase + (n)) * 64 + tid]; } while (0)
#define DNB_STAGE(QCo, KCo, GSo) do { _Pragma("unroll") for (int k = 0; k < 2; ++k) { const int id = tid + 512 * k, row = id >> 4, cp = id & 15; \
                    *(LAS u32x4*)(lds + (QCo) + row * RS + cp * 16) = rq[k]; *(LAS u32x4*)(lds + (KCo) + row * RS + cp * 16) = rk[k]; *(LAS u32x4*)(lds + WC + row * RS + cp * 16) = rw[k]; } \
                { const int row = tid >> 3, cp = tid & 7; *(LAS u32x4*)(lds + TI + row * PS + cp * 16) = rt; } \
                if (tid < 256) { const int row = tid >> 2, cp = tid & 3; u32x4 x; x.x = pk2(lo16(rv.x) * rbeta, hi16(rv.x) * rbeta); x.y = pk2(lo16(rv.y) * rbeta, hi16(rv.y) * rbeta); \
                    x.z = pk2(lo16(rv.z) * rbeta, hi16(rv.z) * rbeta); x.w = pk2(lo16(rv.w) * rbeta, hi16(rv.w) * rbeta); *(LAS u32x4*)(lds + VB + row * VBS + cp * 16) = x; } \
                if (tid < 64) { const float gl = __shfl(rgc, 63); LAS float* gs = (LAS float*)(lds + (GSo)); gs[tid] = rgc; gs[64 + tid] = __expf(rgc); gs[128 + tid] = __expf(gl - rgc); } } while (0)
            for (int i = tid; i < 8704 / 4; i += 512) ((LAS unsigned*)(lds + ST0))[i] = 0u;
            DNB_LOAD(0);
            DNB_STAGE(QC0, KC0, GS0);
            if (NCH > 1) DNB_LOAD(1);
            __syncthreads();
            float bgv[8]; int bg_cur = -1; int bg_it = gw;
            for (int n = 0; n < NCH; ++n) {
                BGW_STORE(0); BGW_ISSUE(bg_it, 0); bg_it += NGW;
                LAS unsigned char* QC = lds + ((n & 1) ? QC1 : QC0); LAS unsigned char* KC = lds + ((n & 1) ? KC1 : KC0);
                LAS float* GS = (LAS float*)(lds + ((n & 1) ? GS1 : GS0));
                LAS unsigned char* STc = lds + ((n & 1) ? ST1 : ST0); LAS unsigned char* STn = lds + ((n & 1) ? ST0 : ST1);
                { f32x4 c = (f32x4){0.f, 0.f, 0.f, 0.f};
#pragma unroll
                  for (int kb = 0; kb < 2; ++kb) c = MFMA16(frag_rows(lds + TI, PS, 16 * it, 32 * kb, r, q), frag_tr(lds + VB, VBS, 32 * kb, 16 * ct, q, qq, pp), c);
#pragma unroll
                  for (int ks = 0; ks < 4; ++ks) c = MFMA16(frag_rows(lds + WC, RS, 16 * it, 32 * ks, r, q), frag_rows(STc, RS, 16 * ct, 32 * ks, r, q), c);
                  const f32x4 ed = *(const LAS f32x4*)(GS + 128 + 16 * it + 4 * q);
                  u32x2 w; w.x = pk2(c[0], c[1]); w.y = pk2(c[2], c[3]); *(LAS u32x2*)(lds + VN + (16 * ct + r) * PS + (16 * it + 4 * q) * 2) = w;
                  w.x = pk2(c[0] * ed[0], c[1] * ed[1]); w.y = pk2(c[2] * ed[2], c[3] * ed[3]); *(LAS u32x2*)(lds + VD + (16 * ct + r) * PS + (16 * it + 4 * q) * 2) = w; }
                __syncthreads();
                if (n + 1 < NCH) { if (n & 1) DNB_STAGE(QC0, KC0, GS0); else DNB_STAGE(QC1, KC1, GS1); }
                if (n + 2 < NCH) DNB_LOAD(n + 2);
                { const float egl = GS[64 + 63];
#pragma unroll
                  for (int e = 0; e < 2; ++e) { f32x4 c = Sacc[e] * egl;
#pragma unroll
                      for (int kb = 0; kb < 2; ++kb) c = MFMA16(frag_tr(KC, RS, 32 * kb, 16 * wave, q, qq, pp), frag_rows(lds + VD, PS, 16 * e, 32 * kb, r, q), c);
                      Sacc[e] = c;
                      u32x2 w; w.x = pk2(c[0], c[1]); w.y = pk2(c[2], c[3]); *(LAS u32x2*)(STn + (16 * e + r) * RS + (16 * wave + 4 * q) * 2) = w; } }
                { f32x4 o = (f32x4){0.f, 0.f, 0.f, 0.f};
                  bf16x8 Qf[4];
#pragma unroll
                  for (int ks = 0; ks < 4; ++ks) Qf[ks] = frag_rows(QC, RS, 16 * it, 32 * ks, r, q);
#pragma unroll
                  for (int ks = 0; ks < 4; ++ks) o = MFMA16(Qf[ks], frag_rows(STc, RS, 16 * ct, 32 * ks, r, q), o);
                  { const f32x4 eg = *(const LAS f32x4*)(GS + 64 + 16 * it + 4 * q); o = o * eg; }
                  const float gi = GS[16 * it + r];
#pragma unroll
                  for (int kp = 0; kp < 2; ++kp) {
                      if (2 * kp <= it) { f32x4 pt[2];
#pragma unroll
                          for (int e = 0; e < 2; ++e) { const int jt = 2 * kp + e; f32x4 c = (f32x4){0.f, 0.f, 0.f, 0.f};
                              if (jt <= it) {
#pragma unroll
                                  for (int ks = 0; ks < 4; ++ks) c = MFMA16(frag_rows(KC, RS, 16 * jt, 32 * ks, r, q), Qf[ks], c);
                                  const f32x4 gj = *(const LAS f32x4*)(GS + 16 * jt + 4 * q);
#pragma unroll
                                  for (int jj = 0; jj < 4; ++jj) c[jj] = (16 * jt + 4 * q + jj <= 16 * it + r) ? c[jj] * __expf(gi - gj[jj]) : 0.f; }
                              pt[e] = c; }
                          o = MFMA16(pack_pair(pt[0], pt[1]), frag_rows_perm(lds + VN, PS, 16 * ct, 32 * kp, r, q), o); }
                  }
#pragma unroll
                  for (int jj = 0; jj < 4; ++jj) { const size_t R = DN_ROW(n, 16 * it + 4 * q + jj); DO[R * 1024 + h * 128 + sl * 32 + 16 * ct + r] = (bf16)f2bf(o[jj]); } }
                __syncthreads();
            }
            BGW_STORE(0);
            for (; bg_it < BGW_ITEMS; bg_it += NGW) { BGW_ISSUE(bg_it, 0); BGW_STORE(0); }
        }
#undef DNB_LOAD
#undef DNB_STAGE
    }
    S5_PASS(true)
    PHASE_END

    PHASE_BEGIN
    {
        const bf16* O0 = (const bf16*)(BIG + B_DNO0); const bf16* O1 = (const bf16*)(BIG + B_DNO1); const bf16* IN0 = (const bf16*)(BIG + B_IN0);
        const f32x4 g0 = *(const f32x4*)(args.in[I_DNNG] + (lane & 15) * 8), g1 = *(const f32x4*)(args.in[I_DNNG] + (lane & 15) * 8 + 4);
        for (int item = gw; item < MROWS * 2; item += NGW) {
            const int R = item >> 1, hq = item & 1; const size_t o = (size_t)R * 1024 + hq * 512 + lane * 8;
            const u32x4 a = *(const u32x4*)(O0 + o), c = *(const u32x4*)(O1 + o), gt = *(const u32x4*)(IN0 + (size_t)R * IN0_LD + 4096 + hq * 512 + lane * 8);
            float v[8] = {lo16(a.x) + lo16(c.x), hi16(a.x) + hi16(c.x), lo16(a.y) + lo16(c.y), hi16(a.y) + hi16(c.y), lo16(a.z) + lo16(c.z), hi16(a.z) + hi16(c.z), lo16(a.w) + lo16(c.w), hi16(a.w) + hi16(c.w)};
            float ss = 0.f;
#pragma unroll
            for (int e = 0; e < 8; ++e) ss += v[e] * v[e];
            ss += __shfl_xor(ss, 1); ss += __shfl_xor(ss, 2); ss += __shfl_xor(ss, 4); ss += __shfl_xor(ss, 8);
            const float rs = __builtin_amdgcn_rsqf(ss * (1.f / 128.f) + EPS);
            const float gv[8] = {lo16(gt.x), hi16(gt.x), lo16(gt.y), hi16(gt.y), lo16(gt.z), hi16(gt.z), lo16(gt.w), hi16(gt.w)};
            const float ng[8] = {g0[0], g0[1], g0[2], g0[3], g1[0], g1[1], g1[2], g1[3]};
            float y[8];
#pragma unroll
            for (int e = 0; e < 8; ++e) y[e] = v[e] * rs * ng[e] * siluf_(gv[e]);
            u32x4 w; w.x = pk2(y[0], y[1]); w.y = pk2(y[2], y[3]); w.z = pk2(y[4], y[5]); w.w = pk2(y[6], y[7]);
            *(u32x4*)(MIX + (size_t)R * 2048 + 1024 + hq * 512 + lane * 8) = w;
        }
    }
    { pg8::Gemm g{(const bf16*)(BIG + B_S5Y), (const bf16*)(WB + W_GLU), 1024, 1024, 1024}; pg8::StaticOrder S; S.init(68, 4, G, bid, 0);
      EpiGlu E{(const bf16*)(BIG + B_S5Y), MIX, args.in[I_GLUB]};
      pg8::gemm_phase<EpiGlu>(lds, g, S, E); }
    PHASE_END

    PHASE_BEGIN
    { pg8::Gemm g{MIX, (const bf16*)(WB + W_OUT), 2048, 2048, 2048}; pg8::TailOrder<32> S; S.init(G, bid);
      EpiRes<true> E{args.in[I_X], XLb, MOD + 2 * 2048, SLAB};
      pg8::gemm_phase<EpiRes<true>, pg8::TailOrder<32>>(lds, g, S, E); }
    PHASE_END

    PHASE_BEGIN
    ADALN(0, 1, true, XLb, args.in[I_CTX], false, SLAB, MOD + 4 * 12288 + 2 * 2048)
    PHASE_END

    PHASE_BEGIN
    { pg8::Gemm g{Hb, (const bf16*)(WB + W_UP), DM, DM, DM}; pg8::StaticOrder S; S.init(68, 44, G, bid, 0);
      EpiSwiglu E{(bf16*)(BIG + B_G)};
      pg8::gemm_phase<EpiSwiglu>(lds, g, S, E); }
    PHASE_END

    PHASE_BEGIN
    { pg8::Gemm g{(const bf16*)(BIG + B_G), (const bf16*)(WB + W_DN), DFF, DFF, DFF}; pg8::TailOrder<88> S; S.init(G, bid);
      EpiRes<false> E{XLb, XLb, MOD + 5 * 2048, SLAB};
      pg8::gemm_phase<EpiRes<false>, pg8::TailOrder<88>>(lds, g, S, E); }
    PHASE_END

    PHASE_BEGIN
    ADALN(1, 0, true, XLb, XC, false, SLAB, MOD + 4 * 12288 + 5 * 2048)
    {
        LAS float* scr = (LAS float*)(lds + wave * 16384);
        constexpr int J0 = 32 * 256, J1 = 48 * 64, J3 = 32 * 176, J4 = J3, J5 = 88 * 64;
        (void)J3; (void)J4; (void)J5;
        for (int it = gw; it < J0 + J1; it += NGW) {
            int r = it;
            if (r < J0) { transpose_job(r, args.in[I_OWIN], 2048, 8192, (bf16*)(WB + W_IN), 0, 0, scr, lane); continue; } r -= J0;
            transpose_job(r, args.in[I_OWOUT], 3072, 2048, (bf16*)(WB + W_OUT), 0, 0, scr, lane);
        }
        bf16* WG = (bf16*)(WB + W_GLU);
        for (int i = bid * 512 + tid; i < 4096 * 256 / 2; i += G * 512) {
            const int kk = (i & 127) * 2, np = i >> 7; const int e = np & 127, half = (np >> 7) & 1, q = np >> 8, blk = q & 7, dir = q >> 3;
            unsigned w = 0u;
            if ((kk >> 7) == (blk & 1)) { const float* src = args.in[half ? I_LWX : I_LWA] + ((size_t)(dir * 8 + blk) * 128 + (kk & 127)) * 128 + e; w = pk2(src[0], src[128]); }
            *(unsigned*)(WG + (size_t)np * 256 + kk) = w;
        }
    }
    PHASE_END

    PHASE_BEGIN
    { pg8::Gemm g{Hb, (const bf16*)(WB + W_IN), DM, DM, DM}; pg8::StaticOrder S; S.init(68, 8, G, bid, 0);
      EpiPlain E{(bf16*)(BIG + B_INA), 2048};
      pg8::gemm_phase<EpiPlain>(lds, g, S, E); }
    PHASE_END

    PHASE_BEGIN
    {
        const bf16* INA = (const bf16*)(BIG + B_INA); bf16* XCV = (bf16*)(BIG + B_XCV);
        int cur_half = -1; f32x4 wv[8]; float cb[8];
        for (int item = gw; item < MROWS * 2; item += NGW) {
            const int half = item / MROWS, R = item - half * MROWS, b = R / SROW, sx = R - b * SROW;
            const int seg_lo = sx < CTX ? 0 : CTX, seg_hi = sx < CTX ? CTX : SROW;
            const int ch = half * 512 + lane * 8;
            if (half != cur_half) { cur_half = half;
#pragma unroll
                for (int e = 0; e < 8; ++e) { wv[e] = *(const f32x4*)(args.in[I_LCW] + (size_t)(ch + e) * 4); cb[e] = args.in[I_LCB][ch + e]; } }
            float acc[8];
#pragma unroll
            for (int e = 0; e < 8; ++e) acc[e] = cb[e];
#pragma unroll
            for (int j = 0; j < 4; ++j) { const int sj = sx + j - 2;
                if (sj >= seg_lo && sj < seg_hi) { const u32x4 w = *(const u32x4*)(INA + (size_t)(b * SROW + sj) * 2048 + ch);
                    acc[0] += wv[0][j] * lo16(w.x); acc[1] += wv[1][j] * hi16(w.x); acc[2] += wv[2][j] * lo16(w.y); acc[3] += wv[3][j] * hi16(w.y);
                    acc[4] += wv[4][j] * lo16(w.z); acc[5] += wv[5][j] * hi16(w.z); acc[6] += wv[6][j] * lo16(w.w); acc[7] += wv[7][j] * hi16(w.w); } }
            u32x4 o; o.x = pk2(acc[0], acc[1]); o.y = pk2(acc[2], acc[3]); o.z = pk2(acc[4], acc[5]); o.w = pk2(acc[6], acc[7]);
            *(u32x4*)(XCV + (size_t)R * 1024 + ch) = o;
        }
    }
    PHASE_END

    PHASE_BEGIN
    { pg8::Gemm g{(const bf16*)(BIG + B_XCV), (const bf16*)(WB + W_GLU), 1024, 256, 256}; pg8::StaticOrder S; S.init(68, 16, G, bid, 0);
      EpiGate E{(const bf16*)(BIG + B_XCV), (bf16*)(BIG + B_LA), (bf16*)(BIG + B_BB), args.in[I_LBA], args.in[I_LBX], T_SPL};
      pg8::gemm_phase<EpiGate, pg8::StaticOrder, true>(lds, g, S, E); }
    PHASE_END

    PHASE_BEGIN
    {
        const bf16* LA = (const bf16*)(BIG + B_LA); const bf16* BBp = (const bf16*)(BIG + B_BB); float* EP = (float*)(BIG + B_LEP);
        for (int i = bid * 512 + tid; i < NB * 2 * NCH * 128; i += G * 512) {
            const int c8 = i & 127; int rest = i >> 7; const int c = rest % NCH; rest /= NCH; const int dir = rest & 1, b = rest >> 1;
            float P[8], h[8];
#pragma unroll
            for (int e = 0; e < 8; ++e) { P[e] = 1.f; h[e] = 0.f; }
#pragma unroll 4
            for (int ti = 0; ti < 64; ++ti) { const int t = dir ? 63 - ti : ti; const size_t o = ((size_t)(b * SROW + c * 64 + t) * 2 + dir) * 1024 + c8 * 8;
                const u32x4 lw = *(const u32x4*)(LA + o), bw = *(const u32x4*)(BBp + o);
                const float la[8] = {lo16(lw.x), hi16(lw.x), lo16(lw.y), hi16(lw.y), lo16(lw.z), hi16(lw.z), lo16(lw.w), hi16(lw.w)};
                const float bb[8] = {lo16(bw.x), hi16(bw.x), lo16(bw.y), hi16(bw.y), lo16(bw.z), hi16(bw.z), lo16(bw.w), hi16(bw.w)};
#pragma unroll
                for (int e = 0; e < 8; ++e) { const float av = __expf(la[e]); P[e] *= av; h[e] = av * h[e] + bb[e]; } }
            float* ep = EP + ((size_t)((b * 2 + dir) * NCH + c) * 1024 + c8 * 8) * 2;
#pragma unroll
            for (int e = 0; e < 8; e += 2) *(f32x4*)(ep + e * 2) = (f32x4){P[e], h[e], P[e + 1], h[e + 1]};
        }
    }
    PHASE_END

    PHASE_BEGIN
    {
        const float* EP = (const float*)(BIG + B_LEP); float* ST = (float*)(BIG + B_LST);
        for (int i = bid * 512 + tid; i < NB * 2 * 1024; i += G * 512) {
            const int ch = i & 1023, dir = (i >> 10) & 1, b = i >> 11; float s = 0.f;
            for (int k = 0; k < NCH; ++k) { const int c = dir == 0 ? k : (k < 4 ? 3 - k : 71 - k); const size_t o = ((size_t)(b * 2 + dir) * NCH + c) * 1024 + ch;
                ST[o] = s; s = EP[o * 2] * s + EP[o * 2 + 1]; }
        }
    }
    PHASE_END

    PHASE_BEGIN
    {
        const bf16* LA = (const bf16*)(BIG + B_LA); const bf16* BBp = (const bf16*)(BIG + B_BB); const float* ST = (const float*)(BIG + B_LST); const bf16* INA = (const bf16*)(BIG + B_INA);
        for (int u = bid; u < NB * 64; u += G) {
            const int c = 4 + (u & 63), b = u >> 6;
            if (tid < 128) {
                const int ch = tid * 8;
                float h[8];
                { const float* st = ST + ((size_t)(b * 2 + 0) * NCH + c) * 1024 + ch; const f32x4 s0 = *(const f32x4*)st, s1 = *(const f32x4*)(st + 4);
                  h[0] = s0[0]; h[1] = s0[1]; h[2] = s0[2]; h[3] = s0[3]; h[4] = s1[0]; h[5] = s1[1]; h[6] = s1[2]; h[7] = s1[3]; }
#pragma unroll 4
                for (int t = 0; t < 64; ++t) { const size_t o = ((size_t)(b * SROW + c * 64 + t) * 2 + 0) * 1024 + ch;
                    const u32x4 lw = *(const u32x4*)(LA + o), bw = *(const u32x4*)(BBp + o);
                    const float la[8] = {lo16(lw.x), hi16(lw.x), lo16(lw.y), hi16(lw.y), lo16(lw.z), hi16(lw.z), lo16(lw.w), hi16(lw.w)};
                    const float bb[8] = {lo16(bw.x), hi16(bw.x), lo16(bw.y), hi16(bw.y), lo16(bw.z), hi16(bw.z), lo16(bw.w), hi16(bw.w)};
#pragma unroll
                    for (int e = 0; e < 8; ++e) h[e] = __expf(la[e]) * h[e] + bb[e];
                    u32x4 w; w.x = pk2(h[0], h[1]); w.y = pk2(h[2], h[3]); w.z = pk2(h[4], h[5]); w.w = pk2(h[6], h[7]);
                    *(LAS u32x4*)(lds + t * 2048 + tid * 16) = w; }
                { const float* st = ST + ((size_t)(b * 2 + 1) * NCH + c) * 1024 + ch; const f32x4 s0 = *(const f32x4*)st, s1 = *(const f32x4*)(st + 4);
                  h[0] = s0[0]; h[1] = s0[1]; h[2] = s0[2]; h[3] = s0[3]; h[4] = s1[0]; h[5] = s1[1]; h[6] = s1[2]; h[7] = s1[3]; }
#pragma unroll 4
                for (int t = 63; t >= 0; --t) { const size_t R = (size_t)(b * SROW + c * 64 + t); const size_t o = (R * 2 + 1) * 1024 + ch;
                    const u32x4 lw = *(const u32x4*)(LA + o), bw = *(const u32x4*)(BBp + o), gw4 = *(const u32x4*)(INA + R * 2048 + 1024 + ch);
                    const u32x4 fw = *(const LAS u32x4*)(lds + t * 2048 + tid * 16);
                    const float la[8] = {lo16(lw.x), hi16(lw.x), lo16(lw.y), hi16(lw.y), lo16(lw.z), hi16(lw.z), lo16(lw.w), hi16(lw.w)};
                    const float bb[8] = {lo16(bw.x), hi16(bw.x), lo16(bw.y), hi16(bw.y), lo16(bw.z), hi16(bw.z), lo16(bw.w), hi16(bw.w)};
                    const float gt[8] = {lo16(gw4.x), hi16(gw4.x), lo16(gw4.y), hi16(gw4.y), lo16(gw4.z), hi16(gw4.z), lo16(gw4.w), hi16(gw4.w)};
                    const float hf[8] = {lo16(fw.x), hi16(fw.x), lo16(fw.y), hi16(fw.y), lo16(fw.z), hi16(fw.z), lo16(fw.w), hi16(fw.w)};
                    float y[8];
#pragma unroll
                    for (int e = 0; e < 8; ++e) { h[e] = __expf(la[e]) * h[e] + bb[e]; y[e] = (hf[e] + h[e]) * gelu_tanh(gt[e]); }
                    u32x4 w; w.x = pk2(y[0], y[1]); w.y = pk2(y[2], y[3]); w.z = pk2(y[4], y[5]); w.w = pk2(y[6], y[7]);
                    *(u32x4*)(MIX + R * 3072 + ch) = w; }
            }
            __syncthreads();
        }
    }
    PHASE_END

    PHASE_BEGIN
    { pg8::Gemm g{Hb, (const bf16*)(WB + W_IN) + (size_t)2048 * 2048, DM, DM, DM}; pg8::StaticOrder S; S.init(68, 24, G, bid, 0);
      EpiRope E{(bf16*)(BIG + B_INB), T_ROPE};
      pg8::gemm_phase<EpiRope>(lds, g, S, E); }
    PHASE_END

    PHASE_BEGIN
    {
        const bf16* INB = (const bf16*)(BIG + B_INB);
        constexpr int QS = 0, KS = 33792, VS = 67584, TS = 76800, RS = 528, VRS = 144;
        const int r = lane & 15, q = lane >> 4, qq = r >> 2, pp = r & 3;
        const int it = wave >> 1, dvp = wave & 1;
        for (int unit0 = bid; unit0 < NB * 4 * 2 * 8; unit0 += G) {
            const int unit = (unit0 & 7) * 32 + (unit0 >> 3);
            const int sl = unit & 7, dir = (unit >> 3) & 1, h = (unit >> 4) & 3, b = unit >> 6;
            bf16* RO = (bf16*)(BIG + (dir ? B_RO1 : B_RO0));
            const float lgam = -expf(args.in[I_RTH][dir * 4 + h]);
            const float gC = expf(64.f * lgam);
            f32x4 Tacc[2][4];
#pragma unroll
            for (int a = 0; a < 2; ++a)
#pragma unroll
                for (int d = 0; d < 4; ++d) Tacc[a][d] = (f32x4){0.f, 0.f, 0.f, 0.f};
            const int vrow = tid >> 3, vcp = tid & 7;
            const float vsc = expf(-(float)vrow * lgam);
            u32x4 pq[4], pk[4], pv;
#define RT_ROW(n, row) ((size_t)b * SROW + (dir == 0 ? ((n) * 64 + (row)) : (((n) * 64 + (row)) < CTX ? CTX - 1 - ((n) * 64 + (row)) : SROW + CTX - 1 - ((n) * 64 + (row)))))
#define RT_LOAD(n) do { _Pragma("unroll") for (int k = 0; k < 4; ++k) { const int id = tid + 512 * k, row = id >> 5, cp = id & 31; const bf16* src = INB + RT_ROW(n, row) * INB_LD + h * 256 + cp * 8; \
                pq[k] = *(const u32x4*)src; pk[k] = *(const u32x4*)(src + 1024); } \
                pv = *(const u32x4*)(INB + RT_ROW(n, vrow) * INB_LD + 2048 + h * 512 + sl * 64 + vcp * 8); } while (0)
            RT_LOAD(0);
            float bgv[8]; int bg_cur = -1; int bg_it = gw;
            for (int n = 0; n < NCH; ++n) {
                BGW_STORE(1); BGW_ISSUE(bg_it, 1); bg_it += NGW;
#pragma unroll
                for (int k = 0; k < 4; ++k) { const int id = tid + 512 * k, row = id >> 5, cp = id & 31;
                    *(LAS u32x4*)(lds + QS + row * RS + cp * 16) = pq[k]; *(LAS u32x4*)(lds + KS + row * RS + cp * 16) = pk[k]; }
                { u32x4 w; w.x = pk2(lo16(pv.x) * vsc, hi16(pv.x) * vsc); w.y = pk2(lo16(pv.y) * vsc, hi16(pv.y) * vsc); w.z = pk2(lo16(pv.z) * vsc, hi16(pv.z) * vsc); w.w = pk2(lo16(pv.w) * vsc, hi16(pv.w) * vsc);
                  *(LAS u32x4*)(lds + VS + vrow * VRS + vcp * 16) = w; }
                const bool outp = n >= 4;
                if (outp) {
#pragma unroll
                    for (int a = 0; a < 2; ++a)
#pragma unroll
                        for (int d = 0; d < 4; ++d) { u32x2 w; w.x = pk2(Tacc[a][d][0], Tacc[a][d][1]); w.y = pk2(Tacc[a][d][2], Tacc[a][d][3]);
                            *(LAS u32x2*)(lds + TS + (16 * d + r) * RS + (16 * (2 * wave + a) + 4 * q) * 2) = w; }
                }
                __syncthreads();
                if (n + 1 < NCH) RT_LOAD(n + 1);
                if (outp) {
                    bf16x8 Qf[8];
#pragma unroll
                    for (int ks = 0; ks < 8; ++ks) Qf[ks] = *(const LAS bf16x8*)(lds + QS + (16 * it + r) * RS + (32 * ks + 8 * q) * 2);
                    f32x4 oacc[2];
#pragma unroll
                    for (int dd = 0; dd < 2; ++dd) { f32x4 c = (f32x4){0.f, 0.f, 0.f, 0.f};
#pragma unroll
                        for (int ks = 0; ks < 8; ++ks) { const bf16x8 tf = *(const LAS bf16x8*)(lds + TS + (16 * (2 * dvp + dd) + r) * RS + (32 * ks + 8 * q) * 2);
                            c = __builtin_amdgcn_mfma_f32_16x16x32_bf16(Qf[ks], tf, c, 0, 0, 0); }
                        oacc[dd] = c * gC; }
#pragma unroll
                    for (int kp = 0; kp < 2; ++kp) {
                        if (2 * kp <= it) {
                            f32x4 pt[2];
#pragma unroll
                            for (int e = 0; e < 2; ++e) { const int jt = 2 * kp + e; f32x4 c = (f32x4){0.f, 0.f, 0.f, 0.f};
                                if (jt <= it) {
#pragma unroll
                                    for (int ks = 0; ks < 8; ++ks) { const bf16x8 kf = *(const LAS bf16x8*)(lds + KS + (16 * jt + r) * RS + (32 * ks + 8 * q) * 2);
                                        c = __builtin_amdgcn_mfma_f32_16x16x32_bf16(kf, Qf[ks], c, 0, 0, 0); }
                                    if (jt == it) {
#pragma unroll
                                        for (int jj = 0; jj < 4; ++jj) if (4 * q + jj > r) c[jj] = 0.f; }
                                }
                                pt[e] = c; }
                            u32x4 pw; pw.x = pk2(pt[0][0], pt[0][1]); pw.y = pk2(pt[0][2], pt[0][3]); pw.z = pk2(pt[1][0], pt[1][1]); pw.w = pk2(pt[1][2], pt[1][3]);
                            const bf16x8 pf = __builtin_bit_cast(bf16x8, pw);
#pragma unroll
                            for (int dd = 0; dd < 2; ++dd) { const int dvt = 2 * dvp + dd;
                                const s16x4 v0 = __builtin_amdgcn_ds_read_tr16_b64_v4i16((LAS s16x4*)(lds + VS + (32 * kp + 4 * q + qq) * VRS + (16 * dvt + 4 * pp) * 2));
                                const s16x4 v1 = __builtin_amdgcn_ds_read_tr16_b64_v4i16((LAS s16x4*)(lds + VS + (32 * kp + 16 + 4 * q + qq) * VRS + (16 * dvt + 4 * pp) * 2));
                                const bf16x8 vf = {v0[0], v0[1], v0[2], v0[3], v1[0], v1[1], v1[2], v1[3]};
                                oacc[dd] = __builtin_amdgcn_mfma_f32_16x16x32_bf16(pf, vf, oacc[dd], 0, 0, 0); }
                        }
                    }
#pragma unroll
                    for (int jj = 0; jj < 4; ++jj) { const int i = 16 * it + 4 * q + jj; const float gi = __expf((float)i * lgam);
                        const size_t R = RT_ROW(n, i); const size_t Rl = (size_t)b * SEQ + (R - (size_t)b * SROW - CTX);
#pragma unroll
                        for (int dd = 0; dd < 2; ++dd) RO[Rl * 2048 + h * 512 + sl * 64 + 16 * (2 * dvp + dd) + r] = (bf16)f2bf(oacc[dd][jj] * gi); }
                }
#pragma unroll
                for (int a = 0; a < 2; ++a)
#pragma unroll
                    for (int d = 0; d < 4; ++d) Tacc[a][d] = Tacc[a][d] * gC;
#pragma unroll
                for (int ks = 0; ks < 2; ++ks) {
                    bf16x8 kt[2], vf[4];
#pragma unroll
                    for (int a = 0; a < 2; ++a) { const int dkt = 2 * wave + a;
                        const s16x4 k0 = __builtin_amdgcn_ds_read_tr16_b64_v4i16((LAS s16x4*)(lds + KS + (32 * ks + 8 * q + qq) * RS + (16 * dkt + 4 * pp) * 2));
                        const s16x4 k1 = __builtin_amdgcn_ds_read_tr16_b64_v4i16((LAS s16x4*)(lds + KS + (32 * ks + 8 * q + 4 + qq) * RS + (16 * dkt + 4 * pp) * 2));
                        kt[a] = (bf16x8){k0[0], k0[1], k0[2], k0[3], k1[0], k1[1], k1[2], k1[3]}; }
#pragma unroll
                    for (int d = 0; d < 4; ++d) {
                        const s16x4 v0 = __builtin_amdgcn_ds_read_tr16_b64_v4i16((LAS s16x4*)(lds + VS + (32 * ks + 8 * q + qq) * VRS + (16 * d + 4 * pp) * 2));
                        const s16x4 v1 = __builtin_amdgcn_ds_read_tr16_b64_v4i16((LAS s16x4*)(lds + VS + (32 * ks + 8 * q + 4 + qq) * VRS + (16 * d + 4 * pp) * 2));
                        vf[d] = (bf16x8){v0[0], v0[1], v0[2], v0[3], v1[0], v1[1], v1[2], v1[3]}; }
#pragma unroll
                    for (int a = 0; a < 2; ++a)
#pragma unroll
                        for (int d = 0; d < 4; ++d) Tacc[a][d] = __builtin_amdgcn_mfma_f32_16x16x32_bf16(kt[a], vf[d], Tacc[a][d], 0, 0, 0);
                }
                __syncthreads();
            }
            BGW_STORE(1);
            for (; bg_it < BGW_ITEMS; bg_it += NGW) { BGW_ISSUE(bg_it, 1); BGW_STORE(1); }
        }
#undef RT_ROW
#undef RT_LOAD
    }
    PHASE_END

    PHASE_BEGIN
    {
        const bf16* O0 = (const bf16*)(BIG + B_RO0); const bf16* O1 = (const bf16*)(BIG + B_RO1); const bf16* INB = (const bf16*)(BIG + B_INB);
        for (int item = gw; item < NB * SEQ * 4; item += NGW) {
            const int Rl = item >> 2, h = item & 3, b = Rl / SEQ, n = Rl % SEQ; const size_t R = (size_t)b * SROW + CTX + n;
            const size_t o = (size_t)Rl * 2048 + h * 512 + lane * 8;
            const u32x4 a = *(const u32x4*)(O0 + o), c = *(const u32x4*)(O1 + o);
            float v[8] = {lo16(a.x) + lo16(c.x), hi16(a.x) + hi16(c.x), lo16(a.y) + lo16(c.y), hi16(a.y) + hi16(c.y), lo16(a.z) + lo16(c.z), hi16(a.z) + hi16(c.z), lo16(a.w) + lo16(c.w), hi16(a.w) + hi16(c.w)};
            float ss = 0.f;
#pragma unroll
            for (int e = 0; e < 8; ++e) ss += v[e] * v[e];
            const float rs = __builtin_amdgcn_rsqf(wave_sum(ss) * (1.f / 512.f) + EPS);
            const u32x4 gw4 = *(const u32x4*)(INB + R * INB_LD + 4096 + h * 512 + lane * 8);
            const float gt[8] = {lo16(gw4.x), hi16(gw4.x), lo16(gw4.y), hi16(gw4.y), lo16(gw4.z), hi16(gw4.z), lo16(gw4.w), hi16(gw4.w)};
            u32x4 w; w.x = pk2(v[0] * rs * siluf_(gt[0]), v[1] * rs * siluf_(gt[1])); w.y = pk2(v[2] * rs * siluf_(gt[2]), v[3] * rs * siluf_(gt[3]));
            w.z = pk2(v[4] * rs * siluf_(gt[4]), v[5] * rs * siluf_(gt[5])); w.w = pk2(v[6] * rs * siluf_(gt[6]), v[7] * rs * siluf_(gt[7]));
            *(u32x4*)(MIX + R * 3072 + 1024 + h * 512 + lane * 8) = w;
        }
    }
    PHASE_END

    PHASE_BEGIN
    { pg8::Gemm g{MIX, (const bf16*)(WB + W_OUT), 3072, 3072, 3072}; pg8::StaticOrder S; S.init(64, 8, G, bid, 1);
      EpiRes<false> E{XLb, XLb, MOD + 5 * 12288 + 2 * 2048, SLAB};
      pg8::gemm_phase<EpiRes<false>>(lds, g, S, E); }
    PHASE_END

    PHASE_BEGIN
    ADALN(1, 1, true, XLb, XC, true, (const float*)nullptr, (const float*)nullptr)
    PHASE_END

    PHASE_BEGIN
    { pg8::Gemm g{Hb, (const bf16*)(WB + W_UP), DM, DM, DM}; pg8::StaticOrder S; S.init(64, 44, G, bid, 1);
      EpiSwiglu E{(bf16*)(BIG + B_G)};
      pg8::gemm_phase<EpiSwiglu>(lds, g, S, E); }
    PHASE_END

    PHASE_BEGIN
    { pg8::Gemm g{(const bf16*)(BIG + B_G), (const bf16*)(WB + W_DN), DFF, DFF, DFF}; pg8::StaticOrder S; S.init(64, 8, G, bid, 1);
      EpiRes<false> E{XLb, XLb, MOD + 5 * 12288 + 5 * 2048, SLAB};
      pg8::gemm_phase<EpiRes<false>>(lds, g, S, E); }
    PHASE_END

    PHASE_BEGIN
    {
        const float* fg = args.in[I_FING];
        f32x4 gg[8];
#pragma unroll
        for (int j = 0; j < 8; ++j) gg[j] = *(const f32x4*)(fg + lane * 4 + j * 256);
        for (int R = gw; R < NB * SEQ; R += NGW) { const bf16* xr = XLb + (size_t)R * DM; float* orow = args.out + (size_t)R * DM;
            f32x4 v[8]; float ss = 0.f;
#pragma unroll
            for (int j = 0; j < 8; ++j) { const u32x2 w = *(const u32x2*)(xr + lane * 4 + j * 256); v[j] = (f32x4){lo16(w.x), hi16(w.x), lo16(w.y), hi16(w.y)};
                ss += (v[j][0] * v[j][0] + v[j][1] * v[j][1]) + (v[j][2] * v[j][2] + v[j][3] * v[j][3]); }
            const float rstd = __builtin_amdgcn_rsqf(wave_sum(ss) * (1.f / DM) + EPS);
#pragma unroll
            for (int j = 0; j < 8; ++j) *(f32x4*)(orow + lane * 4 + j * 256) = v[j] * rstd * gg[j];
        }
    }
    PHASE_END
}
constexpr int N_PHASES = 26;

extern "C" void kernel_launch(void* const* d_in, const int* in_sizes, int n_in, void* d_out, int out_size, void* d_ws, size_t ws_size, hipStream_t stream) {
    static int grid = 0;
    if (grid == 0) {
        if (n_in != 38 || out_size != NB * SEQ * DM || ws_size < WS_END) { fprintf(stderr, "kernel_launch: unexpected problem (n_in %d out %d ws %zu, need %zu)\n", n_in, out_size, ws_size, (size_t)WS_END); grid = -1; return; }
        int dev = 0, cus = 0;
        if (hipGetDevice(&dev) != hipSuccess || hipDeviceGetAttribute(&cus, hipDeviceAttributeMultiprocessorCount, dev) != hipSuccess) { grid = -1; return; }
        if (hipFuncSetAttribute((const void*)fwd_kernel, hipFuncAttributeMaxDynamicSharedMemorySize, LDS_BYTES) != hipSuccess) { fprintf(stderr, "kernel_launch: hipFuncSetAttribute failed\n"); grid = -1; return; }
        int per_cu = 0;
        if (hipOccupancyMaxActiveBlocksPerMultiprocessor(&per_cu, (const void*)fwd_kernel, 512, LDS_BYTES) != hipSuccess || per_cu < 1) { fprintf(stderr, "kernel_launch: occupancy query says %d\n", per_cu); }
        (void)hipGetLastError();
        if (per_cu < 1) { grid = -1; return; }
        grid = cus;
    }
    if (grid < 0) return;
    (void)hipMemsetAsync((char*)d_ws + WS_CTL, 0, CTL_BYTES, stream);
    Args a{};
    for (int i = 0; i < 38; ++i) a.in[i] = (const float*)d_in[i];
    a.out = (float*)d_out; a.ws = (unsigned char*)d_ws;
#if MK_ONE_LAUNCH
    a.ph_lo = 0; a.ph_hi = N_PHASES;
    hipLaunchKernelGGL(fwd_kernel, dim3(grid), dim3(512), LDS_BYTES, stream, a);
#else
    for (int p = 0; p < N_PHASES; ++p) { a.ph_lo = p; a.ph_hi = p + 1; hipLaunchKernelGGL(fwd_kernel, dim3(grid), dim3(512), LDS_BYTES, stream, a); }
#endif
}
```

```cpp
#include <hip/hip_runtime.h>
#include <cstdio>
#include <cstdint>

#ifndef MK_ONE_LAUNCH
#define MK_ONE_LAUNCH 1
#endif

#define DI __device__ __forceinline__
#define LAS __attribute__((address_space(3)))
typedef unsigned short bf16;
typedef short bf16x8 __attribute__((ext_vector_type(8)));
typedef float f32x4 __attribute__((ext_vector_type(4)));
typedef float f32x2 __attribute__((ext_vector_type(2)));
typedef unsigned u32x4 __attribute__((ext_vector_type(4)));
typedef unsigned u32x2 __attribute__((ext_vector_type(2)));
typedef short s16x4 __attribute__((ext_vector_type(4)));

constexpr int DM = 2048, NB = 4, SEQ = 4096, CTX = 256, DFF = 5632;
constexpr int SROW = CTX + SEQ;
constexpr int MROWS = NB * SROW;
constexpr int NCH = SROW / 64;
constexpr float EPS = 1e-6f;
constexpr int IN0_LD = 5120;
constexpr int INB_LD = 6144;

constexpr size_t MiB = 1u << 20;
constexpr size_t WS_CTL = 0, CTL_BYTES = 1 * MiB;
constexpr size_t WS_MOD = 1 * MiB;
constexpr size_t WS_TAB = 2 * MiB;
constexpr size_t WS_XC = 4 * MiB;
constexpr size_t WS_W = 12 * MiB;
constexpr size_t W_IN = 0, W_OUT = 32 * MiB, W_GLU = 44 * MiB, W_UP = 46 * MiB, W_DN = 90 * MiB;
constexpr size_t WS_H = 124 * MiB;
constexpr size_t WS_MIX = 192 * MiB;
constexpr size_t WS_BIG = 294 * MiB;
constexpr size_t B_IN0 = 0, B_AB = 170 * MiB, B_DNQ = 173 * MiB, B_DNK = 207 * MiB, B_DNV = 241 * MiB, B_DNG = 275 * MiB, B_DNB = 277 * MiB,
                 B_DNO0 = 279 * MiB, B_DNO1 = 313 * MiB, B_S5Y = 347 * MiB, B_S5E = 381 * MiB, B_S5S = 398 * MiB, B_GCUM = 415 * MiB, B_END0 = 417 * MiB;
constexpr size_t MIX_TINV = 68 * MiB;
constexpr size_t B_INA = 0, B_XCV = 68 * MiB, B_LA = 102 * MiB, B_BB = 170 * MiB, B_LEP = 238 * MiB, B_LST = 243 * MiB;
constexpr size_t B_INB = 0, B_RO0 = 204 * MiB, B_RO1 = 268 * MiB;
constexpr size_t B_G = 0;
constexpr size_t WS_END = WS_BIG + B_END0;

DI float bf2f(unsigned v) { return __uint_as_float(v << 16); }
typedef __bf16 bf16x2_t __attribute__((ext_vector_type(2)));
DI unsigned pk2(float lo, float hi) { const bf16x2_t v = __builtin_convertvector((f32x2){lo, hi}, bf16x2_t); return __builtin_bit_cast(unsigned, v); }
DI unsigned f2bf(float f) { return pk2(f, 0.f) & 0xffffu; }
DI float lo16(unsigned w) { return __uint_as_float(w << 16); }
DI float hi16(unsigned w) { return __uint_as_float(w & 0xffff0000u); }
DI float sigmoidf_(float x) { return __builtin_amdgcn_rcpf(1.f + __expf(-x)); }
DI float siluf_(float x) { return x * __builtin_amdgcn_rcpf(1.f + __expf(-x)); }
DI float softplusf_(float x) { return fmaxf(x, 0.f) + log1pf(expf(-fabsf(x))); }
DI float gelu_tanh(float x) { const float u = 0.7978845608028654f * (x + 0.044715f * x * x * x); return x * __builtin_amdgcn_rcpf(1.f + __expf(-2.f * u)); }
DI float wave_sum(float v) {
#pragma unroll
    for (int o = 1; o < 64; o <<= 1) v += __shfl_xor(v, o);
    return v;
}

DI bf16x8 frag_rows(LAS unsigned char* base, int RSB, int row0, int k0, int r, int q) { return *(const LAS bf16x8*)(base + (row0 + r) * RSB + (k0 + 8 * q) * 2); }
DI bf16x8 frag_tr(LAS unsigned char* base, int RSB, int k0, int n0, int q, int qq, int pp) {
    const s16x4 a = __builtin_amdgcn_ds_read_tr16_b64_v4i16((LAS s16x4*)(base + (k0 + 8 * q + qq) * RSB + (n0 + 4 * pp) * 2));
    const s16x4 b = __builtin_amdgcn_ds_read_tr16_b64_v4i16((LAS s16x4*)(base + (k0 + 8 * q + 4 + qq) * RSB + (n0 + 4 * pp) * 2));
    return (bf16x8){a[0], a[1], a[2], a[3], b[0], b[1], b[2], b[3]}; }
DI bf16x8 frag_rows_perm(LAS unsigned char* base, int RSB, int row0, int k0, int r, int q) {
    const u32x2 a = *(const LAS u32x2*)(base + (row0 + r) * RSB + (k0 + 4 * q) * 2), b = *(const LAS u32x2*)(base + (row0 + r) * RSB + (k0 + 16 + 4 * q) * 2);
    u32x4 w; w.x = a.x; w.y = a.y; w.z = b.x; w.w = b.y; return __builtin_bit_cast(bf16x8, w); }
DI bf16x8 pack_pair(const f32x4& x, const f32x4& y) { u32x4 w; w.x = pk2(x[0], x[1]); w.y = pk2(x[2], x[3]); w.z = pk2(y[0], y[1]); w.w = pk2(y[2], y[3]); return __builtin_bit_cast(bf16x8, w); }
#define MFMA16(a, b, c) __builtin_amdgcn_mfma_f32_16x16x32_bf16((a), (b), (c), 0, 0, 0)
DI void st_hl(LAS unsigned char* p, int lo_off, const f32x4& c) {
    u32x2 h; h.x = pk2(c[0], c[1]); h.y = pk2(c[2], c[3]);
    u32x2 l; l.x = pk2(c[0] - lo16(h.x), c[1] - hi16(h.x)); l.y = pk2(c[2] - lo16(h.y), c[3] - hi16(h.y));
    *(LAS u32x2*)p = h; *(LAS u32x2*)(p + lo_off) = l; }
DI f32x4 mm3(f32x4 c, const bf16x8& ah, const bf16x8& al, const bf16x8& bh, const bf16x8& bl) { c = MFMA16(ah, bh, c); c = MFMA16(ah, bl, c); c = MFMA16(al, bh, c); return c; }
#define LDS_WAIT() asm volatile("s_waitcnt lgkmcnt(0)" ::: "memory")
#define VM_WAIT() asm volatile("s_waitcnt vmcnt(0)" ::: "memory")

namespace pg8 {
constexpr int BM = 256, BK = 64, HALF = 128, HTB = HALF * BK * 2, STAGE_BYTES = 8 * HTB, NXCD = 8, WGM = 8;
DI int lds_byte(int r, int c) { const int st = (r >> 4) * 2 + (c >> 5), rr = r & 15, cc = c & 31, ob = rr * 64 + cc * 2; return st * 1024 + (ob ^ (((ob >> 9) & 1) << 5)); }
DI void stage_rc(int b, int& R, int& C) { const int st = b / 1024, sb = b % 1024, swz = sb ^ (((sb >> 9) & 1) << 5); R = (st >> 1) * 16 + swz / 64; C = (st & 1) * 32 + (swz % 64) / 2; }
DI int perm32(int rho) { const int n = rho >> 4, i = rho & 15; return 8 * (i >> 2) + 4 * n + (i & 3); }
struct Unit { int pm, pn, koff, nt; };
struct Gemm { const bf16* A; const bf16* Bt; int lda, ldb, K; };
struct StaticOrder {
    int nM, nN, nwg, G, c, lat;
    DI void init(int nM_, int nN_, int G_, int c_, int lat_) { nM = nM_; nN = nN_; nwg = nM * nN; G = G_; c = c_; lat = lat_; }
    DI bool next(int i, int& upm, int& upn, int& ukoff, int& unt) const {
        const long L = (long)i * G + c; if (L >= nwg) return false;
        int wgid = (int)L; { const int q = nwg / NXCD, r = nwg % NXCD, xcd = wgid % NXCD, off = wgid / NXCD; wgid = (xcd < r ? xcd * (q + 1) : r * (q + 1) + (xcd - r) * q) + off; }
        const int nig = WGM * nN, gid = wgid / nig, fm = gid * WGM, gsz = (nM - fm) < WGM ? (nM - fm) : WGM;
        int pm = fm + ((wgid % nig) % gsz); upn = (wgid % nig) / gsz;
        if (lat) pm = (pm >> 4) * 17 + 1 + (pm & 15);
        upm = pm; ukoff = 0; unt = 0; return true;
    }
};
template <int NTOT> struct TailOrder {
    int G, c;
    static constexpr int NWG = 512, LO = (NTOT / 8) & ~1, EX2 = (NTOT - LO * 8) >> 1;
    DI void init(int G_, int c_) { G = G_; c = c_; }
    DI bool next(int i, int& upm, int& upn, int& ukoff, int& unt) const {
        const int L = i * G + c; if (L >= NWG + 256) return false;
        const bool mainu = L < NWG; const int T = L - NWG;
        const int wgid = (L & 7) * (NWG / 8) + (L >> 3);
        const int w = wgid & 63, pml = (wgid >> 6) * 8 + (w & 7); const int ctn = T >> 3, sp = T & 7;
        upm = mainu ? (pml >> 4) * 17 + 1 + (pml & 15) : (ctn >> 3) * 17; upn = mainu ? (w >> 3) : (ctn & 7);
        unt = mainu ? 0 : ((LO + (sp < EX2 ? 2 : 0)) | (sp << 8)); ukoff = mainu ? 0 : (LO * sp + 2 * (sp < EX2 ? sp : EX2)) * 128; return true;
    }
};
DI unsigned cvt_pk_bf16(float lo, float hi) { unsigned r; asm volatile("v_cvt_pk_bf16_f32 %0, %1, %2" : "=v"(r) : "v"(lo), "v"(hi)); return r; }

template <class Epi, class Sched = StaticOrder, bool BLKDIAG = false>
DI void gemm_phase(LAS unsigned char* lds, const Gemm g, const Sched& S, const Epi& E) {
    int tid_ = threadIdx.x; asm volatile("" : "+v"(tid_));
    const int tid = tid_, wid = __builtin_amdgcn_readfirstlane(tid >> 6), lane = tid & 63, wr = wid >> 2, wc = wid & 3, fr = lane & 15, fq = lane >> 4;
    int K_ = g.K; asm volatile("" : "+s"(K_));
    const int K = K_, nt = K / BK;
    unsigned voffA[2], voffB[2];
#pragma unroll
    for (int i = 0; i < 2; ++i) { int R, C; stage_rc(tid * 16 + i * 8192, R, C); const int Rb = Epi::PERM ? ((R & ~31) + perm32(R & 31)) : R;
        voffA[i] = (unsigned)(R * g.lda + C) * 2u; voffB[i] = (unsigned)(Rb * g.ldb + C) * 2u; }
    const size_t kstep = (size_t)(BK * 2);
    const size_t hstepA = (size_t)HALF * g.lda * 2, hstepB = (size_t)HALF * g.ldb * 2;
    const size_t tstepA = 2 * hstepA, tstepB = 2 * hstepB;
    const unsigned ldsw = (unsigned)wid * 1024u;
    const int aoff = lds_byte(wr * 64 + fr, fq * 8), boff = lds_byte(wc * 32 + fr, fq * 8);
#define PG8_SA(b, h) (((b) * 2 + (h)) * HTB)
#define PG8_SB(b, h) ((4 + (b) * 2 + (h)) * HTB)
#define PG8_STAGE(bufoff, gbase, voff) do { _Pragma("unroll") for (int _i = 0; _i < 2; ++_i) \
        __builtin_amdgcn_global_load_lds((const unsigned*)((const char*)(gbase) + (voff)[_i]), (LAS unsigned*)(lds + (bufoff) + ldsw + _i * 8192), 16, 0, 0); } while (0)
#define PG8_LDA(dst, b, h) do { _Pragma("unroll") for (int m = 0; m < 4; ++m) _Pragma("unroll") for (int k = 0; k < 2; ++k) dst[m][k] = *(const LAS bf16x8*)(lds + PG8_SA(b, h) + aoff + m * 2048 + k * 1024); } while (0)
#define PG8_LDB(dst, b, h) do { _Pragma("unroll") for (int n = 0; n < 2; ++n) _Pragma("unroll") for (int k = 0; k < 2; ++k) dst[n][k] = *(const LAS bf16x8*)(lds + PG8_SB(b, h) + boff + n * 2048 + k * 1024); } while (0)
#define PG8_MMA(ai, bj, At, Bt) do { __builtin_amdgcn_s_setprio(1); _Pragma("unroll") for (int m = 0; m < 4; ++m) _Pragma("unroll") for (int n = 0; n < 2; ++n) _Pragma("unroll") for (int k = 0; k < 2; ++k) \
        acc[ai][bj][m][n] = __builtin_amdgcn_mfma_f32_16x16x32_bf16(Bt[n][k], At[m][k], acc[ai][bj][m][n], 0, 0, 0); __builtin_amdgcn_s_setprio(0); } while (0)
#define PG8_WAIT_V(n) asm volatile("s_waitcnt vmcnt(" #n ")" ::: "memory")
#define PG8_WAIT_L(n) asm volatile("s_waitcnt lgkmcnt(" #n ")" ::: "memory")
#define PG8_BAR __builtin_amdgcn_s_barrier()
#define PG8_SCHED __builtin_amdgcn_sched_barrier(0)
#define PG8_KOFF(pn_, koff_) ((BLKDIAG ? (size_t)(((pn_) & 7) >> 1) * 512 : (size_t)0) + (size_t)(koff_))
    int cpm, cpn, ckoff, cnt_, npm = 0, npn = 0, nkoff = 0, nnt = 0; int ui = 0;
    if (!S.next(0, cpm, cpn, ckoff, cnt_)) return;
    f32x4 acc[2][2][4][2];
#pragma unroll
    for (int a = 0; a < 2; ++a)
#pragma unroll
        for (int b = 0; b < 2; ++b)
#pragma unroll
            for (int m = 0; m < 4; ++m)
#pragma unroll
                for (int n = 0; n < 2; ++n) acc[a][b][m][n] = (f32x4){0.f, 0.f, 0.f, 0.f};
    bf16x8 At[4][2], B0[2][2], B1[2][2];
    const char* cA = (const char*)g.A + (size_t)cpm * tstepA + PG8_KOFF(cpn, ckoff); const char* cB = (const char*)g.Bt + (size_t)cpn * tstepB + (size_t)ckoff;
    PG8_STAGE(PG8_SB(0, 0), cB, voffB); PG8_STAGE(PG8_SB(0, 1), cB + hstepB, voffB); PG8_STAGE(PG8_SA(0, 0), cA, voffA); PG8_STAGE(PG8_SA(0, 1), cA + hstepA, voffA);
    if (wr == 1) PG8_BAR;
    PG8_WAIT_V(2); PG8_BAR;
    PG8_STAGE(PG8_SB(1, 0), cB + kstep, voffB); PG8_STAGE(PG8_SA(1, 0), cA + kstep, voffA); PG8_STAGE(PG8_SB(1, 1), cB + hstepB + kstep, voffB);
    PG8_WAIT_V(6); PG8_BAR;
    for (;;) {
        const bool has_next = S.next(ui + 1, npm, npn, nkoff, nnt);
        const char* nA = has_next ? (const char*)g.A + (size_t)npm * tstepA + PG8_KOFF(npn, nkoff) : cA; const char* nB = has_next ? (const char*)g.Bt + (size_t)npn * tstepB + (size_t)nkoff : cB;
        const int cnt = cnt_ ? (cnt_ & 255) : nt;
        for (int t = 0; t < cnt; t += 2) {
            const bool last = (t == cnt - 2);
            const char* a1 = cA + (size_t)(t + 1) * kstep;
            const char* a2 = last ? nA : cA + (size_t)(t + 2) * kstep; const char* b2 = last ? nB : cB + (size_t)(t + 2) * kstep;
            const char* a3 = a2 + kstep; const char* b3 = b2 + kstep;
            PG8_LDB(B0, 0, 0); PG8_LDB(B1, 0, 1); PG8_SCHED; PG8_LDA(At, 0, 0); PG8_STAGE(PG8_SA(1, 1), a1 + hstepA, voffA);
            PG8_WAIT_V(8); PG8_WAIT_L(0); PG8_BAR; PG8_MMA(0, 0, At, B0); PG8_MMA(0, 1, At, B1); PG8_BAR; PG8_SCHED;
            PG8_LDA(At, 0, 1); PG8_STAGE(PG8_SB(0, 0), b2, voffB); PG8_STAGE(PG8_SB(0, 1), b2 + hstepB, voffB); PG8_STAGE(PG8_SA(0, 0), a2, voffA);
            PG8_WAIT_V(8); PG8_WAIT_L(0); PG8_BAR; PG8_MMA(1, 0, At, B0); PG8_MMA(1, 1, At, B1); PG8_BAR; PG8_SCHED;
            PG8_LDB(B0, 1, 0); PG8_LDB(B1, 1, 1); PG8_SCHED; PG8_LDA(At, 1, 0); PG8_STAGE(PG8_SA(0, 1), a2 + hstepA, voffA);
            PG8_WAIT_V(8); PG8_WAIT_L(0); PG8_BAR; PG8_MMA(0, 0, At, B0); PG8_MMA(0, 1, At, B1); PG8_BAR; PG8_SCHED;
            PG8_LDA(At, 1, 1); PG8_STAGE(PG8_SB(1, 0), b3, voffB); PG8_STAGE(PG8_SB(1, 1), b3 + hstepB, voffB); PG8_STAGE(PG8_SA(1, 0), a3, voffA);
            PG8_WAIT_V(8); PG8_WAIT_L(0); PG8_BAR; PG8_MMA(1, 0, At, B0); PG8_MMA(1, 1, At, B1); PG8_BAR; PG8_SCHED;
        }
        if (wr == 0) PG8_BAR;
        { Unit cu; cu.pm = cpm; cu.pn = cpn; cu.koff = ckoff; cu.nt = cnt_; E(acc, cu, wr, wc, fr, fq); }
        if (!has_next) break;
#pragma unroll
        for (int a = 0; a < 2; ++a)
#pragma unroll
            for (int b = 0; b < 2; ++b)
#pragma unroll
                for (int m = 0; m < 4; ++m)
#pragma unroll
                    for (int n = 0; n < 2; ++n) acc[a][b][m][n] = (f32x4){0.f, 0.f, 0.f, 0.f};
        cpm = npm; cpn = npn; ckoff = nkoff; cnt_ = nnt; cA = nA; cB = nB; ++ui;
        if (wr == 1) PG8_BAR;
    }
    PG8_WAIT_V(0);
    PG8_BAR;
#undef PG8_SA
#undef PG8_SB
#undef PG8_STAGE
#undef PG8_LDA
#undef PG8_LDB
#undef PG8_MMA
#undef PG8_WAIT_V
#undef PG8_WAIT_L
#undef PG8_BAR
#undef PG8_SCHED
#undef PG8_KOFF
}
}
using pg8::Unit;
typedef f32x4 AccT[2][2][4][2];

struct EpiPlain {
    static constexpr bool PERM = true;
    bf16* O; int ldc;
    DI void operator()(const AccT& acc, const Unit& u, int wr, int wc, int fr, int fq) const {
        const int row0 = u.pm * 256 + wr * 64 + fr, col0 = u.pn * 256 + wc * 32 + 8 * fq;
#pragma unroll
        for (int ai = 0; ai < 2; ++ai)
#pragma unroll
            for (int m = 0; m < 4; ++m) { bf16* rowp = O + (size_t)(row0 + ai * 128 + m * 16) * ldc + col0;
#pragma unroll
                for (int bj = 0; bj < 2; ++bj) { const f32x4 v0 = acc[ai][bj][m][0], v1 = acc[ai][bj][m][1];
                    u32x4 w; w.x = pg8::cvt_pk_bf16(v0[0], v0[1]); w.y = pg8::cvt_pk_bf16(v0[2], v0[3]); w.z = pg8::cvt_pk_bf16(v1[0], v1[1]); w.w = pg8::cvt_pk_bf16(v1[2], v1[3]);
                    *(u32x4*)(rowp + bj * 128) = w; } }
    }
};
struct EpiIn0 {
    static constexpr bool PERM = true;
    bf16* O; float* AB;
    DI void operator()(const AccT& acc, const Unit& u, int wr, int wc, int fr, int fq) const {
        const int row0 = u.pm * 256 + wr * 64 + fr;
        if (u.pn < 20) {
            const int col0 = u.pn * 256 + wc * 32 + 8 * fq;
#pragma unroll
            for (int ai = 0; ai < 2; ++ai)
#pragma unroll
                for (int m = 0; m < 4; ++m) { bf16* rowp = O + (size_t)(row0 + ai * 128 + m * 16) * IN0_LD + col0;
#pragma unroll
                    for (int bj = 0; bj < 2; ++bj) { const f32x4 v0 = acc[ai][bj][m][0], v1 = acc[ai][bj][m][1];
                        u32x4 w; w.x = pg8::cvt_pk_bf16(v0[0], v0[1]); w.y = pg8::cvt_pk_bf16(v0[2], v0[3]); w.z = pg8::cvt_pk_bf16(v1[0], v1[1]); w.w = pg8::cvt_pk_bf16(v1[2], v1[3]);
                        *(u32x4*)(rowp + bj * 128) = w; } }
        } else if (wc == 0) {
#pragma unroll
            for (int ai = 0; ai < 2; ++ai)
#pragma unroll
                for (int m = 0; m < 4; ++m) { float* rowp = AB + (size_t)(row0 + ai * 128 + m * 16) * 32 + 8 * fq;
                    *(f32x4*)(rowp) = acc[ai][0][m][0]; *(f32x4*)(rowp + 4) = acc[ai][0][m][1]; }
        }
    }
};
template <bool XIN_F32> struct EpiRes {
    static constexpr bool PERM = true;
    const void* xin_l; bf16* xout_l; const float* mod; float* slab;
    DI void operator()(const AccT& acc, const Unit& u, int wr, int wc, int fr, int fq) const {
        const int b = u.pm / 17, j = u.pm % 17;
        const int r0 = wr * 64 + fr, col0 = u.pn * 256 + wc * 32 + 8 * fq;
        if (j == 0) {
            float* sp = slab + ((size_t)(u.nt >> 8) * 1024 + (size_t)b * 256) * DM;
#pragma unroll
            for (int ai = 0; ai < 2; ++ai)
#pragma unroll
                for (int m = 0; m < 4; ++m) { const size_t ro = (size_t)(r0 + ai * 128 + m * 16) * DM + col0;
#pragma unroll
                    for (int bj = 0; bj < 2; ++bj) { *(f32x4*)(sp + ro + bj * 128) = acc[ai][bj][m][0]; *(f32x4*)(sp + ro + bj * 128 + 4) = acc[ai][bj][m][1]; } }
            return;
        }
        const size_t off = ((size_t)b * SEQ + (size_t)(j - 1) * 256) * DM; const float* gt = mod + b * 12288;
        f32x4 gv[2][2];
#pragma unroll
        for (int bj = 0; bj < 2; ++bj)
#pragma unroll
            for (int n = 0; n < 2; ++n) gv[bj][n] = *(const f32x4*)(gt + col0 + bj * 128 + 4 * n);
#pragma unroll
        for (int ai = 0; ai < 2; ++ai)
#pragma unroll
            for (int m = 0; m < 4; ++m) { const size_t ro = off + (size_t)(r0 + ai * 128 + m * 16) * DM + col0;
#pragma unroll
                for (int bj = 0; bj < 2; ++bj) { f32x4 x0, x1;
                    if (XIN_F32) { x0 = *(const f32x4*)((const float*)xin_l + ro + bj * 128); x1 = *(const f32x4*)((const float*)xin_l + ro + bj * 128 + 4); }
                    else { const u32x4 w = *(const u32x4*)((const bf16*)xin_l + ro + bj * 128); x0 = (f32x4){lo16(w.x), hi16(w.x), lo16(w.y), hi16(w.y)}; x1 = (f32x4){lo16(w.z), hi16(w.z), lo16(w.w), hi16(w.w)}; }
                    const f32x4 o0 = x0 + gv[bj][0] * acc[ai][bj][m][0], o1 = x1 + gv[bj][1] * acc[ai][bj][m][1];
                    u32x4 w; w.x = pg8::cvt_pk_bf16(o0[0], o0[1]); w.y = pg8::cvt_pk_bf16(o0[2], o0[3]); w.z = pg8::cvt_pk_bf16(o1[0], o1[1]); w.w = pg8::cvt_pk_bf16(o1[2], o1[3]);
                    *(u32x4*)(xout_l + ro + bj * 128) = w; } }
    }
};
struct EpiSwiglu {
    static constexpr bool PERM = true;
    bf16* O;
    DI void operator()(const AccT& acc, const Unit& u, int wr, int wc, int fr, int fq) const {
        const int row0 = u.pm * 256 + wr * 64 + fr, col0 = u.pn * 128 + wc * 32 + 8 * fq;
#pragma unroll
        for (int ai = 0; ai < 2; ++ai)
#pragma unroll
            for (int m = 0; m < 4; ++m) { bf16* rowp = O + (size_t)(row0 + ai * 128 + m * 16) * DFF + col0;
                float v[8];
#pragma unroll
                for (int n = 0; n < 2; ++n)
#pragma unroll
                    for (int j = 0; j < 4; ++j) { const float a = acc[ai][0][m][n][j], b = acc[ai][1][m][n][j]; v[n * 4 + j] = a * __builtin_amdgcn_rcpf(1.f + __expf(-a)) * b; }
                u32x4 w; w.x = pg8::cvt_pk_bf16(v[0], v[1]); w.y = pg8::cvt_pk_bf16(v[2], v[3]); w.z = pg8::cvt_pk_bf16(v[4], v[5]); w.w = pg8::cvt_pk_bf16(v[6], v[7]);
                *(u32x4*)rowp = w; }
    }
};
struct EpiGlu {
    static constexpr bool PERM = true;
    const bf16* Y; bf16* O; const float* gb;
    DI void operator()(const AccT& acc, const Unit& u, int wr, int wc, int fr, int fq) const {
        const int row0 = u.pm * 256 + wr * 64 + fr, col0 = u.pn * 256 + wc * 32 + 8 * fq;
#pragma unroll
        for (int bj = 0; bj < 2; ++bj) {
            const f32x4 b0 = *(const f32x4*)(gb + col0 + bj * 128), b1 = *(const f32x4*)(gb + col0 + bj * 128 + 4);
#pragma unroll
            for (int ai = 0; ai < 2; ++ai)
#pragma unroll
                for (int m = 0; m < 4; ++m) { const size_t r = (size_t)(row0 + ai * 128 + m * 16);
                    const u32x4 yw = *(const u32x4*)(Y + r * 1024 + col0 + bj * 128);
                    const f32x4 v0 = acc[ai][bj][m][0] + b0, v1 = acc[ai][bj][m][1] + b1;
                    float o[8];
#define FSIG(x) __builtin_amdgcn_rcpf(1.f + __expf(-(x)))
                    o[0] = lo16(yw.x) * FSIG(v0[0]); o[1] = hi16(yw.x) * FSIG(v0[1]); o[2] = lo16(yw.y) * FSIG(v0[2]); o[3] = hi16(yw.y) * FSIG(v0[3]);
                    o[4] = lo16(yw.z) * FSIG(v1[0]); o[5] = hi16(yw.z) * FSIG(v1[1]); o[6] = lo16(yw.w) * FSIG(v1[2]); o[7] = hi16(yw.w) * FSIG(v1[3]);
#undef FSIG
                    u32x4 w; w.x = pg8::cvt_pk_bf16(o[0], o[1]); w.y = pg8::cvt_pk_bf16(o[2], o[3]); w.z = pg8::cvt_pk_bf16(o[4], o[5]); w.w = pg8::cvt_pk_bf16(o[6], o[7]);
                    *(u32x4*)(O + r * 2048 + col0 + bj * 128) = w; }
        }
    }
};
struct EpiGate {
    static constexpr bool PERM = true;
    const bf16* X; bf16* LA; bf16* BB; const float* ba; const float* bx; const float* spl;
    DI void operator()(const AccT& acc, const Unit& u, int wr, int wc, int fr, int fq) const {
        const int dir = u.pn >> 3, blk = u.pn & 7;
        const int row0 = u.pm * 256 + wr * 64 + fr, ch0 = blk * 128 + wc * 32 + 8 * fq;
        const f32x4 ba0 = *(const f32x4*)(ba + dir * 1024 + ch0), ba1 = *(const f32x4*)(ba + dir * 1024 + ch0 + 4);
        const f32x4 bx0 = *(const f32x4*)(bx + dir * 1024 + ch0), bx1 = *(const f32x4*)(bx + dir * 1024 + ch0 + 4);
        const f32x4 sp0 = *(const f32x4*)(spl + dir * 1024 + ch0), sp1 = *(const f32x4*)(spl + dir * 1024 + ch0 + 4);
#pragma unroll
        for (int ai = 0; ai < 2; ++ai)
#pragma unroll
            for (int m = 0; m < 4; ++m) { const size_t r = (size_t)(row0 + ai * 128 + m * 16);
                const u32x4 xw = *(const u32x4*)(X + r * 1024 + ch0);
                const float xv[8] = {lo16(xw.x), hi16(xw.x), lo16(xw.y), hi16(xw.y), lo16(xw.z), hi16(xw.z), lo16(xw.w), hi16(xw.w)};
                float la[8], bb[8];
#pragma unroll
                for (int n = 0; n < 2; ++n)
#pragma unroll
                    for (int j = 0; j < 4; ++j) { const int q = n * 4 + j;
                        const float pa = acc[ai][0][m][n][j] + (n ? ba1[j] : ba0[j]), px = acc[ai][1][m][n][j] + (n ? bx1[j] : bx0[j]);
                        const float rg = __builtin_amdgcn_rcpf(1.f + __expf(-pa)), ig = __builtin_amdgcn_rcpf(1.f + __expf(-px));
                        const float l = rg * (n ? sp1[j] : sp0[j]); la[q] = l;
                        const float x2 = 2.f * l;
                        const float ser = -x2 * (1.f + x2 * 0.5f * (1.f + x2 * (1.f / 3.f) * (1.f + x2 * 0.25f * (1.f + x2 * 0.2f))));
                        const float om = x2 > -0.25f ? ser : 1.f - __expf(x2);
                        bb[q] = __builtin_sqrtf(fmaxf(om, 0.f)) * (ig * xv[q]); }
                u32x4 w; w.x = pg8::cvt_pk_bf16(la[0], la[1]); w.y = pg8::cvt_pk_bf16(la[2], la[3]); w.z = pg8::cvt_pk_bf16(la[4], la[5]); w.w = pg8::cvt_pk_bf16(la[6], la[7]);
                *(u32x4*)(LA + (r * 2 + dir) * 1024 + ch0) = w;
                w.x = pg8::cvt_pk_bf16(bb[0], bb[1]); w.y = pg8::cvt_pk_bf16(bb[2], bb[3]); w.z = pg8::cvt_pk_bf16(bb[4], bb[5]); w.w = pg8::cvt_pk_bf16(bb[6], bb[7]);
                *(u32x4*)(BB + (r * 2 + dir) * 1024 + ch0) = w; }
    }
};
struct EpiRope {
    static constexpr bool PERM = true;
    bf16* O; const f32x2* rope;
    DI void operator()(const AccT& acc, const Unit& u, int wr, int wc, int fr, int fq) const {
        const int row0 = u.pm * 256 + wr * 64 + fr, col0 = u.pn * 256 + wc * 32 + 8 * fq;
        const int jt = u.pm % 17;
        const bool isqk = u.pn < 8, lat = jt != 0;
        const float sc = (u.pn >= 4 && u.pn < 8) ? 0.0625f : 1.f;
#pragma unroll
        for (int ai = 0; ai < 2; ++ai)
#pragma unroll
            for (int m = 0; m < 4; ++m) { const int rl = wr * 64 + fr + ai * 128 + m * 16;
                bf16* rowp = O + (size_t)(u.pm * 256 + rl) * INB_LD + col0;
                float t1[8], t2[8];
#pragma unroll
                for (int n = 0; n < 2; ++n)
#pragma unroll
                    for (int j = 0; j < 4; ++j) { t1[n * 4 + j] = acc[ai][0][m][n][j]; t2[n * 4 + j] = acc[ai][1][m][n][j]; }
                if (isqk && lat) {
                    const int pos = (jt - 1) * 256 + rl;
                    const int p = (wc < 2) ? (pos >> 6) : (pos & 63);
                    const int f0 = (wc & 1) * 32 + 8 * fq;
                    const f32x4* rp = (const f32x4*)(rope + p * 64 + f0);
#pragma unroll
                    for (int q = 0; q < 4; ++q) { const f32x4 cs = rp[q];
                        const float a0 = t1[2 * q], b0 = t2[2 * q], a1 = t1[2 * q + 1], b1 = t2[2 * q + 1];
                        t1[2 * q] = a0 * cs[0] - b0 * cs[1]; t2[2 * q] = a0 * cs[1] + b0 * cs[0];
                        t1[2 * q + 1] = a1 * cs[2] - b1 * cs[3]; t2[2 * q + 1] = a1 * cs[3] + b1 * cs[2]; }
                }
                u32x4 w; w.x = pg8::cvt_pk_bf16(t1[0] * sc, t1[1] * sc); w.y = pg8::cvt_pk_bf16(t1[2] * sc, t1[3] * sc); w.z = pg8::cvt_pk_bf16(t1[4] * sc, t1[5] * sc); w.w = pg8::cvt_pk_bf16(t1[6] * sc, t1[7] * sc);
                *(u32x4*)(rowp) = w;
                w.x = pg8::cvt_pk_bf16(t2[0] * sc, t2[1] * sc); w.y = pg8::cvt_pk_bf16(t2[2] * sc, t2[3] * sc); w.z = pg8::cvt_pk_bf16(t2[4] * sc, t2[5] * sc); w.w = pg8::cvt_pk_bf16(t2[6] * sc, t2[7] * sc);
                *(u32x4*)(rowp + 128) = w; }
    }
};

#define XB_TMO      128
#define XB_XCNT(j)  (256  + 64 * (j))
#define XB_XSUB(j)  (1280 + 64 * (j))
#define XB_XGEN(j)  (2304 + 64 * (j))
#define XB_TOP      3328
#define XB_TOPGEN   3392
#define XCD_BAR_WORDS 3456
#define XB_SPIN_CAP (1u << 22)
__device__ __forceinline__ unsigned xb_ld(unsigned* p)              { return __hip_atomic_load(p, __ATOMIC_RELAXED, __HIP_MEMORY_SCOPE_AGENT); }
__device__ __forceinline__ unsigned xb_add(unsigned* p, unsigned v) { return __hip_atomic_fetch_add(p, v, __ATOMIC_RELAXED, __HIP_MEMORY_SCOPE_AGENT); }
__device__ __forceinline__ unsigned xb_xcc_id() { return (unsigned)__builtin_amdgcn_s_getreg((3 << 11) | 20) & 0xFu; }
#define XB_SPIN(cond, bar) do { unsigned _sp = 0; while (cond) { __builtin_amdgcn_s_sleep(1); \
    if ((++_sp & 255u) == 0u) { if (xb_ld(&(bar)[XB_TMO])) break; if (_sp > XB_SPIN_CAP) { atomicAdd(&(bar)[XB_TMO], 1u); break; } } } } while (0)
struct XcdBarrier { unsigned* bar; unsigned x; volatile LAS unsigned* st; };
__device__ __forceinline__ XcdBarrier xcd_barrier_post(unsigned* bar, volatile LAS unsigned* st) {
    XcdBarrier b; b.bar = bar; b.x = xb_xcc_id(); b.st = st;
    if (threadIdx.x == 0) (void)xb_add(&bar[XB_XCNT(b.x)], 1u);
    return b;
}
__device__ __forceinline__ void xcd_barrier_complete(unsigned* bar, unsigned x, unsigned& nloc, unsigned& nx) {
    const unsigned G = gridDim.x * gridDim.y * gridDim.z;
    unsigned sum, cnt, mine, sp = 0u;
    for (;;) {
        sum = 0u; cnt = 0u; mine = 0u;
#pragma unroll
        for (unsigned j = 0; j < 16; ++j) { const unsigned c = xb_ld(&bar[XB_XCNT(j)]); sum += c; cnt += (c > 0u) ? 1u : 0u; mine = (j == x) ? c : mine; }
        if (sum == G) break;
        __builtin_amdgcn_s_sleep(1);
        if ((++sp & 255u) == 0u) { if (xb_ld(&bar[XB_TMO])) break; if (sp > XB_SPIN_CAP) { atomicAdd(&bar[XB_TMO], 1u); break; } }
    }
    nloc = mine > 0u ? mine : 1u; nx = cnt > 0u ? cnt : 1u;
}
__device__ __forceinline__ void xcd_barrier(const XcdBarrier& b) {
    asm volatile("s_waitcnt vmcnt(0)" ::: "memory");
    __syncthreads();
    if (threadIdx.x == 0) {
        unsigned* bar = b.bar;
        __builtin_amdgcn_s_waitcnt(0);
        unsigned nloc = b.st[0], nx = b.st[1];
        if (nloc == 0u) { xcd_barrier_complete(bar, b.x, nloc, nx); b.st[0] = nloc; b.st[1] = nx; }
        const unsigned old = xb_add(&bar[XB_XSUB(b.x)], 1u);
        const unsigned gen = old / nloc;
        if (old + 1u == (gen + 1u) * nloc) {
            __builtin_amdgcn_fence(__ATOMIC_RELEASE, "agent");
            asm volatile("s_waitcnt vmcnt(0)" ::: "memory");
            const unsigned og = xb_add(&bar[XB_TOP], 1u);
            const unsigned tg = og / nx;
            if (og + 1u == (tg + 1u) * nx) xb_add(&bar[XB_TOPGEN], 1u);
            else XB_SPIN(xb_ld(&bar[XB_TOPGEN]) == tg, bar);
            __builtin_amdgcn_fence(__ATOMIC_ACQUIRE, "agent");
            xb_add(&bar[XB_XGEN(b.x)], 1u);
            asm volatile("s_waitcnt vmcnt(0)" ::: "memory");
        } else {
            XB_SPIN(xb_ld(&bar[XB_XGEN(b.x)]) == gen, bar);
            __builtin_amdgcn_fence(__ATOMIC_ACQUIRE, "agent");
            asm volatile("s_waitcnt vmcnt(0)" ::: "memory");
        }
    }
    __syncthreads();
}

struct Args { const float* in[38]; float* out; unsigned char* ws; int ph_lo, ph_hi; };
enum { I_X = 0, I_C, I_CTX, I_CCTX, I_MODW, I_MODB, I_N1G, I_N2G, I_W1, I_W3, I_W2, I_FING, I_EWIN, I_EWOUT, I_LRE, I_LIM, I_LSTEP, I_BRE, I_BIM, I_CRE, I_CIM,
       I_S5D, I_GLUW, I_GLUB, I_DNCW, I_DNALOG, I_DNDT, I_DNNG, I_OWIN, I_OWOUT, I_LCW, I_LCB, I_LWA, I_LBA, I_LWX, I_LBX, I_LLAM, I_RTH };

constexpr int LDS_RING = 131072, LDS_CTL_OFF = 131072, LDS_BYTES = 147456;
constexpr int NW = 8;

DI void transpose_item(const float* W, int ldw, int k0, int n_src0, bf16* WT, int ldk, int dst_row0, LAS float* scr, int lane) {
#pragma unroll
    for (int i = 0; i < 8; ++i) { const int kk = i * 8 + (lane >> 3), c4 = (lane & 7) * 4; const f32x4 w = *(const f32x4*)(W + (size_t)(k0 + kk) * ldw + n_src0 + c4);
        scr[kk * 33 + c4] = w[0]; scr[kk * 33 + c4 + 1] = w[1]; scr[kk * 33 + c4 + 2] = w[2]; scr[kk * 33 + c4 + 3] = w[3]; }
    LDS_WAIT();
    const int c = lane & 7;
#pragma unroll
    for (int j = 0; j < 4; ++j) { const int n = (lane >> 3) + 8 * j; const LAS float* s = scr + (8 * c) * 33 + n;
        u32x4 o; o.x = pk2(s[0 * 33], s[1 * 33]); o.y = pk2(s[2 * 33], s[3 * 33]); o.z = pk2(s[4 * 33], s[5 * 33]); o.w = pk2(s[6 * 33], s[7 * 33]);
        *(u32x4*)(WT + (size_t)(dst_row0 + n) * ldk + k0 + 8 * c) = o; }
    LDS_WAIT();
}
DI void transpose_job(int it, const float* W, int K, int N, bf16* WT, int mode, int add, LAS float* scr, int lane) {
    const int nblk = N / 32, kb = it / nblk, nb = it % nblk, n0 = nb * 32;
    const int dr = mode ? ((n0 >> 7) * 256 + (n0 & 127) + add) : n0;
    transpose_item(W, N, kb * 64, n0, WT, K, dr, scr, lane);
}


#define BGW_ITEMS 67584
#define BGW_DECODE(it, LAYER) \
    const int job_ = (it) / 22528, idx_ = (it) - job_ * 22528; \
    const int KK_ = job_ < 2 ? 2048 : 5632, NN_ = job_ < 2 ? 5632 : 2048, kbs_ = KK_ >> 3; \
    const int nblk_ = idx_ / kbs_, kblk_ = idx_ - nblk_ * kbs_, n_ = nblk_ * 64 + lane; \
    const float* src_ = args.in[job_ == 0 ? I_W1 : (job_ == 1 ? I_W3 : I_W2)] + (size_t)(LAYER) * 2048 * 5632 + (size_t)(kblk_ * 8) * NN_ + n_; \
    const int row_ = job_ < 2 ? ((n_ >> 7) * 256 + (n_ & 127) + (job_ == 1 ? 128 : 0)) : n_; \
    bf16* dst_ = (bf16*)(WB + (job_ < 2 ? W_UP : W_DN)) + (size_t)row_ * KK_ + kblk_ * 8;
#define BGW_ISSUE(it, LAYER) do { if ((it) < BGW_ITEMS) { BGW_DECODE(it, LAYER) (void)dst_; \
        _Pragma("unroll") for (int e_ = 0; e_ < 8; ++e_) bgv[e_] = src_[(size_t)e_ * NN_]; bg_cur = (it); } else bg_cur = -1; } while (0)
#define BGW_STORE(LAYER) do { if (bg_cur >= 0) { BGW_DECODE(bg_cur, LAYER) (void)src_; \
        u32x4 w_; w_.x = pk2(bgv[0], bgv[1]); w_.y = pk2(bgv[2], bgv[3]); w_.z = pk2(bgv[4], bgv[5]); w_.w = pk2(bgv[6], bgv[7]); *(u32x4*)dst_ = w_; bg_cur = -1; } } while (0)

__global__ void __launch_bounds__(512, 2) fwd_kernel(Args args) {
    extern __shared__ __attribute__((aligned(16))) unsigned char lds_raw[];
    LAS unsigned char* lds = (LAS unsigned char*)lds_raw;
    const int tid0 = threadIdx.x;
    const int G = gridDim.x, bid = blockIdx.x;
    const int NGW = G * NW;
    unsigned char* ws = args.ws;
    float* MOD = (float*)(ws + WS_MOD);
    float* XC = (float*)(ws + WS_XC);
    bf16* XLb = (bf16*)(ws + WS_BIG + 340 * MiB);
    bf16* Hb = (bf16*)(ws + WS_H);
    bf16* MIX = (bf16*)(ws + WS_MIX);
    unsigned char* BIG = ws + WS_BIG;
    unsigned char* WB = ws + WS_W;
    float* SLAB = (float*)(BIG + 200 * MiB);
    float* T_ABAR = (float*)(ws + WS_TAB); float* T_APOW = (float*)(ws + WS_TAB + 65536); f32x2* T_ROPE = (f32x2*)(ws + WS_TAB + 131072);
    float* T_SPL = (float*)(ws + WS_TAB + 163840);
    float* T_BBR = (float*)(ws + WS_XC); float* T_BBI = (float*)(ws + WS_XC + MiB / 2);
    bf16* T_BBF = (bf16*)(ws + WS_TAB + MiB);
    bf16* T_CF = (bf16*)(ws + WS_TAB + MiB + MiB / 2);

    volatile LAS unsigned* CTLW = (volatile LAS unsigned*)(lds + LDS_CTL_OFF);
    for (int u = tid0; u < (LDS_BYTES - LDS_CTL_OFF) / 4; u += 512) CTLW[u] = 0u;
    __syncthreads();
#if MK_ONE_LAUNCH
    XcdBarrier bar = xcd_barrier_post((unsigned*)(ws + WS_CTL) + 4096, CTLW + 8);
#define SEAM() xcd_barrier(bar)
#else
#define SEAM() do {} while (0)
#endif
    const int lo = args.ph_lo, hi = args.ph_hi;
    int ph = 0;
#define PHASE_BEGIN if (ph >= lo && ph < hi) { int tid = tid0; asm volatile("" : "+v"(tid)); const int lane = tid & 63, wave = __builtin_amdgcn_readfirstlane(tid >> 6), gw = bid * NW + wave; (void)lane; (void)gw;
#define PHASE_END   if (ph + 1 < hi) SEAM(); } ++ph;

    PHASE_BEGIN
    {
        LAS float* sc = (LAS float*)lds;
        LAS float* red = (LAS float*)(lds + 40960);
        if (bid < 96) {
            for (int i = tid; i < 5 * 2048; i += 512) { const int r = i >> 11, k = i & 2047; const float v = r < 4 ? args.in[I_C][r * 2048 + k] : args.in[I_CCTX][k]; sc[i] = siluf_(v); }
            __syncthreads();
            for (int cb = bid; cb < 96; cb += G) {
                const int n0 = cb * 256, layer = n0 / 12288, nn = n0 % 12288;
                const float* W = args.in[I_MODW] + (size_t)layer * 2048 * 12288 + nn + lane * 4;
                float a[5][4];
#pragma unroll
                for (int r = 0; r < 5; ++r)
#pragma unroll
                    for (int j = 0; j < 4; ++j) a[r][j] = 0.f;
                const int kb = wave * 256;
#pragma unroll 8
                for (int k = kb; k < kb + 256; ++k) { const f32x4 w = *(const f32x4*)(W + (size_t)k * 12288);
#pragma unroll
                    for (int r = 0; r < 5; ++r) { const float s = sc[r * 2048 + k];
#pragma unroll
                        for (int j = 0; j < 4; ++j) a[r][j] += s * w[j]; } }
#pragma unroll
                for (int r = 0; r < 5; ++r)
#pragma unroll
                    for (int j = 0; j < 4; ++j) red[(wave * 5 + r) * 256 + lane * 4 + j] = a[r][j];
                __syncthreads();
                for (int i = tid; i < 5 * 256; i += 512) { const int r = i >> 8, cc = i & 255; float s = args.in[I_MODB][layer * 12288 + nn + cc];
#pragma unroll
                    for (int w = 0; w < 8; ++w) s += red[(w * 5 + r) * 256 + cc];
                    MOD[(size_t)(layer * 5 + r) * 12288 + nn + cc] = s; }
                __syncthreads();
            }
        }
        for (int i = bid * 512 + tid; i < 2 * 64 * 64 * 16; i += G * 512) {
            const int s = i & 15, p = (i >> 4) & 63, g = (i >> 10) & 63, d = i >> 16;
            const int ip = (d * 64 + g) * 64 + p;
            const float lre = fminf(args.in[I_LRE][ip], -1e-4f), lim = args.in[I_LIM][ip];
            const float dt = expf(args.in[I_LSTEP][d * 64 + g]);
            const float mag = expf(lre * dt); const float ar = mag * cosf(lim * dt), ai = mag * sinf(lim * dt);
            const float nr = ar - 1.f, ni = ai, den = lre * lre + lim * lim;
            const float cre = (nr * lre + ni * lim) / den, cim = (ni * lre - nr * lim) / den;
            const float br = args.in[I_BRE][(size_t)ip * 16 + s], bi = args.in[I_BIM][(size_t)ip * 16 + s];
            T_BBR[(size_t)ip * 16 + s] = cre * br - cim * bi; T_BBI[(size_t)ip * 16 + s] = cre * bi + cim * br;
            T_BBF[((size_t)(d * 64 + g) * 128 + p) * 16 + s] = (bf16)f2bf(cre * br - cim * bi); T_BBF[((size_t)(d * 64 + g) * 128 + 64 + p) * 16 + s] = (bf16)f2bf(cre * bi + cim * br);
            T_CF[((size_t)(d * 64 + g) * 16 + s) * 128 + p] = (bf16)f2bf(args.in[I_CRE][((size_t)(d * 64 + g) * 16 + s) * 64 + p]); T_CF[((size_t)(d * 64 + g) * 16 + s) * 128 + 64 + p] = (bf16)f2bf(-args.in[I_CIM][((size_t)(d * 64 + g) * 16 + s) * 64 + p]);
            if (s == 0) { T_ABAR[ip * 2] = ar; T_ABAR[ip * 2 + 1] = ai; float pr = ar, pi = ai;
#pragma unroll
                for (int q = 0; q < 6; ++q) { const float tr = pr * pr - pi * pi, ti = 2.f * pr * pi; pr = tr; pi = ti; }
                T_APOW[ip * 2] = pr; T_APOW[ip * 2 + 1] = pi; }
        }
        for (int i = bid * 512 + tid; i < 4096; i += G * 512) { const int p = i >> 6, f = i & 63; const float inv = powf(10000.f, -(float)f / 64.f); const float ang = (float)p * inv;
            f32x2 v; v.x = cosf(ang); v.y = sinf(ang); T_ROPE[i] = v; }
        for (int i = bid * 512 + tid; i < 2048; i += G * 512) T_SPL[i] = -8.f * softplusf_(-args.in[I_LLAM][i]);
        __syncthreads();
        LAS float* scr = (LAS float*)(lds + wave * 16384);
        constexpr int J0 = 32 * 161, J1 = 32 * 64, J2 = 16 * 32, J3 = 32 * 176, J4 = J3, J5 = 88 * 64;
        (void)J3; (void)J4; (void)J5;
        for (int it = gw; it < J0 + J1 + J2; it += NGW) {
            int r = it;
            if (r < J0) { transpose_job(r, args.in[I_EWIN], 2048, 5152, (bf16*)(WB + W_IN), 0, 0, scr, lane); continue; } r -= J0;
            if (r < J1) { transpose_job(r, args.in[I_EWOUT], 2048, 2048, (bf16*)(WB + W_OUT), 0, 0, scr, lane); continue; } r -= J1;
            transpose_job(r, args.in[I_GLUW], 1024, 1024, (bf16*)(WB + W_GLU), 0, 0, scr, lane);
        }
    }
    PHASE_END

#define ADALN(LAYER, WHICH, SRCBF, SRC_L, SRC_C, LATONLY, SLABP, SGATE) \
    for (int R = gw; R < MROWS; R += NGW) { const int b = R / SROW, s = R % SROW; const bool cx = s < CTX; if ((LATONLY) && cx) continue; \
        const float* md = MOD + (size_t)((LAYER) * 5 + (cx ? 4 : b)) * 12288 + (WHICH) * 3 * 2048; \
        const float* gn = args.in[(WHICH) ? I_N2G : I_N1G] + (LAYER) * 2048; \
        f32x4 v[8]; float ss = 0.f; \
        if ((SRCBF) && !cx) { const bf16* srcb = (const bf16*)(SRC_L) + ((size_t)b * SEQ + (s - CTX)) * DM; \
            _Pragma("unroll") for (int j = 0; j < 8; ++j) { const u32x2 w = *(const u32x2*)(srcb + lane * 4 + j * 256); v[j] = (f32x4){lo16(w.x), hi16(w.x), lo16(w.y), hi16(w.y)}; } } \
        else { const float* src = cx ? (SRC_C) + ((size_t)b * CTX + s) * DM : (const float*)(SRC_L) + ((size_t)b * SEQ + (s - CTX)) * DM; \
            _Pragma("unroll") for (int j = 0; j < 8; ++j) v[j] = *(const f32x4*)(src + lane * 4 + j * 256); } \
        if ((SLABP) != nullptr && cx) { const size_t crow = (size_t)b * CTX + s; \
            _Pragma("unroll") for (int j = 0; j < 8; ++j) { const int c = lane * 4 + j * 256; f32x4 a = (f32x4){0.f, 0.f, 0.f, 0.f}; \
                _Pragma("unroll") for (int sp = 0; sp < 8; ++sp) a += *(const f32x4*)((SLABP) + ((size_t)sp * 1024 + crow) * DM + c); \
                v[j] = v[j] + *(const f32x4*)((SGATE) + c) * a; *(f32x4*)(XC + crow * DM + c) = v[j]; } } \
        _Pragma("unroll") for (int j = 0; j < 8; ++j) ss += (v[j][0] * v[j][0] + v[j][1] * v[j][1]) + (v[j][2] * v[j][2] + v[j][3] * v[j][3]); \
        const float rstd = __builtin_amdgcn_rsqf(wave_sum(ss) * (1.f / DM) + EPS); \
        _Pragma("unroll") for (int j = 0; j < 8; ++j) { const int c = lane * 4 + j * 256; const f32x4 gg = *(const f32x4*)(gn + c), sh = *(const f32x4*)(md + c), sl = *(const f32x4*)(md + 2048 + c); \
            const f32x4 o = v[j] * rstd * gg * (sl + 1.f) + sh; u32x2 w; w.x = pk2(o[0], o[1]); w.y = pk2(o[2], o[3]); *(u32x2*)(Hb + (size_t)R * DM + c) = w; } }

    PHASE_BEGIN
    ADALN(0, 0, false, args.in[I_X], args.in[I_CTX], false, (const float*)nullptr, (const float*)nullptr)
    PHASE_END

    PHASE_BEGIN
    { pg8::Gemm g{Hb, (const bf16*)(WB + W_IN), DM, DM, DM}; pg8::StaticOrder S; S.init(68, 21, G, bid, 0);
      EpiIn0 E{(bf16*)(BIG + B_IN0), (float*)(BIG + B_AB)};
      pg8::gemm_phase<EpiIn0>(lds, g, S, E); }
    PHASE_END

#define S5_PASS(READOUT) { \
        const bf16* IN0 = (const bf16*)(BIG + B_IN0); \
        LAS float* BU = (LAS float*)(lds + wave * 12800); LAS unsigned char* HB = lds + wave * 12800 + 8448; \
        const int r = lane & 15, q = lane >> 4; \
        const int NU = (READOUT) ? NB * 64 * NCH : NB * 64 * 2 * NCH; \
        for (int unit = gw; unit < NU; unit += NGW) { \
            const int g = unit & 63; int rest = unit >> 6; int dsel = 0; if (!(READOUT)) { dsel = rest & 1; rest >>= 1; } const int c = rest % NCH, b = rest / NCH;     \
            const int R0 = b * SROW + c * 64; \
            s16x4 Uf[4];     \
            _Pragma("unroll") for (int tt = 0; tt < 4; ++tt) Uf[tt] = *(const s16x4*)(IN0 + (size_t)(R0 + 16 * tt + r) * IN0_LD + g * 16 + 4 * q); \
            f32x4 Y[4]; \
            _Pragma("unroll") for (int tt = 0; tt < 4; ++tt) Y[tt] = (f32x4){0.f, 0.f, 0.f, 0.f}; \
            for (int dd = 0; dd < ((READOUT) ? 2 : 1); ++dd) { \
                const int dir = (READOUT) ? dd : dsel; \
                s16x4 Bf[8]; bf16x8 Cf[4]; \
                _Pragma("unroll") for (int pt = 0; pt < 8; ++pt) Bf[pt] = *(const s16x4*)(T_BBF + ((size_t)(dir * 64 + g) * 128 + 16 * pt + r) * 16 + 4 * q); \
                if (READOUT) { _Pragma("unroll") for (int ks = 0; ks < 4; ++ks) Cf[ks] = *(const bf16x8*)(T_CF + ((size_t)(dir * 64 + g) * 16 + r) * 128 + 32 * ks + 8 * q); } \
                const int ip = (dir * 64 + g) * 64 + lane; \
                const float ar = T_ABAR[ip * 2], ai = T_ABAR[ip * 2 + 1]; \
                float hr = 0.f, hi = 0.f; \
                if (READOUT) { const float* st = (const float*)(BIG + B_S5S) + ((((size_t)(b * 64 + g) * 2 + dir) * NCH + c) * 64 + lane) * 2; hr = st[0]; hi = st[1]; } \
                for (int ti = 0; ti < 4; ++ti) { const int tt = dir ? 3 - ti : ti; \
                    _Pragma("unroll") for (int pt = 0; pt < 8; ++pt) { const f32x4 cc = __builtin_amdgcn_mfma_f32_16x16x16bf16_1k(Uf[tt], Bf[pt], ((f32x4){0.f, 0.f, 0.f, 0.f}), 0, 0, 0); \
                        _Pragma("unroll") for (int jj = 0; jj < 4; ++jj) BU[(4 * q + jj) * 132 + 16 * pt + r] = cc[jj]; } \
                    LDS_WAIT(); \
                    _Pragma("unroll") for (int i = 0; i < 16; ++i) { const int tl = dir ? 15 - i : i; \
                        const float bur = BU[tl * 132 + lane], bui = BU[tl * 132 + 64 + lane]; \
                        const float nr = ar * hr - ai * hi + bur, ni = ar * hi + ai * hr + bui; hr = nr; hi = ni; \
                        if (READOUT) { *(LAS bf16*)(HB + tl * 272 + lane * 2) = (bf16)f2bf(hr); *(LAS bf16*)(HB + tl * 272 + 128 + lane * 2) = (bf16)f2bf(hi); } } \
                    if (READOUT) { LDS_WAIT(); \
                        _Pragma("unroll") for (int ks = 0; ks < 4; ++ks) Y[tt] = MFMA16(frag_rows(HB, 272, 0, 32 * ks, r, q), Cf[ks], Y[tt]); } \
                    LDS_WAIT(); \
                } \
                if (!(READOUT)) { float* e = (float*)(BIG + B_S5E) + ((((size_t)(b * 64 + g) * 2 + dir) * NCH + c) * 64 + lane) * 2; e[0] = hr; e[1] = hi; } \
            } \
            if (READOUT) { const float dsk = args.in[I_S5D][g * 16 + r]; \
                _Pragma("unroll") for (int tt = 0; tt < 4; ++tt) \
                    _Pragma("unroll") for (int jj = 0; jj < 4; ++jj) { const size_t R = (size_t)(R0 + 16 * tt + 4 * q + jj); const float uu = bf2f(IN0[R * IN0_LD + g * 16 + r]); \
                        ((bf16*)(BIG + B_S5Y))[R * 1024 + g * 16 + r] = (bf16)f2bf(gelu_tanh(Y[tt][jj] + dsk * uu)); } } \
        } }

#define S5_ENDSTATE() { \
        const bf16* IN0 = (const bf16*)(BIG + B_IN0); \
        LAS float* ubuf = (LAS float*)(lds + wave * 4096); \
        for (int unit = gw; unit < NB * 64 * 2 * NCH; unit += NGW) { \
            const int g = unit & 63; int rest = unit >> 6; const int dir = rest & 1; rest >>= 1; const int c = rest % NCH, b = rest / NCH; \
            const int R0 = b * SROW + c * 64; \
            { const u32x4* up = (const u32x4*)(IN0 + (size_t)(R0 + lane) * IN0_LD + g * 16); const u32x4 w0 = up[0], w1 = up[1]; \
              *(LAS f32x4*)(ubuf + lane * 16) = (f32x4){lo16(w0.x), hi16(w0.x), lo16(w0.y), hi16(w0.y)}; *(LAS f32x4*)(ubuf + lane * 16 + 4) = (f32x4){lo16(w0.z), hi16(w0.z), lo16(w0.w), hi16(w0.w)}; \
              *(LAS f32x4*)(ubuf + lane * 16 + 8) = (f32x4){lo16(w1.x), hi16(w1.x), lo16(w1.y), hi16(w1.y)}; *(LAS f32x4*)(ubuf + lane * 16 + 12) = (f32x4){lo16(w1.z), hi16(w1.z), lo16(w1.w), hi16(w1.w)}; } \
            const int ip = (dir * 64 + g) * 64 + lane; \
            f32x2 cB[16]; \
            _Pragma("unroll") for (int q = 0; q < 4; ++q) { const f32x4 x = *(const f32x4*)(T_BBR + (size_t)ip * 16 + 4 * q), y = *(const f32x4*)(T_BBI + (size_t)ip * 16 + 4 * q); \
                _Pragma("unroll") for (int j = 0; j < 4; ++j) cB[4 * q + j] = (f32x2){x[j], y[j]}; } \
            const float ar = T_ABAR[ip * 2], ai = T_ABAR[ip * 2 + 1]; \
            float hr = 0.f, hi = 0.f; \
            LDS_WAIT(); \
            _Pragma("unroll 4") for (int ti = 0; ti < 64; ++ti) { const int t = dir ? 63 - ti : ti; \
                f32x2 bu0 = (f32x2){0.f, 0.f}, bu1 = (f32x2){0.f, 0.f}; \
                _Pragma("unroll") for (int q = 0; q < 4; ++q) { const f32x4 uu = *(const LAS f32x4*)(ubuf + t * 16 + 4 * q); \
                    bu0 = __builtin_elementwise_fma(cB[4 * q], (f32x2){uu[0], uu[0]}, bu0); bu1 = __builtin_elementwise_fma(cB[4 * q + 1], (f32x2){uu[1], uu[1]}, bu1); \
                    bu0 = __builtin_elementwise_fma(cB[4 * q + 2], (f32x2){uu[2], uu[2]}, bu0); bu1 = __builtin_elementwise_fma(cB[4 * q + 3], (f32x2){uu[3], uu[3]}, bu1); } \
                const f32x2 bu = bu0 + bu1; \
                const float nr = ar * hr - ai * hi + bu[0], ni = ar * hi + ai * hr + bu[1]; hr = nr; hi = ni; } \
            { float* e = (float*)(BIG + B_S5E) + ((((size_t)(b * 64 + g) * 2 + dir) * NCH + c) * 64 + lane) * 2; e[0] = hr; e[1] = hi; } \
            LDS_WAIT(); \
        } }

    PHASE_BEGIN
    S5_PASS(false)
    {
    {
        const bf16* IN0 = (const bf16*)(BIG + B_IN0); const float* AB = (const float*)(BIG + B_AB);
        bf16* DQ = (bf16*)(BIG + B_DNQ); bf16* DK = (bf16*)(BIG + B_DNK); bf16* DV = (bf16*)(BIG + B_DNV);
        float* DG = (float*)(BIG + B_DNG); float* DBt = (float*)(BIG + B_DNB);
        const float* cw = args.in[I_DNCW];
        int cur_combo = -1; f32x4 wv[8];
        for (int item = gw; item < MROWS * 6; item += NGW) {
            const int combo = item / MROWS, R = item - combo * MROWS, part = combo >> 1, hq = combo & 1;
            const int b = R / SROW, sx = R - b * SROW;
            const int seg_lo = sx < CTX ? 0 : CTX, seg_hi = sx < CTX ? CTX : SROW;
            const int cidx = part * 1024 + hq * 512 + lane * 8;
            if (combo != cur_combo) { cur_combo = combo;
#pragma unroll
                for (int e = 0; e < 8; ++e) wv[e] = *(const f32x4*)(cw + (size_t)(cidx + e) * 4); }
            float acc[8];
#pragma unroll
            for (int e = 0; e < 8; ++e) acc[e] = 0.f;
#pragma unroll
            for (int j = 0; j < 4; ++j) { const int sj = sx + j - 2;
                if (sj >= seg_lo && sj < seg_hi) { const u32x4 w = *(const u32x4*)(IN0 + (size_t)(b * SROW + sj) * IN0_LD + 1024 + cidx);
                    acc[0] += wv[0][j] * lo16(w.x); acc[1] += wv[1][j] * hi16(w.x); acc[2] += wv[2][j] * lo16(w.y); acc[3] += wv[3][j] * hi16(w.y);
                    acc[4] += wv[4][j] * lo16(w.z); acc[5] += wv[5][j] * hi16(w.z); acc[6] += wv[6][j] * lo16(w.w); acc[7] += wv[7][j] * hi16(w.w); } }
            float ss = 0.f;
#pragma unroll
            for (int e = 0; e < 8; ++e) { acc[e] = acc[e] * __builtin_amdgcn_rcpf(1.f + __expf(-acc[e])); ss += acc[e] * acc[e]; }
            ss += __shfl_xor(ss, 1); ss += __shfl_xor(ss, 2); ss += __shfl_xor(ss, 4); ss += __shfl_xor(ss, 8);
            const float sc = part == 0 ? 0.08838834764831845f * __builtin_amdgcn_rsqf(ss + EPS) : (part == 1 ? __builtin_amdgcn_rsqf(ss + EPS) : 1.f);
            u32x4 o; o.x = pk2(acc[0] * sc, acc[1] * sc); o.y = pk2(acc[2] * sc, acc[3] * sc); o.z = pk2(acc[4] * sc, acc[5] * sc); o.w = pk2(acc[6] * sc, acc[7] * sc);
            bf16* dst = part == 0 ? DQ : (part == 1 ? DK : DV);
            *(u32x4*)(dst + (size_t)R * 1024 + hq * 512 + lane * 8) = o;
        }
        for (int i = bid * 512 + tid; i < MROWS * 16; i += G * 512) { const int R = i >> 4, l16 = i & 15;
            const float araw = AB[(size_t)R * 32 + l16], braw = AB[(size_t)R * 32 + 16 + l16];
            DG[i] = -expf(args.in[I_DNALOG][l16]) * softplusf_(araw + args.in[I_DNDT][l16]);
            DBt[i] = sigmoidf_(braw); }
    }
    }
    PHASE_END

    PHASE_BEGIN
    {
        for (int i = bid * 512 + tid; i < NB * 64 * 2 * 64; i += G * 512) {
            const int p = i & 63, dir = (i >> 6) & 1, bg = i >> 7, g = bg & 63;
            const int ip = (dir * 64 + g) * 64 + p; const float pr = T_APOW[ip * 2], pi = T_APOW[ip * 2 + 1];
            const float* E = (const float*)(BIG + B_S5E) + ((size_t)(bg * 2 + dir) * NCH) * 128 + p * 2;
            float* St = (float*)(BIG + B_S5S) + ((size_t)(bg * 2 + dir) * NCH) * 128 + p * 2;
            float sr = 0.f, si = 0.f;
            for (int k = 0; k < NCH; ++k) { const int c = dir == 0 ? k : (k < 4 ? 3 - k : 71 - k);
                St[c * 128] = sr; St[c * 128 + 1] = si; const float er = E[c * 128], ei = E[c * 128 + 1];
                const float nr = pr * sr - pi * si + er, ni = pr * si + pi * sr + ei; sr = nr; si = ni; }
        }
        {
            const bf16* DK = (const bf16*)(BIG + B_DNK); const float* DG = (const float*)(BIG + B_DNG); const float* DBt = (const float*)(BIG + B_DNB);
            bf16* TINV = (bf16*)((unsigned char*)MIX + MIX_TINV); bf16* WT = Hb; float* GCUM = (float*)(BIG + B_GCUM);
            constexpr int KC = 0, KB = 17408, KG = 34816, PA = 52224, PB = 61440, TA = 70656, TB = 79872, LO = 36864, WSo = 0  , GCo = 125952, BTo = 126208, RS = 272, PS = 144;
            const int r = lane & 15, q = lane >> 4, qq = r >> 2, pp = r & 3, it = wave >> 1, nh = wave & 1;
            LAS float* GC = (LAS float*)(lds + GCo); LAS float* BT = (LAS float*)(lds + BTo);
#define DN_ROW(n, row) ((size_t)b * SROW + (dir == 0 ? ((n) * 64 + (row)) : (((n) * 64 + (row)) < CTX ? CTX - 1 - ((n) * 64 + (row)) : SROW + CTX - 1 - ((n) * 64 + (row)))))
            for (int i = tid; i < 36864 / 4; i += 512) { ((LAS unsigned*)(lds + PA))[i] = 0u; ((LAS unsigned*)(lds + PA + LO))[i] = 0u; }
            __syncthreads();
            for (int unit = bid; unit < NB * 8 * 2 * NCH; unit += G) {
                const int n = unit % NCH; int rest = unit / NCH; const int dir = rest & 1; rest >>= 1; const int h = rest & 7, b = rest >> 3;
                u32x4 kreg[2];
#pragma unroll
                for (int k = 0; k < 2; ++k) { const int id = tid + 512 * k, row = id >> 4, cp = id & 15; kreg[k] = *(const u32x4*)(DK + DN_ROW(n, row) * 1024 + h * 128 + cp * 8); }
                if (wave == 0) { const size_t R = DN_ROW(n, lane); float g = DG[R * 16 + dir * 8 + h]; const float bt = DBt[R * 16 + dir * 8 + h];
#pragma unroll
                    for (int o = 1; o < 64; o <<= 1) { const float t = __shfl_up(g, o); if (lane >= o) g += t; }
                    GC[lane] = g; BT[lane] = bt; GCUM[(size_t)unit * 64 + lane] = g; }
                __syncthreads();
#pragma unroll
                for (int k = 0; k < 2; ++k) { const int id = tid + 512 * k, row = id >> 4, cp = id & 15; const float bt = BT[row], bg = bt * __expf(GC[row]);
                    const u32x4 w = kreg[k];
                    *(LAS u32x4*)(lds + KC + row * RS + cp * 16) = w;
                    u32x4 x; x.x = pk2(lo16(w.x) * bt, hi16(w.x) * bt); x.y = pk2(lo16(w.y) * bt, hi16(w.y) * bt); x.z = pk2(lo16(w.z) * bt, hi16(w.z) * bt); x.w = pk2(lo16(w.w) * bt, hi16(w.w) * bt);
                    *(LAS u32x4*)(lds + KB + row * RS + cp * 16) = x;
                    x.x = pk2(lo16(w.x) * bg, hi16(w.x) * bg); x.y = pk2(lo16(w.y) * bg, hi16(w.y) * bg); x.z = pk2(lo16(w.z) * bg, hi16(w.z) * bg); x.w = pk2(lo16(w.w) * bg, hi16(w.w) * bg);
                    *(LAS u32x4*)(lds + KG + row * RS + cp * 16) = x; }
                __syncthreads();
#pragma unroll
                for (int e = 0; e < 2; ++e) { const int jt = 2 * nh + e; f32x4 c = (f32x4){0.f, 0.f, 0.f, 0.f};
                    if (jt <= it) {
#pragma unroll
                        for (int ks = 0; ks < 4; ++ks) c = MFMA16(frag_rows(lds + KC, RS, 16 * jt, 32 * ks, r, q), frag_rows(lds + KB, RS, 16 * it, 32 * ks, r, q), c);
                        const float gi = GC[16 * it + r]; const f32x4 gj = *(const LAS f32x4*)(GC + 16 * jt + 4 * q);
#pragma unroll
                        for (int jj = 0; jj < 4; ++jj) c[jj] = (16 * jt + 4 * q + jj < 16 * it + r) ? -c[jj] * __expf(gi - gj[jj]) : 0.f; }
                    st_hl(lds + PA + (16 * it + r) * PS + (16 * jt + 4 * q) * 2, LO, c);
                    if (jt == it) {
#pragma unroll
                        for (int jj = 0; jj < 4; ++jj) if (4 * q + jj == r) c[jj] = 1.f; }
                    st_hl(lds + TA + (16 * it + r) * PS + (16 * jt + 4 * q) * 2, LO, c); }
                __syncthreads();
#pragma unroll
                for (int st = 1; st <= 6; ++st) {
                    LAS unsigned char* Pc = lds + ((st & 1) ? PA : PB); LAS unsigned char* Pn = lds + ((st & 1) ? PB : PA);
                    LAS unsigned char* Tc = lds + ((st & 1) ? TB : TA); LAS unsigned char* Tn = lds + ((st & 1) ? TA : TB);
                    if (st == 1) { Tc = lds + TA; }
                    f32x4 cP[2], cT[2];
#pragma unroll
                    for (int e = 0; e < 2; ++e) { const int nt = 2 * nh + e; cP[e] = (f32x4){0.f, 0.f, 0.f, 0.f}; cT[e] = (f32x4){0.f, 0.f, 0.f, 0.f};
                        if (st >= 2) { const u32x2 t0 = *(const LAS u32x2*)(Tc + (16 * it + r) * PS + (16 * nt + 4 * q) * 2), t1 = *(const LAS u32x2*)(Tc + LO + (16 * it + r) * PS + (16 * nt + 4 * q) * 2);
                            cT[e] = (f32x4){lo16(t0.x) + lo16(t1.x), hi16(t0.x) + hi16(t1.x), lo16(t0.y) + lo16(t1.y), hi16(t0.y) + hi16(t1.y)}; } }
                    {
#pragma unroll
                        for (int kb = 0; kb < 2; ++kb) {
                            bf16x8 rPh, rPl, rTh, rTl;
                            if (st <= 5) { rPh = frag_rows(Pc, PS, 16 * it, 32 * kb, r, q); rPl = frag_rows(Pc + LO, PS, 16 * it, 32 * kb, r, q); }
                            if (st >= 2) { rTh = frag_rows(Tc, PS, 16 * it, 32 * kb, r, q); rTl = frag_rows(Tc + LO, PS, 16 * it, 32 * kb, r, q); }
#pragma unroll
                            for (int e = 0; e < 2; ++e) { const int nt = 2 * nh + e;
                                { const bf16x8 th = frag_tr(Pc, PS, 32 * kb, 16 * nt, q, qq, pp), tl = frag_tr(Pc + LO, PS, 32 * kb, 16 * nt, q, qq, pp);
                                    if (st <= 5) cP[e] = mm3(cP[e], th, tl, rPh, rPl);
                                    if (st >= 2) cT[e] = mm3(cT[e], th, tl, rTh, rTl); } }
                        }
#pragma unroll
                        for (int e = 0; e < 2; ++e) { const int nt = 2 * nh + e;
                            { if (st <= 5) st_hl(Pn + (16 * it + r) * PS + (16 * nt + 4 * q) * 2, LO, cP[e]);
                                if (st >= 2) st_hl(Tn + (16 * it + r) * PS + (16 * nt + 4 * q) * 2, LO, cT[e]); } }
                    }
                    __syncthreads();
                }
#pragma unroll
                for (int e = 0; e < 4; ++e) { const int nt = 4 * nh + e; f32x4 c = (f32x4){0.f, 0.f, 0.f, 0.f};
#pragma unroll
                    for (int kb = 0; kb < 2; ++kb) c = MFMA16(frag_tr(lds + KG, RS, 32 * kb, 16 * nt, q, qq, pp), frag_rows(lds + TB, PS, 16 * it, 32 * kb, r, q), c);
                    u32x2 w; w.x = pk2(-c[0], -c[1]); w.y = pk2(-c[2], -c[3]); *(LAS u32x2*)(lds + WSo + (16 * it + r) * RS + (16 * nt + 4 * q) * 2) = w; }
                __syncthreads();
#pragma unroll
                for (int k = 0; k < 2; ++k) { const int id = tid + 512 * k, row = id >> 4, cp = id & 15; *(u32x4*)(WT + ((size_t)unit * 64 + row) * 128 + cp * 8) = *(const LAS u32x4*)(lds + WSo + row * RS + cp * 16); }
                { const int row = tid >> 3, cp = tid & 7; *(u32x4*)(TINV + ((size_t)unit * 64 + row) * 64 + cp * 8) = *(const LAS u32x4*)(lds + TB + row * PS + cp * 16); }
            }
        }
    }
    PHASE_END

    PHASE_BEGIN
    {
        const bf16* DQ = (const bf16*)(BIG + B_DNQ); const bf16* DK = (const bf16*)(BIG + B_DNK); const bf16* DV = (const bf16*)(BIG + B_DNV);
        const float* DBt = (const float*)(BIG + B_DNB); const bf16* TINV = (const bf16*)((unsigned char*)MIX + MIX_TINV); const bf16* WT = Hb; const float* GCUM = (const float*)(BIG + B_GCUM);
        constexpr int QC0 = 0, KC0 = 17408, QC1 = 34816, KC1 = 52224, WC = 69632, TI = 87040, VB = 96256, VN = 101376, VD = 105984, ST0 = 110592, ST1 = 119296, GS0 = 128000, GS1 = 128768, RS = 272, PS = 144, VBS = 80;
        const int r = lane & 15, q = lane >> 4, qq = r >> 2, pp = r & 3, it = wave >> 1, ct = wave & 1;
        for (int unit0 = bid; unit0 < NB * 8 * 2 * 4; unit0 += G) {
            const int unit = (unit0 & 7) * 32 + (unit0 >> 3);
            const int sl = unit & 3, dir = (unit >> 2) & 1, h = (unit >> 3) & 7, b = unit >> 6;
            const size_t ubase = (size_t)((b * 8 + h) * 2 + dir) * NCH;
            bf16* DO = (bf16*)(BIG + (dir ? B_DNO1 : B_DNO0));
            f32x4 Sacc[2] = {(f32x4){0.f, 0.f, 0.f, 0.f}, (f32x4){0.f, 0.f, 0.f, 0.f}};
            u32x4 rq[2], rk[2], rw[2], rt, rv; float rbeta = 0.f, rgc = 0.f;
#define DNB_LOAD(n) do { _Pragma("unroll") for (int k = 0; k < 2; ++k) { const int id = tid + 512 * k, row = id >> 4, cp = id & 15; const size_t R = DN_ROW(n, row); \
                    rq[k] = *(const u32x4*)(DQ + R * 1024 + h * 128 + cp * 8); rk[k] = *(const u32x4*)(DK + R * 1024 + h * 128 + cp * 8); \
                    rw[k] = *(const u32x4*)(WT + ((ubase + (n)) * 64 + row) * 128 + cp * 8); } \
                { const int row = tid >> 3, cp = tid & 7; rt = *(const u32x4*)(TINV + ((ubase + (n)) * 64 + row) * 64 + cp * 8); } \
                if (tid < 256) { const int row = tid >> 2, cp = tid & 3; const size_t R = DN_ROW(n, row); rv = *(const u32x4*)(DV + R * 1024 + h * 128 + sl * 32 + cp * 8); rbeta = DBt[R * 16 + dir * 8 + h]; } \
                if (tid < 64) rgc = GCUM[(ubase + (n)) * 64 + tid]; } while (0)
#define DNB_STAGE(QCo, KCo, GSo) do { _Pragma("unroll") for (int k = 0; k < 2; ++k) { const int id = tid + 512 * k, row = id >> 4, cp = id & 15; \
                    *(LAS u32x4*)(lds + (QCo) + row * RS + cp * 16) = rq[k]; *(LAS u32x4*)(lds + (KCo) + row * RS + cp * 16) = rk[k]; *(LAS u32x4*)(lds + WC + row * RS + cp * 16) = rw[k]; } \
                { const int row = tid >> 3, cp = tid & 7; *(LAS u32x4*)(lds + TI + row * PS + cp * 16) = rt; } \
                if (tid < 256) { const int row = tid >> 2, cp = tid & 3; u32x4 x; x.x = pk2(lo16(rv.x) * rbeta, hi16(rv.x) * rbeta); x.y = pk2(lo16(rv.y) * rbeta, hi16(rv.y) * rbeta); \
                    x.z = pk2(lo16(rv.z) * rbeta, hi16(rv.z) * rbeta); x.w = pk2(lo16(rv.w) * rbeta, hi16(rv.w) * rbeta); *(LAS u32x4*)(lds + VB + row * VBS + cp * 16) = x; } \
                if (tid < 64) { const float gl = __shfl(rgc, 63); LAS float* gs = (LAS float*)(lds + (GSo)); gs[tid] = rgc; gs[64 + tid] = __expf(rgc); gs[128 + tid] = __expf(gl - rgc); } } while (0)
            for (int i = tid; i < 8704 / 4; i += 512) ((LAS unsigned*)(lds + ST0))[i] = 0u;
            DNB_LOAD(0);
            DNB_STAGE(QC0, KC0, GS0);
            if (NCH > 1) DNB_LOAD(1);
            __syncthreads();
            float bgv[8]; int bg_cur = -1; int bg_it = gw;
            for (int n = 0; n < NCH; ++n) {
                BGW_STORE(0); BGW_ISSUE(bg_it, 0); bg_it += NGW;
                LAS unsigned char* QC = lds + ((n & 1) ? QC1 : QC0); LAS unsigned char* KC = lds + ((n & 1) ? KC1 : KC0);
                LAS float* GS = (LAS float*)(lds + ((n & 1) ? GS1 : GS0));
                LAS unsigned char* STc = lds + ((n & 1) ? ST1 : ST0); LAS unsigned char* STn = lds + ((n & 1) ? ST0 : ST1);
                { f32x4 c = (f32x4){0.f, 0.f, 0.f, 0.f};
#pragma unroll
                  for (int kb = 0; kb < 2; ++kb) c = MFMA16(frag_rows(lds + TI, PS, 16 * it, 32 * kb, r, q), frag_tr(lds + VB, VBS, 32 * kb, 16 * ct, q, qq, pp), c);
#pragma unroll
                  for (int ks = 0; ks < 4; ++ks) c = MFMA16(frag_rows(lds + WC, RS, 16 * it, 32 * ks, r, q), frag_rows(STc, RS, 16 * ct, 32 * ks, r, q), c);
                  const f32x4 ed = *(const LAS f32x4*)(GS + 128 + 16 * it + 4 * q);
                  u32x2 w; w.x = pk2(c[0], c[1]); w.y = pk2(c[2], c[3]); *(LAS u32x2*)(lds + VN + (16 * ct + r) * PS + (16 * it + 4 * q) * 2) = w;
                  w.x = pk2(c[0] * ed[0], c[1] * ed[1]); w.y = pk2(c[2] * ed[2], c[3] * ed[3]); *(LAS u32x2*)(lds + VD + (16 * ct + r) * PS + (16 * it + 4 * q) * 2) = w; }
                __syncthreads();
                if (n + 1 < NCH) { if (n & 1) DNB_STAGE(QC0, KC0, GS0); else DNB_STAGE(QC1, KC1, GS1); }
                if (n + 2 < NCH) DNB_LOAD(n + 2);
                { const float egl = GS[64 + 63];
#pragma unroll
                  for (int e = 0; e < 2; ++e) { f32x4 c = Sacc[e] * egl;
#pragma unroll
                      for (int kb = 0; kb < 2; ++kb) c = MFMA16(frag_tr(KC, RS, 32 * kb, 16 * wave, q, qq, pp), frag_rows(lds + VD, PS, 16 * e, 32 * kb, r, q), c);
                      Sacc[e] = c;
                      u32x2 w; w.x = pk2(c[0], c[1]); w.y = pk2(c[2], c[3]); *(LAS u32x2*)(STn + (16 * e + r) * RS + (16 * wave + 4 * q) * 2) = w; } }
                { f32x4 o = (f32x4){0.f, 0.f, 0.f, 0.f};
                  bf16x8 Qf[4];
#pragma unroll
                  for (int ks = 0; ks < 4; ++ks) Qf[ks] = frag_rows(QC, RS, 16 * it, 32 * ks, r, q);
#pragma unroll
                  for (int ks = 0; ks < 4; ++ks) o = MFMA16(Qf[ks], frag_rows(STc, RS, 16 * ct, 32 * ks, r, q), o);
                  { const f32x4 eg = *(const LAS f32x4*)(GS + 64 + 16 * it + 4 * q); o = o * eg; }
                  const float gi = GS[16 * it + r];
#pragma unroll
                  for (int kp = 0; kp < 2; ++kp) {
                      if (2 * kp <= it) { f32x4 pt[2];
#pragma unroll
                          for (int e = 0; e < 2; ++e) { const int jt = 2 * kp + e; f32x4 c = (f32x4){0.f, 0.f, 0.f, 0.f};
                              if (jt <= it) {
#pragma unroll
                                  for (int ks = 0; ks < 4; ++ks) c = MFMA16(frag_rows(KC, RS, 16 * jt, 32 * ks, r, q), Qf[ks], c);
                                  const f32x4 gj = *(const LAS f32x4*)(GS + 16 * jt + 4 * q);
#pragma unroll
                                  for (int jj = 0; jj < 4; ++jj) c[jj] = (16 * jt + 4 * q + jj <= 16 * it + r) ? c[jj] * __expf(gi - gj[jj]) : 0.f; }
                              pt[e] = c; }
                          o = MFMA16(pack_pair(pt[0], pt[1]), frag_rows_perm(lds + VN, PS, 16 * ct, 32 * kp, r, q), o); }
                  }
#pragma unroll
                  for (int jj = 0; jj < 4; ++jj) { const size_t R = DN_ROW(n, 16 * it + 4 * q + jj); DO[R * 1024 + h * 128 + sl * 32 + 16 * ct + r] = (bf16)f2bf(o[jj]); } }
                __syncthreads();
            }
            BGW_STORE(0);
            for (; bg_it < BGW_ITEMS; bg_it += NGW) { BGW_ISSUE(bg_it, 0); BGW_STORE(0); }
        }
#undef DNB_LOAD
#undef DNB_STAGE
    }
    S5_PASS(true)
    PHASE_END

    PHASE_BEGIN
    {
        const bf16* O0 = (const bf16*)(BIG + B_DNO0); const bf16* O1 = (const bf16*)(BIG + B_DNO1); const bf16* IN0 = (const bf16*)(BIG + B_IN0);
        const f32x4 g0 = *(const f32x4*)(args.in[I_DNNG] + (lane & 15) * 8), g1 = *(const f32x4*)(args.in[I_DNNG] + (lane & 15) * 8 + 4);
        for (int item = gw; item < MROWS * 2; item += NGW) {
            const int R = item >> 1, hq = item & 1; const size_t o = (size_t)R * 1024 + hq * 512 + lane * 8;
            const u32x4 a = *(const u32x4*)(O0 + o), c = *(const u32x4*)(O1 + o), gt = *(const u32x4*)(IN0 + (size_t)R * IN0_LD + 4096 + hq * 512 + lane * 8);
            float v[8] = {lo16(a.x) + lo16(c.x), hi16(a.x) + hi16(c.x), lo16(a.y) + lo16(c.y), hi16(a.y) + hi16(c.y), lo16(a.z) + lo16(c.z), hi16(a.z) + hi16(c.z), lo16(a.w) + lo16(c.w), hi16(a.w) + hi16(c.w)};
            float ss = 0.f;
#pragma unroll
            for (int e = 0; e < 8; ++e) ss += v[e] * v[e];
            ss += __shfl_xor(ss, 1); ss += __shfl_xor(ss, 2); ss += __shfl_xor(ss, 4); ss += __shfl_xor(ss, 8);
            const float rs = __builtin_amdgcn_rsqf(ss * (1.f / 128.f) + EPS);
            const float gv[8] = {lo16(gt.x), hi16(gt.x), lo16(gt.y), hi16(gt.y), lo16(gt.z), hi16(gt.z), lo16(gt.w), hi16(gt.w)};
            const float ng[8] = {g0[0], g0[1], g0[2], g0[3], g1[0], g1[1], g1[2], g1[3]};
            float y[8];
#pragma unroll
            for (int e = 0; e < 8; ++e) y[e] = v[e] * rs * ng[e] * siluf_(gv[e]);
            u32x4 w; w.x = pk2(y[0], y[1]); w.y = pk2(y[2], y[3]); w.z = pk2(y[4], y[5]); w.w = pk2(y[6], y[7]);
            *(u32x4*)(MIX + (size_t)R * 2048 + 1024 + hq * 512 + lane * 8) = w;
        }
    }
    { pg8::Gemm g{(const bf16*)(BIG + B_S5Y), (const bf16*)(WB + W_GLU), 1024, 1024, 1024}; pg8::StaticOrder S; S.init(68, 4, G, bid, 0);
      EpiGlu E{(const bf16*)(BIG + B_S5Y), MIX, args.in[I_GLUB]};
      pg8::gemm_phase<EpiGlu>(lds, g, S, E); }
    PHASE_END

    PHASE_BEGIN
    { pg8::Gemm g{MIX, (const bf16*)(WB + W_OUT), 2048, 2048, 2048}; pg8::TailOrder<32> S; S.init(G, bid);
      EpiRes<true> E{args.in[I_X], XLb, MOD + 2 * 2048, SLAB};
      pg8::gemm_phase<EpiRes<true>, pg8::TailOrder<32>>(lds, g, S, E); }
    PHASE_END

    PHASE_BEGIN
    ADALN(0, 1, true, XLb, args.in[I_CTX], false, SLAB, MOD + 4 * 12288 + 2 * 2048)
    PHASE_END

    PHASE_BEGIN
    { pg8::Gemm g{Hb, (const bf16*)(WB + W_UP), DM, DM, DM}; pg8::StaticOrder S; S.init(68, 44, G, bid, 0);
      EpiSwiglu E{(bf16*)(BIG + B_G)};
      pg8::gemm_phase<EpiSwiglu>(lds, g, S, E); }
    PHASE_END

    PHASE_BEGIN
    { pg8::Gemm g{(const bf16*)(BIG + B_G), (const bf16*)(WB + W_DN), DFF, DFF, DFF}; pg8::TailOrder<88> S; S.init(G, bid);
      EpiRes<false> E{XLb, XLb, MOD + 5 * 2048, SLAB};
      pg8::gemm_phase<EpiRes<false>, pg8::TailOrder<88>>(lds, g, S, E); }
    PHASE_END

    PHASE_BEGIN
    ADALN(1, 0, true, XLb, XC, false, SLAB, MOD + 4 * 12288 + 5 * 2048)
    {
        LAS float* scr = (LAS float*)(lds + wave * 16384);
        constexpr int J0 = 32 * 256, J1 = 48 * 64, J3 = 32 * 176, J4 = J3, J5 = 88 * 64;
        (void)J3; (void)J4; (void)J5;
        for (int it = gw; it < J0 + J1; it += NGW) {
            int r = it;
            if (r < J0) { transpose_job(r, args.in[I_OWIN], 2048, 8192, (bf16*)(WB + W_IN), 0, 0, scr, lane); continue; } r -= J0;
            transpose_job(r, args.in[I_OWOUT], 3072, 2048, (bf16*)(WB + W_OUT), 0, 0, scr, lane);
        }
        bf16* WG = (bf16*)(WB + W_GLU);
        for (int i = bid * 512 + tid; i < 4096 * 256 / 2; i += G * 512) {
            const int kk = (i & 127) * 2, np = i >> 7; const int e = np & 127, half = (np >> 7) & 1, q = np >> 8, blk = q & 7, dir = q >> 3;
            unsigned w = 0u;
            if ((kk >> 7) == (blk & 1)) { const float* src = args.in[half ? I_LWX : I_LWA] + ((size_t)(dir * 8 + blk) * 128 + (kk & 127)) * 128 + e; w = pk2(src[0], src[128]); }
            *(unsigned*)(WG + (size_t)np * 256 + kk) = w;
        }
    }
    PHASE_END

    PHASE_BEGIN
    { pg8::Gemm g{Hb, (const bf16*)(WB + W_IN), DM, DM, DM}; pg8::StaticOrder S; S.init(68, 8, G, bid, 0);
      EpiPlain E{(bf16*)(BIG + B_INA), 2048};
      pg8::gemm_phase<EpiPlain>(lds, g, S, E); }
    PHASE_END

    PHASE_BEGIN
    {
        const bf16* INA = (const bf16*)(BIG + B_INA); bf16* XCV = (bf16*)(BIG + B_XCV);
        int cur_half = -1; f32x4 wv[8]; float cb[8];
        for (int item = gw; item < MROWS * 2; item += NGW) {
            const int half = item / MROWS, R = item - half * MROWS, b = R / SROW, sx = R - b * SROW;
            const int seg_lo = sx < CTX ? 0 : CTX, seg_hi = sx < CTX ? CTX : SROW;
            const int ch = half * 512 + lane * 8;
            if (half != cur_half) { cur_half = half;
#pragma unroll
                for (int e = 0; e < 8; ++e) { wv[e] = *(const f32x4*)(args.in[I_LCW] + (size_t)(ch + e) * 4); cb[e] = args.in[I_LCB][ch + e]; } }
            float acc[8];
#pragma unroll
            for (int e = 0; e < 8; ++e) acc[e] = cb[e];
#pragma unroll
            for (int j = 0; j < 4; ++j) { const int sj = sx + j - 2;
                if (sj >= seg_lo && sj < seg_hi) { const u32x4 w = *(const u32x4*)(INA + (size_t)(b * SROW + sj) * 2048 + ch);
                    acc[0] += wv[0][j] * lo16(w.x); acc[1] += wv[1][j] * hi16(w.x); acc[2] += wv[2][j] * lo16(w.y); acc[3] += wv[3][j] * hi16(w.y);
                    acc[4] += wv[4][j] * lo16(w.z); acc[5] += wv[5][j] * hi16(w.z); acc[6] += wv[6][j] * lo16(w.w); acc[7] += wv[7][j] * hi16(w.w); } }
            u32x4 o; o.x = pk2(acc[0], acc[1]); o.y = pk2(acc[2], acc[3]); o.z = pk2(acc[4], acc[5]); o.w = pk2(acc[6], acc[7]);
            *(u32x4*)(XCV + (size_t)R * 1024 + ch) = o;
        }
    }
    PHASE_END

    PHASE_BEGIN
    { pg8::Gemm g{(const bf16*)(BIG + B_XCV), (const bf16*)(WB + W_GLU), 1024, 256, 256}; pg8::StaticOrder S; S.init(68, 16, G, bid, 0);
      EpiGate E{(const bf16*)(BIG + B_XCV), (bf16*)(BIG + B_LA), (bf16*)(BIG + B_BB), args.in[I_LBA], args.in[I_LBX], T_SPL};
      pg8::gemm_phase<EpiGate, pg8::StaticOrder, true>(lds, g, S, E); }
    PHASE_END

    PHASE_BEGIN
    {
        const bf16* LA = (const bf16*)(BIG + B_LA); const bf16* BBp = (const bf16*)(BIG + B_BB); float* EP = (float*)(BIG + B_LEP);
        for (int i = bid * 512 + tid; i < NB * 2 * NCH * 128; i += G * 512) {
            const int c8 = i & 127; int rest = i >> 7; const int c = rest % NCH; rest /= NCH; const int dir = rest & 1, b = rest >> 1;
            float P[8], h[8];
#pragma unroll
            for (int e = 0; e < 8; ++e) { P[e] = 1.f; h[e] = 0.f; }
#pragma unroll 4
            for (int ti = 0; ti < 64; ++ti) { const int t = dir ? 63 - ti : ti; const size_t o = ((size_t)(b * SROW + c * 64 + t) * 2 + dir) * 1024 + c8 * 8;
                const u32x4 lw = *(const u32x4*)(LA + o), bw = *(const u32x4*)(BBp + o);
                const float la[8] = {lo16(lw.x), hi16(lw.x), lo16(lw.y), hi16(lw.y), lo16(lw.z), hi16(lw.z), lo16(lw.w), hi16(lw.w)};
                const float bb[8] = {lo16(bw.x), hi16(bw.x), lo16(bw.y), hi16(bw.y), lo16(bw.z), hi16(bw.z), lo16(bw.w), hi16(bw.w)};
#pragma unroll
                for (int e = 0; e < 8; ++e) { const float av = __expf(la[e]); P[e] *= av; h[e] = av * h[e] + bb[e]; } }
            float* ep = EP + ((size_t)((b * 2 + dir) * NCH + c) * 1024 + c8 * 8) * 2;
#pragma unroll
            for (int e = 0; e < 8; e += 2) *(f32x4*)(ep + e * 2) = (f32x4){P[e], h[e], P[e + 1], h[e + 1]};
        }
    }
    PHASE_END

    PHASE_BEGIN
    {
        const float* EP = (const float*)(BIG + B_LEP); float* ST = (float*)(BIG + B_LST);
        for (int i = bid * 512 + tid; i < NB * 2 * 1024; i += G * 512) {
            const int ch = i & 1023, dir = (i >> 10) & 1, b = i >> 11; float s = 0.f;
            for (int k = 0; k < NCH; ++k) { const int c = dir == 0 ? k : (k < 4 ? 3 - k : 71 - k); const size_t o = ((size_t)(b * 2 + dir) * NCH + c) * 1024 + ch;
                ST[o] = s; s = EP[o * 2] * s + EP[o * 2 + 1]; }
        }
    }
    PHASE_END

    PHASE_BEGIN
    {
        const bf16* LA = (const bf16*)(BIG + B_LA); const bf16* BBp = (const bf16*)(BIG + B_BB); const float* ST = (const float*)(BIG + B_LST); const bf16* INA = (const bf16*)(BIG + B_INA);
        for (int u = bid; u < NB * 64; u += G) {
            const int c = 4 + (u & 63), b = u >> 6;
            if (tid < 128) {
                const int ch = tid * 8;
                float h[8];
                { const float* st = ST + ((size_t)(b * 2 + 0) * NCH + c) * 1024 + ch; const f32x4 s0 = *(const f32x4*)st, s1 = *(const f32x4*)(st + 4);
                  h[0] = s0[0]; h[1] = s0[1]; h[2] = s0[2]; h[3] = s0[3]; h[4] = s1[0]; h[5] = s1[1]; h[6] = s1[2]; h[7] = s1[3]; }
#pragma unroll 4
                for (int t = 0; t < 64; ++t) { const size_t o = ((size_t)(b * SROW + c * 64 + t) * 2 + 0) * 1024 + ch;
                    const u32x4 lw = *(const u32x4*)(LA + o), bw = *(const u32x4*)(BBp + o);
                    const float la[8] = {lo16(lw.x), hi16(lw.x), lo16(lw.y), hi16(lw.y), lo16(lw.z), hi16(lw.z), lo16(lw.w), hi16(lw.w)};
                    const float bb[8] = {lo16(bw.x), hi16(bw.x), lo16(bw.y), hi16(bw.y), lo16(bw.z), hi16(bw.z), lo16(bw.w), hi16(bw.w)};
#pragma unroll
                    for (int e = 0; e < 8; ++e) h[e] = __expf(la[e]) * h[e] + bb[e];
                    u32x4 w; w.x = pk2(h[0], h[1]); w.y = pk2(h[2], h[3]); w.z = pk2(h[4], h[5]); w.w = pk2(h[6], h[7]);
                    *(LAS u32x4*)(lds + t * 2048 + tid * 16) = w; }
                { const float* st = ST + ((size_t)(b * 2 + 1) * NCH + c) * 1024 + ch; const f32x4 s0 = *(const f32x4*)st, s1 = *(const f32x4*)(st + 4);
                  h[0] = s0[0]; h[1] = s0[1]; h[2] = s0[2]; h[3] = s0[3]; h[4] = s1[0]; h[5] = s1[1]; h[6] = s1[2]; h[7] = s1[3]; }
#pragma unroll 4
                for (int t = 63; t >= 0; --t) { const size_t R = (size_t)(b * SROW + c * 64 + t); const size_t o = (R * 2 + 1) * 1024 + ch;
                    const u32x4 lw = *(const u32x4*)(LA + o), bw = *(const u32x4*)(BBp + o), gw4 = *(const u32x4*)(INA + R * 2048 + 1024 + ch);
                    const u32x4 fw = *(const LAS u32x4*)(lds + t * 2048 + tid * 16);
                    const float la[8] = {lo16(lw.x), hi16(lw.x), lo16(lw.y), hi16(lw.y), lo16(lw.z), hi16(lw.z), lo16(lw.w), hi16(lw.w)};
                    const float bb[8] = {lo16(bw.x), hi16(bw.x), lo16(bw.y), hi16(bw.y), lo16(bw.z), hi16(bw.z), lo16(bw.w), hi16(bw.w)};
                    const float gt[8] = {lo16(gw4.x), hi16(gw4.x), lo16(gw4.y), hi16(gw4.y), lo16(gw4.z), hi16(gw4.z), lo16(gw4.w), hi16(gw4.w)};
                    const float hf[8] = {lo16(fw.x), hi16(fw.x), lo16(fw.y), hi16(fw.y), lo16(fw.z), hi16(fw.z), lo16(fw.w), hi16(fw.w)};
                    float y[8];
#pragma unroll
                    for (int e = 0; e < 8; ++e) { h[e] = __expf(la[e]) * h[e] + bb[e]; y[e] = (hf[e] + h[e]) * gelu_tanh(gt[e]); }
                    u32x4 w; w.x = pk2(y[0], y[1]); w.y = pk2(y[2], y[3]); w.z = pk2(y[4], y[5]); w.w = pk2(y[6], y[7]);
                    *(u32x4*)(MIX + R * 3072 + ch) = w; }
            }
            __syncthreads();
        }
    }
    PHASE_END

    PHASE_BEGIN
    { pg8::Gemm g{Hb, (const bf16*)(WB + W_IN) + (size_t)2048 * 2048, DM, DM, DM}; pg8::StaticOrder S; S.init(68, 24, G, bid, 0);
      EpiRope E{(bf16*)(BIG + B_INB), T_ROPE};
      pg8::gemm_phase<EpiRope>(lds, g, S, E); }
    PHASE_END

    PHASE_BEGIN
    {
        const bf16* INB = (const bf16*)(BIG + B_INB);
        constexpr int QS = 0, KS = 33792, VS = 67584, TS = 76800, RS = 528, VRS = 144;
        const int r = lane & 15, q = lane >> 4, qq = r >> 2, pp = r & 3;
        const int it = wave >> 1, dvp = wave & 1;
        for (int unit0 = bid; unit0 < NB * 4 * 2 * 8; unit0 += G) {
            const int unit = (unit0 & 7) * 32 + (unit0 >> 3);
            const int sl = unit & 7, dir = (unit >> 3) & 1, h = (unit >> 4) & 3, b = unit >> 6;
            bf16* RO = (bf16*)(BIG + (dir ? B_RO1 : B_RO0));
            const float lgam = -expf(args.in[I_RTH][dir * 4 + h]);
            const float gC = expf(64.f * lgam);
            f32x4 Tacc[2][4];
#pragma unroll
            for (int a = 0; a < 2; ++a)
#pragma unroll
                for (int d = 0; d < 4; ++d) Tacc[a][d] = (f32x4){0.f, 0.f, 0.f, 0.f};
            const int vrow = tid >> 3, vcp = tid & 7;
            const float vsc = expf(-(float)vrow * lgam);
            u32x4 pq[4], pk[4], pv;
#define RT_ROW(n, row) ((size_t)b * SROW + (dir == 0 ? ((n) * 64 + (row)) : (((n) * 64 + (row)) < CTX ? CTX - 1 - ((n) * 64 + (row)) : SROW + CTX - 1 - ((n) * 64 + (row)))))
#define RT_LOAD(n) do { _Pragma("unroll") for (int k = 0; k < 4; ++k) { const int id = tid + 512 * k, row = id >> 5, cp = id & 31; const bf16* src = INB + RT_ROW(n, row) * INB_LD + h * 256 + cp * 8; \
                pq[k] = *(const u32x4*)src; pk[k] = *(const u32x4*)(src + 1024); } \
                pv = *(const u32x4*)(INB + RT_ROW(n, vrow) * INB_LD + 2048 + h * 512 + sl * 64 + vcp * 8); } while (0)
            RT_LOAD(0);
            float bgv[8]; int bg_cur = -1; int bg_it = gw;
            for (int n = 0; n < NCH; ++n) {
                BGW_STORE(1); BGW_ISSUE(bg_it, 1); bg_it += NGW;
#pragma unroll
                for (int k = 0; k < 4; ++k) { const int id = tid + 512 * k, row = id >> 5, cp = id & 31;
                    *(LAS u32x4*)(lds + QS + row * RS + cp * 16) = pq[k]; *(LAS u32x4*)(lds + KS + row * RS + cp * 16) = pk[k]; }
                { u32x4 w; w.x = pk2(lo16(pv.x) * vsc, hi16(pv.x) * vsc); w.y = pk2(lo16(pv.y) * vsc, hi16(pv.y) * vsc); w.z = pk2(lo16(pv.z) * vsc, hi16(pv.z) * vsc); w.w = pk2(lo16(pv.w) * vsc, hi16(pv.w) * vsc);
                  *(LAS u32x4*)(lds + VS + vrow * VRS + vcp * 16) = w; }
                const bool outp = n >= 4;
                if (outp) {
#pragma unroll
                    for (int a = 0; a < 2; ++a)
#pragma unroll
                        for (int d = 0; d < 4; ++d) { u32x2 w; w.x = pk2(Tacc[a][d][0], Tacc[a][d][1]); w.y = pk2(Tacc[a][d][2], Tacc[a][d][3]);
                            *(LAS u32x2*)(lds + TS + (16 * d + r) * RS + (16 * (2 * wave + a) + 4 * q) * 2) = w; }
                }
                __syncthreads();
                if (n + 1 < NCH) RT_LOAD(n + 1);
                if (outp) {
                    bf16x8 Qf[8];
#pragma unroll
                    for (int ks = 0; ks < 8; ++ks) Qf[ks] = *(const LAS bf16x8*)(lds + QS + (16 * it + r) * RS + (32 * ks + 8 * q) * 2);
                    f32x4 oacc[2];
#pragma unroll
                    for (int dd = 0; dd < 2; ++dd) { f32x4 c = (f32x4){0.f, 0.f, 0.f, 0.f};
#pragma unroll
                        for (int ks = 0; ks < 8; ++ks) { const bf16x8 tf = *(const LAS bf16x8*)(lds + TS + (16 * (2 * dvp + dd) + r) * RS + (32 * ks + 8 * q) * 2);
                            c = __builtin_amdgcn_mfma_f32_16x16x32_bf16(Qf[ks], tf, c, 0, 0, 0); }
                        oacc[dd] = c * gC; }
#pragma unroll
                    for (int kp = 0; kp < 2; ++kp) {
                        if (2 * kp <= it) {
                            f32x4 pt[2];
#pragma unroll
                            for (int e = 0; e < 2; ++e) { const int jt = 2 * kp + e; f32x4 c = (f32x4){0.f, 0.f, 0.f, 0.f};
                                if (jt <= it) {
#pragma unroll
                                    for (int ks = 0; ks < 8; ++ks) { const bf16x8 kf = *(const LAS bf16x8*)(lds + KS + (16 * jt + r) * RS + (32 * ks + 8 * q) * 2);
                                        c = __builtin_amdgcn_mfma_f32_16x16x32_bf16(kf, Qf[ks], c, 0, 0, 0); }
                                    if (jt == it) {
#pragma unroll
                                        for (int jj = 0; jj < 4; ++jj) if (4 * q + jj > r) c[jj] = 0.f; }
                                }
                                pt[e] = c; }
                            u32x4 pw; pw.x = pk2(pt[0][0], pt[0][1]); pw.y = pk2(pt[0][2], pt[0][3]); pw.z = pk2(pt[1][0], pt[1][1]); pw.w = pk2(pt[1][2], pt[1][3]);
                            const bf16x8 pf = __builtin_bit_cast(bf16x8, pw);
#pragma unroll
                            for (int dd = 0; dd < 2; ++dd) { const int dvt = 2 * dvp + dd;
                                const s16x4 v0 = __builtin_amdgcn_ds_read_tr16_b64_v4i16((LAS s16x4*)(lds + VS + (32 * kp + 4 * q + qq) * VRS + (16 * dvt + 4 * pp) * 2));
                                const s16x4 v1 = __builtin_amdgcn_ds_read_tr16_b64_v4i16((LAS s16x4*)(lds + VS + (32 * kp + 16 + 4 * q + qq) * VRS + (16 * dvt + 4 * pp) * 2));
                                const bf16x8 vf = {v0[0], v0[1], v0[2], v0[3], v1[0], v1[1], v1[2], v1[3]};
                                oacc[dd] = __builtin_amdgcn_mfma_f32_16x16x32_bf16(pf, vf, oacc[dd], 0, 0, 0); }
                        }
                    }
#pragma unroll
                    for (int jj = 0; jj < 4; ++jj) { const int i = 16 * it + 4 * q + jj; const float gi = __expf((float)i * lgam);
                        const size_t R = RT_ROW(n, i); const size_t Rl = (size_t)b * SEQ + (R - (size_t)b * SROW - CTX);
#pragma unroll
                        for (int dd = 0; dd < 2; ++dd) RO[Rl * 2048 + h * 512 + sl * 64 + 16 * (2 * dvp + dd) + r] = (bf16)f2bf(oacc[dd][jj] * gi); }
                }
#pragma unroll
                for (int a = 0; a < 2; ++a)
#pragma unroll
                    for (int d = 0; d < 4; ++d) Tacc[a][d] = Tacc[a][d] * gC;
#pragma unroll
                for (int ks = 0; ks < 2; ++ks) {
                    bf16x8 kt[2], vf[4];
#pragma unroll
                    for (int a = 0; a < 2; ++a) { const int dkt = 2 * wave + a;
                        const s16x4 k0 = __builtin_amdgcn_ds_read_tr16_b64_v4i16((LAS s16x4*)(lds + KS + (32 * ks + 8 * q + qq) * RS + (16 * dkt + 4 * pp) * 2));
                        const s16x4 k1 = __builtin_amdgcn_ds_read_tr16_b64_v4i16((LAS s16x4*)(lds + KS + (32 * ks + 8 * q + 4 + qq) * RS + (16 * dkt + 4 * pp) * 2));
                        kt[a] = (bf16x8){k0[0], k0[1], k0[2], k0[3], k1[0], k1[1], k1[2], k1[3]}; }
#pragma unroll
                    for (int d = 0; d < 4; ++d) {
                        const s16x4 v0 = __builtin_amdgcn_ds_read_tr16_b64_v4i16((LAS s16x4*)(lds + VS + (32 * ks + 8 * q + qq) * VRS + (16 * d + 4 * pp) * 2));
                        const s16x4 v1 = __builtin_amdgcn_ds_read_tr16_b64_v4i16((LAS s16x4*)(lds + VS + (32 * ks + 8 * q + 4 + qq) * VRS + (16 * d + 4 * pp) * 2));
                        vf[d] = (bf16x8){v0[0], v0[1], v0[2], v0[3], v1[0], v1[1], v1[2], v1[3]}; }
#pragma unroll
                    for (int a = 0; a < 2; ++a)
#pragma unroll
                        for (int d = 0; d < 4; ++d) Tacc[a][d] = __builtin_amdgcn_mfma_f32_16x16x32_bf16(kt[a], vf[d], Tacc[a][d], 0, 0, 0);
                }
                __syncthreads();
            }
            BGW_STORE(1);
            for (; bg_it < BGW_ITEMS; bg_it += NGW) { BGW_ISSUE(bg_it, 1); BGW_STORE(1); }
        }
#undef RT_ROW
#undef RT_LOAD
    }
    PHASE_END

    PHASE_BEGIN
    {
        const bf16* O0 = (const bf16*)(BIG + B_RO0); const bf16* O1 = (const bf16*)(BIG + B_RO1); const bf16* INB = (const bf16*)(BIG + B_INB);
        for (int item = gw; item < NB * SEQ * 4; item += NGW) {
            const int Rl = item >> 2, h = item & 3, b = Rl / SEQ, n = Rl % SEQ; const size_t R = (size_t)b * SROW + CTX + n;
            const size_t o = (size_t)Rl * 2048 + h * 512 + lane * 8;
            const u32x4 a = *(const u32x4*)(O0 + o), c = *(const u32x4*)(O1 + o);
            float v[8] = {lo16(a.x) + lo16(c.x), hi16(a.x) + hi16(c.x), lo16(a.y) + lo16(c.y), hi16(a.y) + hi16(c.y), lo16(a.z) + lo16(c.z), hi16(a.z) + hi16(c.z), lo16(a.w) + lo16(c.w), hi16(a.w) + hi16(c.w)};
            float ss = 0.f;
#pragma unroll
            for (int e = 0; e < 8; ++e) ss += v[e] * v[e];
            const float rs = __builtin_amdgcn_rsqf(wave_sum(ss) * (1.f / 512.f) + EPS);
            const u32x4 gw4 = *(const u32x4*)(INB + R * INB_LD + 4096 + h * 512 + lane * 8);
            const float gt[8] = {lo16(gw4.x), hi16(gw4.x), lo16(gw4.y), hi16(gw4.y), lo16(gw4.z), hi16(gw4.z), lo16(gw4.w), hi16(gw4.w)};
            u32x4 w; w.x = pk2(v[0] * rs * siluf_(gt[0]), v[1] * rs * siluf_(gt[1])); w.y = pk2(v[2] * rs * siluf_(gt[2]), v[3] * rs * siluf_(gt[3]));
            w.z = pk2(v[4] * rs * siluf_(gt[4]), v[5] * rs * siluf_(gt[5])); w.w = pk2(v[6] * rs * siluf_(gt[6]), v[7] * rs * siluf_(gt[7]));
            *(u32x4*)(MIX + R * 3072 + 1024 + h * 512 + lane * 8) = w;
        }
    }
    PHASE_END

    PHASE_BEGIN
    { pg8::Gemm g{MIX, (const bf16*)(WB + W_OUT), 3072, 3072, 3072}; pg8::StaticOrder S; S.init(64, 8, G, bid, 1);
      EpiRes<false> E{XLb, XLb, MOD + 5 * 12288 + 2 * 2048, SLAB};
      pg8::gemm_phase<EpiRes<false>>(lds, g, S, E); }
    PHASE_END

    PHASE_BEGIN
    ADALN(1, 1, true, XLb, XC, true, (const float*)nullptr, (const float*)nullptr)
    PHASE_END

    PHASE_BEGIN
    { pg8::Gemm g{Hb, (const bf16*)(WB + W_UP), DM, DM, DM}; pg8::StaticOrder S; S.init(64, 44, G, bid, 1);
      EpiSwiglu E{(bf16*)(BIG + B_G)};
      pg8::gemm_phase<EpiSwiglu>(lds, g, S, E); }
    PHASE_END

    PHASE_BEGIN
    { pg8::Gemm g{(const bf16*)(BIG + B_G), (const bf16*)(WB + W_DN), DFF, DFF, DFF}; pg8::StaticOrder S; S.init(64, 8, G, bid, 1);
      EpiRes<false> E{XLb, XLb, MOD + 5 * 12288 + 5 * 2048, SLAB};
      pg8::gemm_phase<EpiRes<false>>(lds, g, S, E); }
    PHASE_END

    PHASE_BEGIN
    {
        const float* fg = args.in[I_FING];
        f32x4 gg[8];
#pragma unroll
        for (int j = 0; j < 8; ++j) gg[j] = *(const f32x4*)(fg + lane * 4 + j * 256);
        for (int R = gw; R < NB * SEQ; R += NGW) { const bf16* xr = XLb + (size_t)R * DM; float* orow = args.out + (size_t)R * DM;
            f32x4 v[8]; float ss = 0.f;
#pragma unroll
            for (int j = 0; j < 8; ++j) { const u32x2 w = *(const u32x2*)(xr + lane * 4 + j * 256); v[j] = (f32x4){lo16(w.x), hi16(w.x), lo16(w.y), hi16(w.y)};
                ss += (v[j][0] * v[j][0] + v[j][1] * v[j][1]) + (v[j][2] * v[j][2] + v[j][3] * v[j][3]); }
            const float rstd = __builtin_amdgcn_rsqf(wave_sum(ss) * (1.f / DM) + EPS);
#pragma unroll
            for (int j = 0; j < 8; ++j) *(f32x4*)(orow + lane * 4 + j * 256) = v[j] * rstd * gg[j];
        }
    }
    PHASE_END
}
constexpr int N_PHASES = 26;

extern "C" void kernel_launch(void* const* d_in, const int* in_sizes, int n_in, void* d_out, int out_size, void* d_ws, size_t ws_size, hipStream_t stream) {
    static int grid = 0;
    if (grid == 0) {
        if (n_in != 38 || out_size != NB * SEQ * DM || ws_size < WS_END) { fprintf(stderr, "kernel_launch: unexpected problem (n_in %d out %d ws %zu, need %zu)\n", n_in, out_size, ws_size, (size_t)WS_END); grid = -1; return; }
        int dev = 0, cus = 0;
        if (hipGetDevice(&dev) != hipSuccess || hipDeviceGetAttribute(&cus, hipDeviceAttributeMultiprocessorCount, dev) != hipSuccess) { grid = -1; return; }
        if (hipFuncSetAttribute((const void*)fwd_kernel, hipFuncAttributeMaxDynamicSharedMemorySize, LDS_BYTES) != hipSuccess) { fprintf(stderr, "kernel_launch: hipFuncSetAttribute failed\n"); grid = -1; return; }
        int per_cu = 0;
        if (hipOccupancyMaxActiveBlocksPerMultiprocessor(&per_cu, (const void*)fwd_kernel, 512, LDS_BYTES) != hipSuccess || per_cu < 1) { fprintf(stderr, "kernel_launch: occupancy query says %d\n", per_cu); }
        (void)hipGetLastError();
        if (per_cu < 1) { grid = -1; return; }
        grid = cus;
    }
    if (grid < 0) return;
    (void)hipMemsetAsync((char*)d_ws + WS_CTL, 0, CTL_BYTES, stream);
    Args a{};
    for (int i = 0; i < 38; ++i) a.in[i] = (const float*)d_in[i];
    a.out = (float*)d_out; a.ws = (unsigned char*)d_ws;
#if MK_ONE_LAUNCH
    a.ph_lo = 0; a.ph_hi = N_PHASES;
    hipLaunchKernelGGL(fwd_kernel, dim3(grid), dim3(512), LDS_BYTES, stream, a);
#else
    for (int p = 0; p < N_PHASES; ++p) { a.ph_lo = p; a.ph_hi = p + 1; hipLaunchKernelGGL(fwd_kernel, dim3(grid), dim3(512), LDS_BYTES, stream, a); }
#endif
}
```
